# Optimizing an MI355X kernel written in HIP

```python
import math
import jax, jax.numpy as jnp
from jax import lax
import numpy as np

D_MODEL = 1024
BATCH = 2
SEQ = 16384
DEPTH = 1

GRID_W = 64
CTX_LEN = 256
EPS = 1e-6
CHUNK = 128
CONV_K = 5
D_SSD = D_MODEL
SSD_HEAD_DIM = 64
SSD_HEADS = D_SSD // SSD_HEAD_DIM
SSD_STATE = 128
SSD_GROUPS = 2
D_XBC = D_SSD + 2 * SSD_GROUPS * SSD_STATE
D_MLSTM = D_MODEL
MLSTM_DV = 128
MLSTM_HEADS = D_MLSTM // MLSTM_DV
MLSTM_DK = MLSTM_DV // 2
D_QK = 2 * MLSTM_HEADS * MLSTM_DK
N_EXPERTS = 256
TOP_K = 8
N_EXPERT_GROUPS = 8
TOPK_GROUPS = 4
D_EXPERT = D_MODEL // 4
D_SHARED = D_EXPERT
ROUTED_SCALE = 2.5
MOE_BLOCK = 128
IN_PROJ_SIZES = (D_SSD, D_XBC, 2 * SSD_HEADS, D_QK, D_MLSTM, 4 * MLSTM_HEADS, D_MLSTM, 2 * D_MODEL)
D_IN_PROJ = sum(IN_PROJ_SIZES)

kernel_name = 'hybrid_ssd_mlstm_moe_prefix_block'


def rmsnorm(t, g):
    t32 = t.astype(jnp.float32)
    y = t32 * lax.rsqrt(jnp.mean(t32 * t32, axis=-1, keepdims=True) + EPS)
    return (y * g.astype(jnp.float32)).astype(t.dtype)


def modulate(t, g, shift, scale):
    return rmsnorm(t, g) * (1 + scale) + shift


def dwconv_centred(t, w, b, n_seg):
    bsz, length, ch = t.shape
    seg = t.reshape(bsz * n_seg, length // n_seg, ch)
    y = lax.conv_general_dilated(seg, w[:, None, :].astype(t.dtype), window_strides=(1,),
                                 padding=((CONV_K // 2, CONV_K // 2),),
                                 dimension_numbers=('NWC', 'WIO', 'NWC'), feature_group_count=ch)
    return y.reshape(bsz, length, ch) + b


def to_chunks(t):
    bsz, length = t.shape[:2]
    return jnp.moveaxis(t.reshape(bsz, length // CHUNK, CHUNK, *t.shape[2:]), 1, 0)


def from_chunks(t):
    t = jnp.moveaxis(t, 0, 1)
    return t.reshape(t.shape[0], t.shape[1] * t.shape[2], *t.shape[3:])


def ssd_scan(xh, dt, a_neg, bm, cm, s0, with_output):
    bsz, length, n_heads, hd = xh.shape
    n_groups, d_state = bm.shape[2], bm.shape[3]
    hpg = n_heads // n_groups
    f32 = jnp.float32
    xs = (to_chunks(xh.astype(f32).reshape(bsz, length, n_groups, hpg, hd)),
          to_chunks(dt.reshape(bsz, length, n_groups, hpg)),
          to_chunks(bm.astype(f32)), to_chunks(cm.astype(f32)))
    ag = a_neg.reshape(n_groups, hpg)
    causal = jnp.tril(jnp.ones((CHUNK, CHUNK), dtype=bool))

    def step(s, inp):
        xc, dtc, bc, cc = inp
        cum = jnp.cumsum(dtc * ag, axis=1)
        total = cum[:, -1]
        s_new = jnp.exp(total)[..., None, None] * s + jnp.einsum(
            'bkgn,bkgh,bkghp->bghpn', bc, dtc * jnp.exp(total[:, None] - cum), xc)
        if not with_output:
            return s_new, None
        seg = cum[:, :, None] - cum[:, None]
        decay = jnp.exp(jnp.where(causal[None, :, :, None, None], seg, -jnp.inf))
        cb = jnp.einsum('bqgn,bkgn->bqkg', cc, bc)
        y = (jnp.einsum('bqkg,bqkgh,bkgh,bkghp->bqghp', cb, decay, dtc, xc)
             + jnp.einsum('bqgn,bghpn,bqgh->bqghp', cc, s, jnp.exp(cum)))
        return s_new, y

    s_fin, ys = lax.scan(step, s0.reshape(bsz, n_groups, hpg, hd, d_state), xs)
    s_fin = s_fin.reshape(bsz, n_heads, hd, d_state)
    if not with_output:
        return None, s_fin
    return from_chunks(ys).reshape(bsz, length, n_heads, hd), s_fin


def mlstm_scan(q, k, v, ig, lf, state0, with_output):
    f32 = jnp.float32
    xs = (to_chunks(q.astype(f32)), to_chunks(k.astype(f32)), to_chunks(v.astype(f32)), to_chunks(ig), to_chunks(lf))
    causal = jnp.tril(jnp.ones((CHUNK, CHUNK), dtype=bool))

    def step(carry, inp):
        c, n, m = carry
        qc, kc, vc, igc, lfc = inp
        b = jnp.cumsum(lfc, axis=1)
        b_end = b[:, -1]
        g = b_end[:, None] - b + igc
        m_new = jnp.maximum(b_end + m, g.max(axis=1))
        w = jnp.exp(g - m_new[:, None])
        carry_decay = jnp.exp(b_end + m - m_new)
        c_new = carry_decay[..., None, None] * c + jnp.einsum('bkh,bkhv,bkhd->bhvd', w, vc, kc)
        n_new = carry_decay[..., None] * n + jnp.einsum('bkh,bkhd->bhd', w, kc)
        if not with_output:
            return (c_new, n_new, m_new), None
        log_d = jnp.where(causal[None, :, :, None], b[:, :, None] - b[:, None] + igc[:, None], -jnp.inf)
        inter = b + m[:, None]
        m_q = jnp.maximum(log_d.max(axis=2), inter)
        s = jnp.einsum('bqhd,bkhd->bqkh', qc, kc) * jnp.exp(log_d - m_q[:, :, None])
        w_state = jnp.exp(inter - m_q)
        num = jnp.einsum('bqkh,bkhv->bqhv', s, vc) + w_state[..., None] * jnp.einsum('bqhd,bhvd->bqhv', qc, c)
        den = s.sum(axis=2) + w_state * jnp.einsum('bqhd,bhd->bqh', qc, n)
        h = num / jnp.maximum(jnp.abs(den), jnp.exp(-m_q))[..., None]
        return (c_new, n_new, m_new), h

    fin, hs = lax.scan(step, state0, xs)
    if not with_output:
        return None, fin
    return from_chunks(hs), fin


def zero_states(bsz):
    f32 = jnp.float32
    return [(jnp.zeros((bsz, SSD_HEADS, SSD_HEAD_DIM, SSD_STATE), f32),
             (jnp.zeros((bsz, MLSTM_HEADS, MLSTM_DV, MLSTM_DK), f32),
              jnp.zeros((bsz, MLSTM_HEADS, MLSTM_DK), f32),
              jnp.zeros((bsz, MLSTM_HEADS), f32))) for _ in range(2)]


def prepare_mixer_inputs(u, lp, n_seg):
    bsz, length = u.shape[:2]
    f32 = jnp.float32
    proj = u @ lp['w_in']
    split_idx = np.cumsum(IN_PROJ_SIZES)[:-1].tolist()
    z, xbc, dt_raw, qk, v, gates_raw, o_raw, merge_raw = jnp.split(proj, split_idx, axis=-1)
    xbc = jax.nn.silu(dwconv_centred(xbc, lp['conv_xbc_w'], lp['conv_xbc_b'], n_seg))
    xs, bm, cm = jnp.split(xbc, [D_SSD, D_SSD + SSD_GROUPS * SSD_STATE], axis=-1)
    dt = jax.nn.softplus(dt_raw.astype(f32).reshape(bsz, length, 2, SSD_HEADS) + lp['ssd_dt_bias'].astype(f32))
    qk = jax.nn.silu(dwconv_centred(qk, lp['conv_qk_w'], lp['conv_qk_b'], n_seg))
    q, k = jnp.split(qk, 2, axis=-1)
    gates = gates_raw.astype(f32).reshape(bsz, length, 2, 2, MLSTM_HEADS)
    return {
        'z': z,
        'xh': xs.reshape(bsz, length, SSD_HEADS, SSD_HEAD_DIM),
        'bm': bm.reshape(bsz, length, SSD_GROUPS, SSD_STATE),
        'cm': cm.reshape(bsz, length, SSD_GROUPS, SSD_STATE),
        'dt': dt,
        'q': q.reshape(bsz, length, MLSTM_HEADS, MLSTM_DK) * (MLSTM_DK ** -0.5),
        'k': k.reshape(bsz, length, MLSTM_HEADS, MLSTM_DK),
        'v': v.reshape(bsz, length, MLSTM_HEADS, MLSTM_DV),
        'ig': gates[:, :, :, 0] + lp['mlstm_i_bias'].astype(f32),
        'lf': jax.nn.log_sigmoid(gates[:, :, :, 1] + lp['mlstm_f_bias'].astype(f32)),
        'o': jax.nn.sigmoid(o_raw),
        'merge': merge_raw,
    }


def maybe_flip(t, rev):
    return t[:, ::-1] if rev else t


def bidirectional_scans(p, lp, init, with_output):
    a_neg = -jnp.exp(lp['ssd_a_log'].astype(jnp.float32))
    ys_ssd, ys_m, finals = [], [], []
    for d in range(2):
        rev = d == 1
        s0, m0 = init[d]
        y_s, s_fin = ssd_scan(maybe_flip(p['xh'], rev), maybe_flip(p['dt'][:, :, d], rev), a_neg[d],
                              maybe_flip(p['bm'], rev), maybe_flip(p['cm'], rev), s0, with_output)
        h_m, m_fin = mlstm_scan(maybe_flip(p['q'], rev), maybe_flip(p['k'], rev), maybe_flip(p['v'], rev),
                                maybe_flip(p['ig'][:, :, d], rev), maybe_flip(p['lf'][:, :, d], rev), m0, with_output)
        finals.append((s_fin, m_fin))
        if with_output:
            ys_ssd.append(maybe_flip(y_s, rev))
            ys_m.append(maybe_flip(h_m, rev))
    if not with_output:
        return None, None, finals
    return ys_ssd[0] + ys_ssd[1], ys_m[0] + ys_m[1], finals


def merge_branches(p, y_ssd, h_m, lp):
    bsz, length = p['z'].shape[:2]
    dt_in = p['z'].dtype
    y = (y_ssd + lp['ssd_d'].astype(jnp.float32)[:, None] * p['xh'].astype(jnp.float32)).reshape(bsz, length, D_SSD)
    y = rmsnorm(y * jax.nn.silu(p['z'].astype(jnp.float32)), lp['ssd_norm_g']).astype(dt_in)
    h = rmsnorm(h_m, lp['mlstm_norm_g'].reshape(MLSTM_HEADS, MLSTM_DV)).reshape(bsz, length, D_MLSTM).astype(dt_in)
    h = p['o'] * h
    g_ssd, g_m = jnp.split(jax.nn.sigmoid(p['merge']), 2, axis=-1)
    merged = g_ssd * (y @ lp['w_ssd_out']) + g_m * (h @ lp['w_mlstm_out'])
    return merged @ lp['w_out']


def moe_ffn(u, lp):
    bsz, length, dm = u.shape
    t = u.reshape(-1, dm)
    n_tok = t.shape[0]
    scores = jax.nn.sigmoid((t @ lp['router_w']).astype(jnp.float32))
    grouped = (scores + lp['router_bias'].astype(jnp.float32)).reshape(n_tok, N_EXPERT_GROUPS, -1)
    group_score = lax.top_k(grouped, 2)[0].sum(-1)
    _, top_groups = lax.top_k(group_score, TOPK_GROUPS)
    group_mask = jax.nn.one_hot(top_groups, N_EXPERT_GROUPS, dtype=jnp.float32).sum(1) > 0
    sel = jnp.where(group_mask[:, :, None], grouped, -jnp.inf).reshape(n_tok, N_EXPERTS)
    _, top_e = lax.top_k(sel, TOP_K)
    wts = jnp.take_along_axis(scores, top_e, axis=1)
    wts = ROUTED_SCALE * wts / wts.sum(-1, keepdims=True)
    n_assign = n_tok * TOP_K
    flat_e = top_e.reshape(-1)
    order = jnp.argsort(flat_e)
    e_sorted = flat_e[order]
    tok_sorted = (order // TOP_K).astype(jnp.int32)
    w_sorted = wts.reshape(-1)[order]
    counts = jnp.bincount(flat_e, length=N_EXPERTS)
    padded = (counts + MOE_BLOCK - 1) // MOE_BLOCK * MOE_BLOCK
    pad_end = jnp.cumsum(padded)
    pad_start = pad_end - padded
    start = jnp.cumsum(counts) - counts
    dest = pad_start[e_sorted] + jnp.arange(n_assign) - start[e_sorted]
    n_blocks = -(-n_assign // MOE_BLOCK) + N_EXPERTS
    slot_tok = jnp.full((n_blocks * MOE_BLOCK,), n_tok, jnp.int32).at[dest].set(tok_sorted)
    slot_w = jnp.zeros((n_blocks * MOE_BLOCK,), u.dtype).at[dest].set(w_sorted.astype(u.dtype))
    block_expert = jnp.minimum(jnp.searchsorted(pad_end, jnp.arange(n_blocks) * MOE_BLOCK, side='right'), N_EXPERTS - 1)
    t_pad = jnp.concatenate([t, jnp.zeros((1, dm), t.dtype)], axis=0)
    w_gate, w_up, w_down = lp['moe_w_gate'], lp['moe_w_up'], lp['moe_w_down']

    def block(acc, inp):
        tok, wt, e = inp
        xb = t_pad[tok]
        hb = jax.nn.silu(xb @ w_gate[e]) * (xb @ w_up[e])
        return acc.at[tok].add((hb @ w_down[e]) * wt[:, None]), None

    acc, _ = lax.scan(block, jnp.zeros_like(t_pad),
                      (slot_tok.reshape(n_blocks, MOE_BLOCK), slot_w.reshape(n_blocks, MOE_BLOCK), block_expert))
    shared = (jax.nn.silu(t @ lp['shared_w_gate']) * (t @ lp['shared_w_up'])) @ lp['shared_w_down']
    return (acc[:n_tok] + shared).reshape(bsz, length, dm)


def setup_inputs(seed: int = 0) -> dict:
    key = jax.random.key(seed)
    ks = jax.random.split(key, 40)
    nrm = lambda k, shape, s: jax.random.normal(k, shape, jnp.float32) * s
    dt0 = jnp.exp(jax.random.uniform(ks[10], (DEPTH, 2, SSD_HEADS)) * (math.log(0.1) - math.log(0.001)) + math.log(0.001))
    return {
        'x': nrm(ks[0], (BATCH, SEQ, D_MODEL), 1.0),
        'c': nrm(ks[1], (BATCH, D_MODEL), 1.0),
        'ctx': nrm(ks[2], (BATCH, CTX_LEN, D_MODEL), 1.0),
        'c_ctx': nrm(ks[3], (D_MODEL,), 1.0),
        'ada_w': nrm(ks[4], (DEPTH, D_MODEL, 6 * D_MODEL), 0.3 * D_MODEL ** -0.5),
        'ada_b': nrm(ks[5], (DEPTH, 6 * D_MODEL), 0.02),
        'norm_mix_g': 1.0 + nrm(ks[6], (DEPTH, D_MODEL), 0.02),
        'norm_ffn_g': 1.0 + nrm(ks[7], (DEPTH, D_MODEL), 0.02),
        'w_in': nrm(ks[8], (DEPTH, D_MODEL, D_IN_PROJ), D_MODEL ** -0.5),
        'conv_xbc_w': nrm(ks[9], (DEPTH, CONV_K, D_XBC), CONV_K ** -0.5),
        'conv_xbc_b': nrm(ks[11], (DEPTH, D_XBC), 0.02),
        'ssd_dt_bias': dt0 + jnp.log(-jnp.expm1(-dt0)),
        'ssd_a_log': jnp.log(jax.random.uniform(ks[12], (DEPTH, 2, SSD_HEADS), jnp.float32, 1.0, 16.0)),
        'ssd_d': 1.0 + nrm(ks[13], (DEPTH, SSD_HEADS), 0.1),
        'ssd_norm_g': 1.0 + nrm(ks[14], (DEPTH, D_SSD), 0.02),
        'conv_qk_w': nrm(ks[15], (DEPTH, CONV_K, D_QK), CONV_K ** -0.5),
        'conv_qk_b': nrm(ks[16], (DEPTH, D_QK), 0.02),
        'mlstm_i_bias': -1.0 + nrm(ks[17], (DEPTH, 2, MLSTM_HEADS), 0.1),
        'mlstm_f_bias': jnp.linspace(3.0, 6.0, MLSTM_HEADS) + nrm(ks[18], (DEPTH, 2, MLSTM_HEADS), 0.1),
        'mlstm_norm_g': 1.0 + nrm(ks[19], (DEPTH, D_MLSTM), 0.02),
        'w_ssd_out': nrm(ks[20], (DEPTH, D_SSD, D_MODEL), D_SSD ** -0.5),
        'w_mlstm_out': nrm(ks[21], (DEPTH, D_MLSTM, D_MODEL), D_MLSTM ** -0.5),
        'w_out': nrm(ks[22], (DEPTH, D_MODEL, D_MODEL), D_MODEL ** -0.5),
        'router_w': nrm(ks[23], (DEPTH, D_MODEL, N_EXPERTS), D_MODEL ** -0.5),
        'router_bias': nrm(ks[24], (DEPTH, N_EXPERTS), 0.01),
        'moe_w_gate': nrm(ks[25], (DEPTH, N_EXPERTS, D_MODEL, D_EXPERT), D_MODEL ** -0.5),
        'moe_w_up': nrm(ks[26], (DEPTH, N_EXPERTS, D_MODEL, D_EXPERT), D_MODEL ** -0.5),
        'moe_w_down': nrm(ks[27], (DEPTH, N_EXPERTS, D_EXPERT, D_MODEL), D_EXPERT ** -0.5),
        'shared_w_gate': nrm(ks[28], (DEPTH, D_MODEL, D_SHARED), D_MODEL ** -0.5),
        'shared_w_up': nrm(ks[29], (DEPTH, D_MODEL, D_SHARED), D_MODEL ** -0.5),
        'shared_w_down': nrm(ks[30], (DEPTH, D_SHARED, D_MODEL), D_SHARED ** -0.5),
        'norm_final_g': 1.0 + nrm(ks[31], (D_MODEL,), 0.02),
    }


def reference(x, c, ctx, c_ctx, ada_w, ada_b, norm_mix_g, norm_ffn_g, w_in, conv_xbc_w, conv_xbc_b, ssd_dt_bias,
              ssd_a_log, ssd_d, ssd_norm_g, conv_qk_w, conv_qk_b, mlstm_i_bias, mlstm_f_bias, mlstm_norm_g,
              w_ssd_out, w_mlstm_out, w_out, router_w, router_bias, moe_w_gate, moe_w_up, moe_w_down,
              shared_w_gate, shared_w_up, shared_w_down, norm_final_g):
    rows = x.shape[1] // GRID_W
    cond_lat = jax.nn.silu(c)
    cond_ctx = jax.nn.silu(c_ctx)[None]
    for l in range(DEPTH):
        last = l == DEPTH - 1
        lp = {
            'w_in': w_in[l], 'conv_xbc_w': conv_xbc_w[l], 'conv_xbc_b': conv_xbc_b[l],
            'ssd_dt_bias': ssd_dt_bias[l], 'ssd_a_log': ssd_a_log[l], 'ssd_d': ssd_d[l], 'ssd_norm_g': ssd_norm_g[l],
            'conv_qk_w': conv_qk_w[l], 'conv_qk_b': conv_qk_b[l], 'mlstm_i_bias': mlstm_i_bias[l],
            'mlstm_f_bias': mlstm_f_bias[l], 'mlstm_norm_g': mlstm_norm_g[l],
            'w_ssd_out': w_ssd_out[l], 'w_mlstm_out': w_mlstm_out[l], 'w_out': w_out[l],
            'router_w': router_w[l], 'router_bias': router_bias[l],
            'moe_w_gate': moe_w_gate[l], 'moe_w_up': moe_w_up[l], 'moe_w_down': moe_w_down[l],
            'shared_w_gate': shared_w_gate[l], 'shared_w_up': shared_w_up[l], 'shared_w_down': shared_w_down[l],
        }
        mod_lat = jnp.split((cond_lat @ ada_w[l] + ada_b[l])[:, None], 6, axis=-1)
        mod_ctx = jnp.split((cond_ctx @ ada_w[l] + ada_b[l])[:, None], 6, axis=-1)
        p_ctx = prepare_mixer_inputs(modulate(ctx, norm_mix_g[l], mod_ctx[0], mod_ctx[1]), lp, 1)
        y_ssd_c, h_m_c, ctx_states = bidirectional_scans(p_ctx, lp, zero_states(ctx.shape[0]), not last)
        p_lat = prepare_mixer_inputs(modulate(x, norm_mix_g[l], mod_lat[0], mod_lat[1]), lp, rows)
        y_ssd, h_m, _ = bidirectional_scans(p_lat, lp, ctx_states, True)
        x = x + mod_lat[2] * merge_branches(p_lat, y_ssd, h_m, lp)
        x = x + mod_lat[5] * moe_ffn(modulate(x, norm_ffn_g[l], mod_lat[3], mod_lat[4]), lp)
        if not last:
            ctx = ctx + mod_ctx[2] * merge_branches(p_ctx, y_ssd_c, h_m_c, lp)
            ctx = ctx + mod_ctx[5] * moe_ffn(modulate(ctx, norm_ffn_g[l], mod_ctx[3], mod_ctx[4]), lp)
    return rmsnorm(x, norm_final_g)
```

```cpp
#ifndef HOST_EMU
#include <hip/hip_runtime.h>
#include <hip/hip_cooperative_groups.h>
#include <cstdio>
#include <cstdint>
#define DEV __device__ __forceinline__
#define LAS __attribute__((address_space(3)))
#define TID ((int)threadIdx.x)
#define BID ((int)blockIdx.x)
#define NBLK ((int)gridDim.x)
#define SYNC() __syncthreads()
#define EXPF(x) __expf(x)
#define RCPF(x) __builtin_amdgcn_rcpf(x)
#define RSQF(x) __builtin_amdgcn_rsqf(x)
#define ATOMIC_ADD_I(p, v) atomicAdd((p), (v))
#define RFL(x) __builtin_amdgcn_readfirstlane(x)
#define SCHED_FENCE() __builtin_amdgcn_sched_barrier(0)
#define MEM_FENCE() asm volatile("" ::: "memory")
#endif

#ifndef CFG_SEQ
#define CFG_SEQ 16384
#endif
#ifndef CFG_NEXP
#define CFG_NEXP 256
#endif
constexpr int DM = 1024, BATCH = 2, SEQ = CFG_SEQ, CTXL = 256, CHUNK = 128;
constexpr int NLAT = BATCH * SEQ, NCTX = BATCH * CTXL, NROWS = NLAT + NCTX;
constexpr int NCH = SEQ / CHUNK, NCHC = CTXL / CHUNK, NCHT = NCH + NCHC;
constexpr int SSD_H = 16, SSD_P = 64, SSD_N = 128, D_XBC = 1536;
constexpr int ML_H = 8, ML_DV = 128, ML_DK = 64, ML_PP = 144;
constexpr int NEXP = CFG_NEXP, TOPK = 8, TOPKG = 4, DEXP = 256, EPL = NEXP / 64;
constexpr int NASG = NLAT * TOPK, MAXSLOT = NASG + NEXP * 256, HALFE = NEXP / 2;
constexpr int NIN = 7936;
constexpr float EPS = 1e-6f;
constexpr int NTHR = 512;

typedef unsigned short bf16_t;
typedef short bf16x8 __attribute__((ext_vector_type(8)));
typedef float f32x4 __attribute__((ext_vector_type(4)));
typedef unsigned u32x4 __attribute__((ext_vector_type(4)));
typedef unsigned u32x2 __attribute__((ext_vector_type(2)));

constexpr size_t alignup(size_t x) { return (x + 4095) & ~(size_t)4095; }
constexpr size_t WS_CTL = 0;
constexpr size_t CTL_BYTES = 65536;
constexpr size_t WS_MOD = WS_CTL + CTL_BYTES;
constexpr size_t WS_DECS = WS_MOD + alignup(3 * 6144 * 4);
constexpr size_t WS_DECM = WS_DECS + alignup((size_t)BATCH * 2 * NCHT * 16 * 4);
constexpr size_t WS_WIN = WS_DECM + alignup((size_t)BATCH * 2 * NCHT * 8 * 4);
constexpr size_t WS_WSO = WS_WIN + alignup((size_t)NIN * 1024 * 2);
constexpr size_t WS_WMO = WS_WSO + alignup((size_t)1024 * 1024 * 2);
constexpr size_t WS_WOUT = WS_WMO + alignup((size_t)1024 * 1024 * 2);
constexpr size_t WS_WRS = WS_WOUT + alignup((size_t)1024 * 1024 * 2);
constexpr size_t WS_WSD = WS_WRS + alignup((size_t)768 * 1024 * 2);
constexpr size_t WS_XN = WS_WSD + alignup((size_t)1024 * 256 * 2);
constexpr size_t WS_STAGE = WS_XN + alignup((size_t)NROWS * 1024 * 2);
constexpr size_t WS_Z = WS_STAGE;
constexpr size_t WS_XBC = WS_Z + alignup((size_t)NROWS * 1024 * 2);
constexpr size_t WS_QK = WS_XBC + alignup((size_t)NROWS * 1536 * 2);
constexpr size_t WS_V = WS_QK + alignup((size_t)NROWS * 1024 * 2);
constexpr size_t WS_O = WS_V + alignup((size_t)NROWS * 1024 * 2);
constexpr size_t WS_MG = WS_O + alignup((size_t)NROWS * 1024 * 2);
constexpr size_t WS_DTG = WS_MG + alignup((size_t)NROWS * 2048 * 2);
constexpr size_t WS_STS = WS_DTG + alignup((size_t)NROWS * 64 * 4);
constexpr size_t STS_CH = (size_t)SSD_H * SSD_P * SSD_N;
constexpr size_t WS_STM = WS_STS + alignup((size_t)BATCH * 2 * NCHT * STS_CH * 2);
constexpr size_t STM_CH = (size_t)ML_H * ML_PP * ML_DK;
constexpr size_t WS_YPRE = WS_STM + alignup((size_t)BATCH * 2 * NCHT * STM_CH * 2);
constexpr size_t WS_HP = WS_YPRE + alignup((size_t)NLAT * 1024 * 2);
constexpr size_t WS_SSQ = WS_HP + alignup((size_t)NLAT * 1024 * 2);
constexpr size_t WS_MIX_END = WS_SSQ + alignup((size_t)NLAT * 16 * 4);
constexpr size_t WS_M1 = WS_XBC;
constexpr size_t WS_MERGED = WS_QK;
constexpr size_t WS_W1T = WS_STAGE;
constexpr size_t WS_W2T = WS_W1T + alignup((size_t)HALFE * 512 * 1024 * 2);
constexpr size_t WS_H = WS_W2T + alignup((size_t)HALFE * 1024 * 256 * 2);
constexpr size_t WS_Y = WS_H + alignup((size_t)MAXSLOT * 256 * 2);
constexpr size_t WS_LOG = WS_Y + alignup((size_t)NASG * 1024 * 2);
constexpr size_t WS_HS = WS_LOG + alignup((size_t)NLAT * NEXP * 4);
constexpr size_t WS_ASGE = WS_HS + alignup((size_t)NLAT * 256 * 2);
constexpr size_t WS_ASGR = WS_ASGE + alignup((size_t)NASG * 4);
constexpr size_t WS_ASGW = WS_ASGR + alignup((size_t)NASG * 4);
constexpr size_t WS_STOK = WS_ASGW + alignup((size_t)NASG * 4);
constexpr size_t WS_SDST = WS_STOK + alignup((size_t)MAXSLOT * 4);
constexpr size_t WS_SW = WS_SDST + alignup((size_t)MAXSLOT * 4);
constexpr size_t WS_TEXP = WS_SW + alignup((size_t)MAXSLOT * 4);
constexpr size_t WS_MOE_END = WS_TEXP + alignup((size_t)(MAXSLOT / 256) * 4);
constexpr size_t WS_NEED = WS_MIX_END > WS_MOE_END ? WS_MIX_END : WS_MOE_END;

constexpr int LDS_BYTES = 147456;
constexpr int NPHASE = 20;

struct Params { const float* in[32]; float* out; unsigned char* ws; int ph_lo, ph_hi; };

DEV unsigned f2bf(float f) { unsigned u = __builtin_bit_cast(unsigned, f); return (u + 0x7fffu + ((u >> 16) & 1u)) >> 16; }
DEV float bf2f(unsigned h) { return __builtin_bit_cast(float, (h & 0xffffu) << 16); }
DEV unsigned pk2(float lo, float hi) { return f2bf(lo) | (f2bf(hi) << 16); }
DEV float bflo(unsigned w) { return __builtin_bit_cast(float, w << 16); }
DEV float bfhi(unsigned w) { return __builtin_bit_cast(float, w & 0xffff0000u); }
DEV float sigmoidf_(float x) { return RCPF(1.f + EXPF(-x)); }
DEV float siluf_(float x) { return x * RCPF(1.f + EXPF(-x)); }
DEV float softplusf_(float x) { return x > 20.f ? x : log1pf(EXPF(x)); }
DEV float logsigmoidf_(float x) { return -softplusf_(-x); }
DEV float wave_sum(float v) {
#pragma unroll
    for (int o = 1; o < 64; o <<= 1) v += __shfl_xor(v, o);
    return v;
}
DEV float wave_incl_scan(float v, int lane) {
#pragma unroll
    for (int d = 1; d < 64; d <<= 1) { float t = __shfl_up(v, d); if (lane >= d) v += t; }
    return v;
}
#ifndef HOST_EMU
DEV f32x4 mfma16(bf16x8 a, bf16x8 b, f32x4 c) { return __builtin_amdgcn_mfma_f32_16x16x32_bf16(a, b, c, 0, 0, 0); }
#endif
DEV f32x4 lds_tile(const LAS bf16_t* A, int lda, const LAS bf16_t* B, int ldb, int K, int lane, f32x4 acc) {
    const LAS bf16_t* ap = A + (lane & 15) * lda + 8 * (lane >> 4);
    const LAS bf16_t* bp = B + (lane & 15) * ldb + 8 * (lane >> 4);
    for (int k = 0; k < K; k += 32) {
        bf16x8 a = *(const LAS bf16x8*)(ap + k); bf16x8 b = *(const LAS bf16x8*)(bp + k);
        acc = mfma16(a, b, acc);
    }
    return acc;
}

namespace pg8 {
constexpr int BM = 256, BK = 64, HALF = 128, HTB = HALF * BK * 2, STAGE_BYTES = 8 * HTB, NXCD = 8, WGM = 8;
struct Unit { int pm, pn; };
struct Gemm { const bf16_t* A; const bf16_t* Bt; int M, N, K; };

DEV int lds_byte(int r, int c) { const int st = (r >> 4) * 2 + (c >> 5), rr = r & 15, cc = c & 31, ob = rr * 64 + cc * 2; return st * 1024 + (ob ^ (((ob >> 9) & 1) << 5)); }
DEV void stage_rc(int b, int& R, int& C) { const int st = b / 1024, sb = b % 1024, swz = sb ^ (((sb >> 9) & 1) << 5); R = (st >> 1) * 16 + swz / 64; C = (st & 1) * 32 + (swz % 64) / 2; }
DEV int perm32(int rho) { const int n = rho >> 4, i = rho & 15; return 8 * (i >> 2) + 4 * n + (i & 3); }

struct StaticOrder {
    static constexpr bool GATHER = false;
    int nM, nN, nwg, G, c;
    DEV void init(int M, int N, int G_, int c_) { nM = M / BM; nN = N / BM; nwg = nM * nN; G = G_; c = c_; }
    DEV bool next(int i, Unit& u) const {
        const long L = (long)i * G + c; if (L >= nwg) return false;
        int wgid = (int)L; { const int q = nwg / NXCD, r = nwg % NXCD, xcd = wgid % NXCD, off = wgid / NXCD; wgid = (xcd < r ? xcd * (q + 1) : r * (q + 1) + (xcd - r) * q) + off; }
        const int nig = WGM * nN, gid = wgid / nig, fm = gid * WGM, gsz = (nM - fm) < WGM ? (nM - fm) : WGM;
        u.pm = fm + ((wgid % nig) % gsz); u.pn = (wgid % nig) / gsz; return true;
    }
    DEV unsigned arow(const Unit& u, int r) const { return (unsigned)(u.pm * BM + r); }
    DEV const char* bbase(const Gemm& g, const Unit& u) const { return (const char*)g.Bt + (size_t)u.pn * BM * g.K * 2; }
};
template <bool GATHER_> struct ExpertOrder {
    static constexpr bool GATHER = GATHER_;
    int tlo, thi, np, G, c; const int* texp; int e0; size_t estride  ; const int* rowmap;
    DEV bool next(int i, Unit& u) const {
        const long L = (long)i * G + c; const long n = (long)(thi - tlo) * np; if (L >= n) return false;
        u.pm = tlo + (int)(L / np); u.pn = (int)(L % np); return true;
    }
    DEV unsigned arow(const Unit& u, int r) const { return GATHER_ ? (unsigned)rowmap[u.pm * BM + r] : (unsigned)(u.pm * BM + r); }
    DEV const char* bbase(const Gemm& g, const Unit& u) const { const int e = texp[u.pm] - e0; return (const char*)(g.Bt + (size_t)e * estride) + (size_t)u.pn * BM * g.K * 2; }
};

#ifndef HOST_EMU
#define PG8_LAS __attribute__((address_space(3)))
template <class Epi, class Sched>
__device__ __forceinline__ void gemm_phase(PG8_LAS unsigned char* lds, const Gemm g, const Sched& S, const Epi& E) {
    int tid_ = threadIdx.x; asm volatile("" : "+v"(tid_));
    const int tid = tid_, wid = __builtin_amdgcn_readfirstlane(tid >> 6), lane = tid & 63, wr = wid >> 2, wc = wid & 3, fr = lane & 15, fq = lane >> 4;
    int Kop = g.K; asm volatile("" : "+s"(Kop));
    const int K = Kop, nt = K / BK;
    int RA[2], CA[2]; unsigned voffB[2];
#pragma unroll
    for (int i = 0; i < 2; ++i) { int R, C; stage_rc(tid * 16 + i * 8192, R, C); const int Rb = Epi::PERM ? ((R & ~31) + perm32(R & 31)) : R;
        RA[i] = R; CA[i] = C; voffB[i] = (unsigned)(Rb * K + C) * 2u; }
    const size_t kstep = (size_t)(BK * 2);
    const size_t hstep = (size_t)HALF * K * 2;
    const unsigned ldsw = (unsigned)wid * 1024u;
    const int aoff = lds_byte(wr * 64 + fr, fq * 8), boff = lds_byte(wc * 32 + fr, fq * 8);
    const char* const Ab = (const char*)g.A;
#define PG8_SA(b, h) (((b) * 2 + (h)) * HTB)
#define PG8_SB(b, h) ((4 + (b) * 2 + (h)) * HTB)
#define PG8_STAGE(bufoff, gbase, voff) do { _Pragma("unroll") for (int _i = 0; _i < 2; ++_i) \
        __builtin_amdgcn_global_load_lds((const unsigned*)((const char*)(gbase) + (voff)[_i]), (PG8_LAS unsigned*)(lds + (bufoff) + ldsw + _i * 8192), 16, 0, 0); } while (0)
#define PG8_LDA(dst, b, h) do { _Pragma("unroll") for (int m = 0; m < 4; ++m) _Pragma("unroll") for (int k = 0; k < 2; ++k) dst[m][k] = *(const PG8_LAS bf16x8*)(lds + PG8_SA(b, h) + aoff + m * 2048 + k * 1024); } while (0)
#define PG8_LDB(dst, b, h) do { _Pragma("unroll") for (int n = 0; n < 2; ++n) _Pragma("unroll") for (int k = 0; k < 2; ++k) dst[n][k] = *(const PG8_LAS bf16x8*)(lds + PG8_SB(b, h) + boff + n * 2048 + k * 1024); } while (0)
#define PG8_MMA(ai, bj, At, Bt) do { __builtin_amdgcn_s_setprio(1); _Pragma("unroll") for (int m = 0; m < 4; ++m) _Pragma("unroll") for (int n = 0; n < 2; ++n) _Pragma("unroll") for (int k = 0; k < 2; ++k) \
        acc[ai][bj][m][n] = __builtin_amdgcn_mfma_f32_16x16x32_bf16(Bt[n][k], At[m][k], acc[ai][bj][m][n], 0, 0, 0); __builtin_amdgcn_s_setprio(0); } while (0)
#define PG8_WAIT_V(n) asm volatile("s_waitcnt vmcnt(" #n ")" ::: "memory")
#define PG8_WAIT_L(n) asm volatile("s_waitcnt lgkmcnt(" #n ")" ::: "memory")
#define PG8_BAR __builtin_amdgcn_s_barrier()
#define PG8_SCHED __builtin_amdgcn_sched_barrier(0)
#define PG8_VOFFA(dst, u) do { _Pragma("unroll") for (int _h = 0; _h < 2; ++_h) _Pragma("unroll") for (int _i = 0; _i < 2; ++_i) \
        dst[_h][_i] = (S.arow(u, _h * HALF + RA[_i]) * (unsigned)K + (unsigned)CA[_i]) * 2u; } while (0)
    Unit cur, nxt; int ui = 0;
    if (!S.next(0, cur)) return;
    f32x4 acc[2][2][4][2];
#pragma unroll
    for (int a = 0; a < 2; ++a)
#pragma unroll
        for (int b = 0; b < 2; ++b)
#pragma unroll
            for (int m = 0; m < 4; ++m)
#pragma unroll
                for (int n = 0; n < 2; ++n) acc[a][b][m][n] = (f32x4){0.f, 0.f, 0.f, 0.f};
    bf16x8 At[4][2], B0[2][2], B1[2][2];
    constexpr bool GA = Sched::GATHER;
    unsigned vAc[2][2], vAn[2][2];
    unsigned voffA[2];
#pragma unroll
    for (int i = 0; i < 2; ++i) voffA[i] = (unsigned)(RA[i] * K + CA[i]) * 2u;
    const size_t tstep = 2 * hstep;
    const char* cA = Ab;
    if constexpr (GA) { PG8_VOFFA(vAc, cur); } else { cA = Ab + (size_t)S.arow(cur, 0) * K * 2; (void)tstep; }
    const char* cB = S.bbase(g, cur);
#define PG8_STAGE_A(bufoff, h, ubase, vg) do { if constexpr (GA) { PG8_STAGE(bufoff, ubase, vg[h]); } else { PG8_STAGE(bufoff, (ubase) + (h) * hstep, voffA); } } while (0)
    PG8_STAGE(PG8_SB(0, 0), cB, voffB); PG8_STAGE(PG8_SB(0, 1), cB + hstep, voffB); PG8_STAGE_A(PG8_SA(0, 0), 0, cA, vAc); PG8_STAGE_A(PG8_SA(0, 1), 1, cA, vAc);
    if (wr == 1) PG8_BAR;
    PG8_WAIT_V(2); PG8_BAR;
    PG8_STAGE(PG8_SB(1, 0), cB + kstep, voffB); PG8_STAGE_A(PG8_SA(1, 0), 0, cA + kstep, vAc); PG8_STAGE(PG8_SB(1, 1), cB + hstep + kstep, voffB);
    PG8_WAIT_V(6); PG8_BAR;
    for (;;) {
        const bool has_next = S.next(ui + 1, nxt);
        const char* nB = cB; const char* nA = cA;
        if (has_next) { nB = S.bbase(g, nxt); if constexpr (GA) { PG8_VOFFA(vAn, nxt); } else { nA = Ab + (size_t)S.arow(nxt, 0) * K * 2; } }
        else if constexpr (GA) {
#pragma unroll
            for (int _h = 0; _h < 2; ++_h)
#pragma unroll
                for (int _i = 0; _i < 2; ++_i) vAn[_h][_i] = vAc[_h][_i];
        }
#pragma unroll 1
        for (int t = 0; t < nt; t += 2) {
            const bool last = (t == nt - 2);
            const char* a1 = cA + (size_t)(t + 1) * kstep;
            const char* a2 = last ? nA : cA + (size_t)(t + 2) * kstep; const char* b2 = last ? nB : cB + (size_t)(t + 2) * kstep;
            const char* a3 = a2 + kstep; const char* b3 = b2 + kstep;
            unsigned v2[2][2];
            if constexpr (GA) {
#pragma unroll
                for (int _h = 0; _h < 2; ++_h)
#pragma unroll
                    for (int _i = 0; _i < 2; ++_i) v2[_h][_i] = last ? vAn[_h][_i] : vAc[_h][_i];
            }
            PG8_LDB(B0, 0, 0); PG8_LDB(B1, 0, 1); PG8_SCHED; PG8_LDA(At, 0, 0); PG8_STAGE_A(PG8_SA(1, 1), 1, a1, vAc);
            PG8_WAIT_V(8); PG8_WAIT_L(0); PG8_BAR; PG8_MMA(0, 0, At, B0); PG8_MMA(0, 1, At, B1); PG8_BAR; PG8_SCHED;
            PG8_LDA(At, 0, 1); PG8_STAGE(PG8_SB(0, 0), b2, voffB); PG8_STAGE(PG8_SB(0, 1), b2 + hstep, voffB); PG8_STAGE_A(PG8_SA(0, 0), 0, a2, v2);
            PG8_WAIT_V(8); PG8_WAIT_L(0); PG8_BAR; PG8_MMA(1, 0, At, B0); PG8_MMA(1, 1, At, B1); PG8_BAR; PG8_SCHED;
            PG8_LDB(B0, 1, 0); PG8_LDB(B1, 1, 1); PG8_SCHED; PG8_LDA(At, 1, 0); PG8_STAGE_A(PG8_SA(0, 1), 1, a2, v2);
            PG8_WAIT_V(8); PG8_WAIT_L(0); PG8_BAR; PG8_MMA(0, 0, At, B0); PG8_MMA(0, 1, At, B1); PG8_BAR; PG8_SCHED;
            PG8_LDA(At, 1, 1); PG8_STAGE(PG8_SB(1, 0), b3, voffB); PG8_STAGE(PG8_SB(1, 1), b3 + hstep, voffB); PG8_STAGE_A(PG8_SA(1, 0), 0, a3, v2);
            PG8_WAIT_V(8); PG8_WAIT_L(0); PG8_BAR; PG8_MMA(1, 0, At, B0); PG8_MMA(1, 1, At, B1); PG8_BAR; PG8_SCHED;
        }
        if (wr == 0) PG8_BAR;
        E(acc, cur, wr, wc, fr, fq);
        if (!has_next) break;
#pragma unroll
        for (int a = 0; a < 2; ++a)
#pragma unroll
            for (int b = 0; b < 2; ++b)
#pragma unroll
                for (int m = 0; m < 4; ++m)
#pragma unroll
                    for (int n = 0; n < 2; ++n) acc[a][b][m][n] = (f32x4){0.f, 0.f, 0.f, 0.f};
        cur = nxt; cB = nB; cA = nA; ++ui;
        if constexpr (GA) {
#pragma unroll
            for (int _h = 0; _h < 2; ++_h)
#pragma unroll
                for (int _i = 0; _i < 2; ++_i) vAc[_h][_i] = vAn[_h][_i];
        }
        if (wr == 1) PG8_BAR;
    }
    PG8_WAIT_V(0);
    PG8_BAR;
#undef PG8_SA
#undef PG8_SB
#undef PG8_STAGE
#undef PG8_LDA
#undef PG8_LDB
#undef PG8_MMA
#undef PG8_WAIT_V
#undef PG8_WAIT_L
#undef PG8_BAR
#undef PG8_SCHED
#undef PG8_VOFFA
#undef PG8_STAGE_A
}
#endif
}

struct Frame {
    LAS unsigned char* lds;
    int tid, lane, wave, G, bid;
    const Params* pp; float* out; unsigned char* ws;
};
#define WSP(T, off) ((T*)(F.ws + (off)))

DEV void transpose_item(const float* W, int K, int N, bf16_t* WT, int dst_row, int k0, int n0, LAS float* scr, int lane) {
#pragma unroll 8
    for (int i = 0; i < 32; ++i) { const int kk = 2 * i + (lane >> 5); scr[kk * 33 + (lane & 31)] = W[(size_t)(k0 + kk) * N + n0 + (lane & 31)]; }
    SYNC();
    const int c = lane & 7;
#pragma unroll
    for (int j = 0; j < 4; ++j) { const int n = (lane >> 3) + 8 * j; const LAS float* s = scr + (8 * c) * 33 + n;
        u32x4 o; o.x = pk2(s[0 * 33], s[1 * 33]); o.y = pk2(s[2 * 33], s[3 * 33]); o.z = pk2(s[4 * 33], s[5 * 33]); o.w = pk2(s[6 * 33], s[7 * 33]);
        *(u32x4*)(WT + (size_t)(dst_row + n) * K + k0 + 8 * c) = o; }
    SYNC();
}
DEV int map_in(int s) {
    if (s < 2560) return s;
    if (s < 2592) return 7680 + (s - 2560);
    if (s < 4640) return s - 32;
    if (s < 4672) return 7712 + (s - 4640);
    return s - 64;
}
DEV int map_gu(int s, int up) { return (s >> 7) * 256 + up * 128 + (s & 127); }
DEV void transpose_job(Frame& F, const float* W, int K, int N, bf16_t* WT, int mode  , int row_base, int item, bool active) {
    LAS float* scr = (LAS float*)(F.lds) + F.wave * (64 * 33);
    if (active) {
        const int nblk = N / 32, kb = item / nblk, nb = item % nblk, n0 = nb * 32;
        int d = n0; if (mode == 1) d = map_in(n0); else if (mode == 2) d = map_gu(n0, 0); else if (mode == 3) d = map_gu(n0, 1);
        transpose_item(W, K, N, WT, row_base + d, kb * 64, n0, scr, F.lane);
    } else { SYNC(); SYNC(); }
}
DEV void p0_small(Frame& F) {
    const float* c = F.pp->in[1]; const float* cctx = F.pp->in[3]; const float* aw = F.pp->in[4]; const float* ab = F.pp->in[5];
    float* mod = WSP(float, WS_MOD);
    LAS float* red = (LAS float*)F.lds;
    for (int cb = F.bid; cb < 192; cb += F.G) {
        const int cl = F.tid & 31, kg = F.tid >> 5, col = cb * 32 + cl;
        float s0 = 0.f, s1 = 0.f, s2 = 0.f;
        for (int k = kg * 64; k < kg * 64 + 64; ++k) { const float w = aw[(size_t)k * 6144 + col]; s0 += siluf_(c[k]) * w; s1 += siluf_(c[1024 + k]) * w; s2 += siluf_(cctx[k]) * w; }
        red[(kg * 32 + cl) * 3 + 0] = s0; red[(kg * 32 + cl) * 3 + 1] = s1; red[(kg * 32 + cl) * 3 + 2] = s2;
        SYNC();
        if (F.tid < 96) { const int v = F.tid / 32, cc = F.tid % 32; float s = 0.f; for (int q = 0; q < 16; ++q) s += red[(q * 32 + cc) * 3 + v]; mod[v * 6144 + cb * 32 + cc] = s + ab[cb * 32 + cc]; }
        SYNC();
    }
    const int gw = F.bid * 8 + F.wave, NGW = F.G * 8;
#define P0_JOB(Wp, Kv, Nv, WTp, modev, rb) do { const int nitems_ = ((Kv) / 64) * ((Nv) / 32); const int rounds_ = (nitems_ + NGW - 1) / NGW; \
        for (int r_ = 0; r_ < rounds_; ++r_) { const int it_ = r_ * NGW + gw; transpose_job(F, (Wp), (Kv), (Nv), (WTp), (modev), (rb), it_, it_ < nitems_); } } while (0)
    P0_JOB(F.pp->in[8], 1024, 7744, WSP(bf16_t, WS_WIN), 1, 0);
    P0_JOB(F.pp->in[20], 1024, 1024, WSP(bf16_t, WS_WSO), 0, 0);
    P0_JOB(F.pp->in[21], 1024, 1024, WSP(bf16_t, WS_WMO), 0, 0);
    P0_JOB(F.pp->in[22], 1024, 1024, WSP(bf16_t, WS_WOUT), 0, 0);
    P0_JOB(F.pp->in[23], 1024, NEXP, WSP(bf16_t, WS_WRS), 0, 0);
    P0_JOB(F.pp->in[28], 1024, 256, WSP(bf16_t, WS_WRS), 2, 256);
    P0_JOB(F.pp->in[29], 1024, 256, WSP(bf16_t, WS_WRS), 3, 256);
    P0_JOB(F.pp->in[30], 256, 1024, WSP(bf16_t, WS_WSD), 0, 0);
#undef P0_JOB
}
DEV void p_expert_weights(Frame& F, int hf) {
    const int gw = F.bid * 8 + F.wave, NGW = F.G * 8;
    const int per = 384, nitems = HALFE * per, rounds = (nitems + NGW - 1) / NGW;
    for (int r = 0; r < rounds; ++r) {
        const int it = r * NGW + gw; const bool act = it < nitems;
        const int el = act ? it / per : 0, j = act ? it % per : 0, e = hf * HALFE + el;
        if (j < 128) transpose_job(F, F.pp->in[25] + (size_t)e * 1024 * 256, 1024, 256, WSP(bf16_t, WS_W1T) + (size_t)el * 512 * 1024, 2, 0, j, act);
        else if (j < 256) transpose_job(F, F.pp->in[26] + (size_t)e * 1024 * 256, 1024, 256, WSP(bf16_t, WS_W1T) + (size_t)el * 512 * 1024, 3, 0, j - 128, act);
        else transpose_job(F, F.pp->in[27] + (size_t)e * 256 * 1024, 256, 1024, WSP(bf16_t, WS_W2T) + (size_t)el * 1024 * 256, 0, 0, j - 256, act);
    }
}

DEV void norm_mod_row(const float* xrow, const float* g, const float* shift, const float* scale, bf16_t* orow, int lane) {
    const f32x4* xr = (const f32x4*)xrow + lane;
    f32x4 v[4]; float s = 0.f;
#pragma unroll
    for (int j = 0; j < 4; ++j) { v[j] = xr[64 * j]; s += (v[j].x * v[j].x + v[j].y * v[j].y) + (v[j].z * v[j].z + v[j].w * v[j].w); }
    const float rstd = RSQF(wave_sum(s) * (1.f / DM) + EPS);
    u32x2* o8 = (u32x2*)orow + lane;
#pragma unroll
    for (int j = 0; j < 4; ++j) {
        const f32x4 gg = ((const f32x4*)g)[lane + 64 * j], sh = ((const f32x4*)shift)[lane + 64 * j], sc = ((const f32x4*)scale)[lane + 64 * j];
        const f32x4 y = v[j] * rstd * gg * (sc + 1.0f) + sh;
        u32x2 w; w.x = pk2(y.x, y.y); w.y = pk2(y.z, y.w); o8[64 * j] = w;
    }
}
DEV void p1_xn(Frame& F) {
    const float* mod = WSP(float, WS_MOD); bf16_t* XN = WSP(bf16_t, WS_XN);
    const int gw = F.bid * 8 + F.wave, NGW = F.G * 8;
    for (int r = gw; r < NROWS; r += NGW) {
        const float* src = r < NLAT ? F.pp->in[0] + (size_t)r * DM : F.pp->in[2] + (size_t)(r - NLAT) * DM;
        const int mv = r < NLAT ? r / SEQ : 2;
        norm_mod_row(src, F.pp->in[6], mod + mv * 6144, mod + mv * 6144 + 1024, XN + (size_t)r * DM, F.lane);
    }
}
DEV void p10_xn2(Frame& F) {
    const float* mod = WSP(float, WS_MOD); bf16_t* XN = WSP(bf16_t, WS_XN);
    const int gw = F.bid * 8 + F.wave, NGW = F.G * 8;
    for (int r = gw; r < NLAT; r += NGW) {
        const int mv = r / SEQ;
        norm_mod_row(F.out + (size_t)r * DM, F.pp->in[7], mod + mv * 6144 + 3 * 1024, mod + mv * 6144 + 4 * 1024, XN + (size_t)r * DM, F.lane);
    }
}

typedef f32x4 AccT[2][2][4][2];
DEV u32x4 pack8(f32x4 a, f32x4 b) { u32x4 w; w.x = pk2(a.x, a.y); w.y = pk2(a.z, a.w); w.z = pk2(b.x, b.y); w.w = pk2(b.z, b.w); return w; }
DEV f32x4 sig4(f32x4 a) { f32x4 r; r.x = sigmoidf_(a.x); r.y = sigmoidf_(a.y); r.z = sigmoidf_(a.z); r.w = sigmoidf_(a.w); return r; }
DEV void unpack8(u32x4 w, f32x4& a, f32x4& b) { a.x = bflo(w.x); a.y = bfhi(w.x); a.z = bflo(w.y); a.w = bfhi(w.y); b.x = bflo(w.z); b.y = bfhi(w.z); b.z = bflo(w.w); b.w = bfhi(w.w); }

struct EpiInProj {
    static constexpr bool PERM = true;
    bf16_t *Z, *XBC, *QK, *V, *O, *MG; float* DTG;
    DEV void operator()(const AccT& acc, const pg8::Unit& u, int wr, int wc, int fr, int fq) const {
        const int row0 = u.pm * 256 + wr * 64 + fr; const int t = u.pn;
        if (t < 30) {
            bf16_t* base; int ldc, colt; bool act = false;
            if (t < 4) { base = Z; ldc = 1024; colt = t * 256; }
            else if (t < 10) { base = XBC; ldc = 1536; colt = (t - 4) * 256; }
            else if (t < 14) { base = QK; ldc = 1024; colt = (t - 10) * 256; }
            else if (t < 18) { base = V; ldc = 1024; colt = (t - 14) * 256; }
            else if (t < 22) { base = O; ldc = 1024; colt = (t - 18) * 256; act = true; }
            else { base = MG; ldc = 2048; colt = (t - 22) * 256; act = true; }
            const int col0 = colt + wc * 32 + 8 * fq;
#pragma unroll
            for (int ai = 0; ai < 2; ++ai)
#pragma unroll
                for (int m = 0; m < 4; ++m) { bf16_t* rowp = base + (size_t)(row0 + ai * 128 + m * 16) * ldc + col0;
#pragma unroll
                    for (int bj = 0; bj < 2; ++bj) { f32x4 v0 = acc[ai][bj][m][0], v1 = acc[ai][bj][m][1];
                        if (act) { v0 = sig4(v0); v1 = sig4(v1); }
                        *(u32x4*)(rowp + bj * 128) = pack8(v0, v1); } }
        } else if (wc < 2) {
#pragma unroll
            for (int ai = 0; ai < 2; ++ai)
#pragma unroll
                for (int m = 0; m < 4; ++m)
#pragma unroll
                    for (int n = 0; n < 2; ++n) {
                        const int c0 = 32 * wc + 8 * fq + 4 * n; const f32x4 a = acc[ai][0][m][n]; f32x4 r;
#pragma unroll
                        for (int i = 0; i < 4; ++i) r[i] = a[i];
                        *(f32x4*)(DTG + (size_t)(row0 + ai * 128 + m * 16) * 64 + c0) = r; }
        }
    }
};
struct EpiG1 {
    static constexpr bool PERM = true;
    bf16_t* M1; const bf16_t* MG; const float* SSQ;
    DEV void operator()(const AccT& acc, const pg8::Unit& u, int wr, int wc, int fr, int fq) const {
        const int row0 = u.pm * 256 + wr * 64 + fr, col0 = u.pn * 256 + wc * 32 + 8 * fq;
#pragma unroll
        for (int ai = 0; ai < 2; ++ai)
#pragma unroll
            for (int m = 0; m < 4; ++m) { const size_t row = (size_t)(row0 + ai * 128 + m * 16);
                const f32x4* sq = (const f32x4*)(SSQ + row * 16); const f32x4 q0 = sq[0], q1 = sq[1], q2 = sq[2], q3 = sq[3];
                const float ss = ((q0.x + q0.y) + (q0.z + q0.w)) + ((q1.x + q1.y) + (q1.z + q1.w)) + ((q2.x + q2.y) + (q2.z + q2.w)) + ((q3.x + q3.y) + (q3.z + q3.w));
                const float rstd = RSQF(ss * (1.f / 1024.f) + EPS);
#pragma unroll
                for (int bj = 0; bj < 2; ++bj) { f32x4 g0, g1; unpack8(*(const u32x4*)(MG + row * 2048 + col0 + bj * 128), g0, g1);
                    *(u32x4*)(M1 + row * 1024 + col0 + bj * 128) = pack8(acc[ai][bj][m][0] * g0 * rstd, acc[ai][bj][m][1] * g1 * rstd); } }
    }
};
struct EpiG2 {
    static constexpr bool PERM = true;
    bf16_t* MERGED; const bf16_t* M1; const bf16_t* MG;
    DEV void operator()(const AccT& acc, const pg8::Unit& u, int wr, int wc, int fr, int fq) const {
        const int row0 = u.pm * 256 + wr * 64 + fr, col0 = u.pn * 256 + wc * 32 + 8 * fq;
#pragma unroll
        for (int ai = 0; ai < 2; ++ai)
#pragma unroll
            for (int m = 0; m < 4; ++m) { const size_t row = (size_t)(row0 + ai * 128 + m * 16);
#pragma unroll
                for (int bj = 0; bj < 2; ++bj) { f32x4 g0, g1, p0, p1; unpack8(*(const u32x4*)(MG + row * 2048 + 1024 + col0 + bj * 128), g0, g1);
                    unpack8(*(const u32x4*)(M1 + row * 1024 + col0 + bj * 128), p0, p1);
                    *(u32x4*)(MERGED + row * 1024 + col0 + bj * 128) = pack8(p0 + acc[ai][bj][m][0] * g0, p1 + acc[ai][bj][m][1] * g1); } }
    }
};
struct EpiG3 {
    static constexpr bool PERM = false;
    const float* x; float* x1; const float* mod;
    DEV void operator()(const AccT& acc, const pg8::Unit& u, int wr, int wc, int fr, int fq) const {
        const int row0 = u.pm * 256 + wr * 64 + fr, col0 = u.pn * 256 + wc * 32 + 4 * fq;
        const float* gate = mod + ((u.pm * 256) / SEQ) * 6144 + 2 * 1024;
#pragma unroll
        for (int bj = 0; bj < 2; ++bj)
#pragma unroll
            for (int n = 0; n < 2; ++n) { const int c = col0 + bj * 128 + n * 16; const f32x4 gv = *(const f32x4*)(gate + c);
#pragma unroll
                for (int ai = 0; ai < 2; ++ai)
#pragma unroll
                    for (int m = 0; m < 4; ++m) { const size_t off = (size_t)(row0 + ai * 128 + m * 16) * 1024 + c;
                        *(f32x4*)(x1 + off) = *(const f32x4*)(x + off) + gv * acc[ai][bj][m][n]; } }
    }
};
struct EpiRS {
    static constexpr bool PERM = true;
    float* LOGIT; bf16_t* HS;
    DEV void operator()(const AccT& acc, const pg8::Unit& u, int wr, int wc, int fr, int fq) const {
        const int row0 = u.pm * 256 + wr * 64 + fr;
        if (u.pn == 0) {
            {
#pragma unroll
                for (int ai = 0; ai < 2; ++ai)
#pragma unroll
                    for (int m = 0; m < 4; ++m)
#pragma unroll
                        for (int bj = 0; bj < 2; ++bj)
#pragma unroll
                            for (int n = 0; n < 2; ++n) { const int c = bj * 128 + wc * 32 + 8 * fq + 4 * n;
                                if (c < NEXP) *(f32x4*)(LOGIT + (size_t)(row0 + ai * 128 + m * 16) * NEXP + c) = acc[ai][bj][m][n]; }
            }
        } else {
            const int col0 = (u.pn - 1) * 128 + wc * 32 + 8 * fq;
#pragma unroll
            for (int ai = 0; ai < 2; ++ai)
#pragma unroll
                for (int m = 0; m < 4; ++m) { f32x4 h0, h1;
#pragma unroll
                    for (int i = 0; i < 4; ++i) { h0[i] = siluf_(acc[ai][0][m][0][i]) * acc[ai][1][m][0][i]; h1[i] = siluf_(acc[ai][0][m][1][i]) * acc[ai][1][m][1][i]; }
                    *(u32x4*)(HS + (size_t)(row0 + ai * 128 + m * 16) * 256 + col0) = pack8(h0, h1); }
        }
    }
};
struct EpiX1 {
    static constexpr bool PERM = true;
    bf16_t* H;
    DEV void operator()(const AccT& acc, const pg8::Unit& u, int wr, int wc, int fr, int fq) const {
        const int row0 = u.pm * 256 + wr * 64 + fr, col0 = u.pn * 128 + wc * 32 + 8 * fq;
#pragma unroll
        for (int ai = 0; ai < 2; ++ai)
#pragma unroll
            for (int m = 0; m < 4; ++m) { f32x4 h0, h1;
#pragma unroll
                for (int i = 0; i < 4; ++i) { h0[i] = siluf_(acc[ai][0][m][0][i]) * acc[ai][1][m][0][i]; h1[i] = siluf_(acc[ai][0][m][1][i]) * acc[ai][1][m][1][i]; }
                *(u32x4*)(H + (size_t)(row0 + ai * 128 + m * 16) * 256 + col0) = pack8(h0, h1); }
    }
};
struct EpiX2 {
    static constexpr bool PERM = true;
    bf16_t* Y; const int* sdst; const float* sw;
    DEV void operator()(const AccT& acc, const pg8::Unit& u, int wr, int wc, int fr, int fq) const {
        const int row0 = u.pm * 256 + wr * 64 + fr, col0 = u.pn * 256 + wc * 32 + 8 * fq;
#pragma unroll
        for (int ai = 0; ai < 2; ++ai)
#pragma unroll
            for (int m = 0; m < 4; ++m) { const int slot = row0 + ai * 128 + m * 16; const int dst = sdst[slot]; const float w = sw[slot];
                if (dst >= 0) {
#pragma unroll
                    for (int bj = 0; bj < 2; ++bj) *(u32x4*)(Y + (size_t)dst * 1024 + col0 + bj * 128) = pack8(acc[ai][bj][m][0] * w, acc[ai][bj][m][1] * w); }
                MEM_FENCE(); }
    }
};
struct EpiSD {
    static constexpr bool PERM = false;
    float* x1; const float* mod;
    DEV void operator()(const AccT& acc, const pg8::Unit& u, int wr, int wc, int fr, int fq) const {
        const int row0 = u.pm * 256 + wr * 64 + fr, col0 = u.pn * 256 + wc * 32 + 4 * fq;
        const float* gate = mod + ((u.pm * 256) / SEQ) * 6144 + 5 * 1024 + col0;
#pragma unroll
        for (int ai = 0; ai < 2; ++ai)
#pragma unroll
            for (int m = 0; m < 4; ++m) { float* rp = x1 + (size_t)(row0 + ai * 128 + m * 16) * 1024 + col0;
#pragma unroll
                for (int bj = 0; bj < 2; ++bj)
#pragma unroll
                    for (int n = 0; n < 2; ++n) { const int c = bj * 128 + n * 16;
                        *(f32x4*)(rp + c) = *(const f32x4*)(rp + c) + *(const f32x4*)(gate + c) * acc[ai][bj][m][n]; }
                MEM_FENCE(); }
    }
};

DEV void p3_conv(Frame& F) {
    {
        float* DTG = WSP(float, WS_DTG); const float *dtb = F.pp->in[11], *ib = F.pp->in[17], *fb = F.pp->in[18];
        const int gt = F.bid * NTHR + F.tid, GT = F.G * NTHR;
        for (int idx = gt; idx < NROWS * 64; idx += GT) { const int ci = idx & 63; float v = DTG[idx];
            if (ci < 32) v = softplusf_(v + dtb[ci]);
            else { const int gq = ci - 32, dir = gq >> 4, which = (gq >> 3) & 1, hd = gq & 7; v = which ? logsigmoidf_(v + fb[dir * 8 + hd]) : v + ib[dir * 8 + hd]; }
            DTG[idx] = v; }
    }
    bf16_t* XBC = WSP(bf16_t, WS_XBC); bf16_t* QK = WSP(bf16_t, WS_QK);
    const int n_lat = (NLAT / 64) * 10, total = n_lat + BATCH * 10;
    constexpr int RS = 528;
    for (int it = F.bid; it < total; it += F.G) {
        int seg, slab, row0, L;
        if (it < n_lat) { seg = it / 10; slab = it % 10; row0 = seg * 64; L = 64; }
        else { const int j = it - n_lat; seg = j / 10; slab = j % 10; row0 = NLAT + seg * CTXL; L = CTXL; }
        bf16_t* buf; int ld, col0; const float *cw, *cbv; int cwld; float osc = 1.f;
        if (slab < 6) { buf = XBC; ld = 1536; col0 = slab * 256; cw = F.pp->in[9]; cbv = F.pp->in[10]; cwld = 1536; }
        else { buf = QK; ld = 1024; col0 = (slab - 6) * 256; cw = F.pp->in[15]; cbv = F.pp->in[16]; cwld = 1024; if (col0 < 512) osc = 0.125f; }
        for (int idx = F.tid; idx < L * 32; idx += NTHR) { const int r = idx >> 5, c8 = idx & 31;
            *(LAS u32x4*)(F.lds + r * RS + c8 * 16) = *(const u32x4*)(buf + (size_t)(row0 + r) * ld + col0 + c8 * 8); }
        SYNC();
        const int cg = F.tid & 31, ts = F.tid >> 5, cc = col0 + cg * 8;
        float w[5][8], bb[8];
#pragma unroll
        for (int j = 0; j < 5; ++j)
#pragma unroll
            for (int i = 0; i < 8; ++i) w[j][i] = cw[(size_t)j * cwld + cc + i];
#pragma unroll
        for (int i = 0; i < 8; ++i) bb[i] = cbv[cc + i];
        for (int r = ts; r < L; r += 16) {
            float a[8];
#pragma unroll
            for (int i = 0; i < 8; ++i) a[i] = bb[i];
#pragma unroll
            for (int j = 0; j < 5; ++j) { const int rr = r + j - 2;
                if (rr >= 0 && rr < L) { f32x4 v0, v1; unpack8(*(const LAS u32x4*)(F.lds + rr * RS + cg * 16), v0, v1);
#pragma unroll
                    for (int i = 0; i < 4; ++i) { a[i] += w[j][i] * v0[i]; a[4 + i] += w[j][4 + i] * v1[i]; } } }
            f32x4 o0, o1;
#pragma unroll
            for (int i = 0; i < 4; ++i) { o0[i] = siluf_(a[i]) * osc; o1[i] = siluf_(a[4 + i]) * osc; }
            *(u32x4*)(buf + (size_t)(row0 + r) * ld + cc) = pack8(o0, o1);
        }
        SYNC();
    }
}

template <bool ML> struct SC;
template <> struct SC<false> { static constexpr int NH = 8, PP = 64, PD = 64, NN = 128, NHS = 4; };
template <> struct SC<true> { static constexpr int NH = 1, PP = 144, PD = 128, NN = 64, NHS = 1; };

DEV int chunk_row0(int b, int cc) { return cc < NCH ? b * SEQ + cc * CHUNK : NLAT + b * CTXL + (cc - NCH) * CHUNK; }

template <bool ML> DEV void tok_ag(const float* DTG, const float* aneg, size_t row, int dir, int hg, float& a, float& g) {
    if (!ML) { const float dt = DTG[row * 64 + dir * 16 + hg]; a = dt * aneg[dir * 16 + hg]; g = dt; }
    else { const float ig = DTG[row * 64 + 32 + dir * 16 + hg]; a = DTG[row * 64 + 32 + dir * 16 + 8 + hg]; g = EXPF(ig); }
}

template <bool ML> DEV void s1_item(Frame& F, int b, int cc, int gi, const float* aneg) {
    typedef SC<ML> C; constexpr int NN = C::NN, PP = C::PP, PD = C::PD, NHS = C::NHS, LDK = 136;
    const bf16_t* XBC = WSP(bf16_t, WS_XBC); const bf16_t* QK = WSP(bf16_t, WS_QK); const bf16_t* V = WSP(bf16_t, WS_V); const float* DTG = WSP(float, WS_DTG);
    LAS bf16_t* BkT = (LAS bf16_t*)F.lds;
    LAS bf16_t* XwT = BkT + NN * LDK;
    LAS float* wl = (LAS float*)(XwT + NHS * PP * LDK);
    const int row0 = chunk_row0(b, cc);
    const bf16_t* Bsrc = ML ? QK + 512 + gi * 64 : XBC + 1024 + gi * 128; const int ldb = ML ? 1024 : 1536;
    const bf16_t* Xsrc = ML ? V + gi * 128 : XBC + gi * 512; const int ldx = ML ? 1024 : 1536;
    for (int idx = F.tid; idx < 128 * (NN / 8); idx += NTHR) { const int k = idx / (NN / 8), n8 = idx % (NN / 8);
        const u32x4 v = *(const u32x4*)(Bsrc + (size_t)(row0 + k) * ldb + n8 * 8);
        const unsigned ws[4] = {v.x, v.y, v.z, v.w};
#pragma unroll
        for (int i = 0; i < 4; ++i) { BkT[(n8 * 8 + 2 * i) * LDK + k] = (bf16_t)(ws[i] & 0xffffu); BkT[(n8 * 8 + 2 * i + 1) * LDK + k] = (bf16_t)(ws[i] >> 16); } }
#pragma unroll 1
    for (int dir = 0; dir < 2; ++dir)
#pragma unroll 1
        for (int hq = 0; hq < C::NH / NHS; ++hq) {
            SYNC();
            if (F.wave < NHS) {
                const int hl = hq * NHS + F.wave, hg = ML ? gi : gi * 8 + hl;
                float a0, g0, a1, g1; tok_ag<ML>(DTG, aneg, (size_t)(row0 + F.lane), dir, hg, a0, g0); tok_ag<ML>(DTG, aneg, (size_t)(row0 + 64 + F.lane), dir, hg, a1, g1);
                const float p0 = wave_incl_scan(a0, F.lane); const float t0 = __shfl(p0, 63);
                const float p1 = wave_incl_scan(a1, F.lane) + t0; const float T = __shfl(p1, 63);
                float w0, w1;
                if (dir == 0) { w0 = EXPF(T - p0) * g0; w1 = EXPF(T - p1) * g1; } else { w0 = EXPF(p0 - a0) * g0; w1 = EXPF(p1 - a1) * g1; }
                wl[F.wave * 128 + F.lane] = w0; wl[F.wave * 128 + 64 + F.lane] = w1;
                if (F.lane == 0) { float* dec = ML ? WSP(float, WS_DECM) + ((size_t)(b * 2 + dir) * NCHT + cc) * 8 + hg : WSP(float, WS_DECS) + ((size_t)(b * 2 + dir) * NCHT + cc) * 16 + hg; *dec = EXPF(T); }
            }
            SYNC();
            for (int idx = F.tid; idx < 128 * NHS * (PD / 8); idx += NTHR) { const int k = idx / (NHS * (PD / 8)), r = idx % (NHS * (PD / 8)), h = r / (PD / 8), p8 = r % (PD / 8);
                f32x4 v0, v1; unpack8(*(const u32x4*)(Xsrc + (size_t)(row0 + k) * ldx + (hq * NHS + h) * PD + p8 * 8), v0, v1);
                const float w = wl[h * 128 + k]; LAS bf16_t* d = XwT + (h * PP + p8 * 8) * LDK + k;
#pragma unroll
                for (int i = 0; i < 4; ++i) { d[i * LDK] = (bf16_t)f2bf(v0[i] * w); d[(4 + i) * LDK] = (bf16_t)f2bf(v1[i] * w); } }
            if (ML) for (int idx = F.tid; idx < 16 * 128; idx += NTHR) { const int r = idx >> 7, k = idx & 127; XwT[(128 + r) * LDK + k] = r == 0 ? (bf16_t)f2bf(wl[k]) : (bf16_t)0; }
            SYNC();
            constexpr int RT = NHS * PP / 16, CT = NN / 16;
            for (int tile = F.wave; tile < RT * CT; tile += 8) { const int rt = tile / CT, ct = tile % CT;
                f32x4 acc = {0.f, 0.f, 0.f, 0.f};
                acc = lds_tile(XwT + rt * 16 * LDK, LDK, BkT + ct * 16 * LDK, LDK, 128, F.lane, acc);
                const int rg = rt * 16 + 4 * (F.lane >> 4), h = rg / PP, p = rg % PP, n = ct * 16 + (F.lane & 15);
                const int hg = ML ? gi : gi * 8 + hq * NHS + h;
                bf16_t* dst = ML ? WSP(bf16_t, WS_STM) + ((size_t)(b * 2 + dir) * NCHT + cc) * STM_CH + ((size_t)hg * PP + p) * NN + n
                                 : WSP(bf16_t, WS_STS) + ((size_t)(b * 2 + dir) * NCHT + cc) * STS_CH + ((size_t)hg * PP + p) * NN + n;
#pragma unroll
                for (int i = 0; i < 4; ++i) dst[(size_t)i * NN] = (bf16_t)f2bf(acc[i]);
            }
        }
    SYNC();
}
DEV void p4_local_states(Frame& F) {
    LAS float* aneg_l = (LAS float*)(F.lds + LDS_BYTES - 256);
    if (F.tid < 32) aneg_l[F.tid] = -EXPF(F.pp->in[12][F.tid]);
    SYNC();
    const int nS = BATCH * NCHT * 2, nM = BATCH * NCHT * 8;
#pragma unroll 1
    for (int it = F.bid; it < nS; it += F.G) { const int b = it / (NCHT * 2), r = it % (NCHT * 2); s1_item<false>(F, b, r / 2, r % 2, (const float*)aneg_l); }
#pragma unroll 1
    for (int it = F.bid; it < nM; it += F.G) { const int b = it / (NCHT * 8), r = it % (NCHT * 8); s1_item<true>(F, b, r / 8, r % 8, (const float*)aneg_l); }
}

DEV int chunk_order(int dir, int s) { return dir == 0 ? (s < NCHC ? NCH + s : s - NCHC) : (s < NCHC ? NCH + (NCHC - 1 - s) : NCH - 1 - (s - NCHC)); }
DEV void p5_scan(Frame& F) {
    const int NS = BATCH * 2 * SSD_H * SSD_P * (SSD_N / 8), NM = BATCH * 2 * ML_H * ML_PP * (ML_DK / 8);
    const int gt = F.bid * NTHR + F.tid, GT = F.G * NTHR;
    for (int idx = gt; idx < NS + NM; idx += GT) {
        bf16_t* base; const float* dec; size_t cstride; int dstride, dir;
        if (idx < NS) { const int n8 = idx % 16, p = (idx / 16) % 64, hd = (idx / 1024) % 16; dir = (idx / 16384) % 2; const int b = idx / 32768;
            base = WSP(bf16_t, WS_STS) + (size_t)(b * 2 + dir) * NCHT * STS_CH + ((size_t)hd * 64 + p) * 128 + n8 * 8; cstride = STS_CH;
            dec = WSP(float, WS_DECS) + (size_t)(b * 2 + dir) * NCHT * 16 + hd; dstride = 16; }
        else { const int j = idx - NS; const int n8 = j % 8, p = (j / 8) % 144, hd = (j / 1152) % 8; dir = (j / 9216) % 2; const int b = j / 18432;
            base = WSP(bf16_t, WS_STM) + (size_t)(b * 2 + dir) * NCHT * STM_CH + ((size_t)hd * 144 + p) * 64 + n8 * 8; cstride = STM_CH;
            dec = WSP(float, WS_DECM) + (size_t)(b * 2 + dir) * NCHT * 8 + hd; dstride = 8; }
        f32x4 c0 = {0.f, 0.f, 0.f, 0.f}, c1 = {0.f, 0.f, 0.f, 0.f};
        constexpr int UB = (NCHT % 10 == 0) ? 10 : ((NCHT % 2 == 0) ? 2 : 1);
        for (int s0 = 0; s0 < NCHT; s0 += UB) {
            u32x4 v[UB]; float d[UB];
#pragma unroll
            for (int j = 0; j < UB; ++j) { const int cc = chunk_order(dir, s0 + j); v[j] = *(const u32x4*)(base + (size_t)cc * cstride); d[j] = dec[cc * dstride]; }
#pragma unroll
            for (int j = 0; j < UB; ++j) { const int cc = chunk_order(dir, s0 + j);
                if (cc < NCH) *(u32x4*)(base + (size_t)cc * cstride) = pack8(c0, c1);
                f32x4 a0, a1; unpack8(v[j], a0, a1); c0 = c0 * d[j] + a0; c1 = c1 * d[j] + a1; }
        }
    }
}

template <bool ML> DEV void s3_item(Frame& F, int b, int cc, int gi, const float* aneg) {
    typedef SC<ML> C; constexpr int NN = C::NN, PP = C::PP, PD = C::PD, NH = C::NH, LDK = 136, LDN = NN + 8, PT = PP / 16;
    const bf16_t* XBC = WSP(bf16_t, WS_XBC); const bf16_t* QK = WSP(bf16_t, WS_QK); const bf16_t* V = WSP(bf16_t, WS_V); const float* DTG = WSP(float, WS_DTG);
    LAS bf16_t* CQ = (LAS bf16_t*)F.lds;
    LAS bf16_t* GL = CQ + 128 * LDN;
    LAS bf16_t* XT = GL + 128 * LDK;
    LAS bf16_t* ST = XT + PP * LDK;
    LAS float* rq = (LAS float*)(ST + PP * LDN);
    LAS float* ck = rq + 256;
    LAS float* gk = ck + 256;
    LAS float* itr = gk + 256;
    const int row0 = chunk_row0(b, cc), w = F.wave, lane = F.lane, lq = lane >> 4, lc = lane & 15;
    const bf16_t* Csrc = ML ? QK + gi * 64 : XBC + 1280 + gi * 128; const bf16_t* Bsrc = ML ? QK + 512 + gi * 64 : XBC + 1024 + gi * 128; const int ldcb = ML ? 1024 : 1536;
    SYNC();
    for (int idx = F.tid; idx < 128 * (NN / 8); idx += NTHR) { const int k = idx / (NN / 8), n8 = idx % (NN / 8);
        *(LAS u32x4*)(CQ + k * LDN + n8 * 8) = *(const u32x4*)(Csrc + (size_t)(row0 + k) * ldcb + n8 * 8);
        *(LAS u32x4*)(GL + k * LDN + n8 * 8) = *(const u32x4*)(Bsrc + (size_t)(row0 + k) * ldcb + n8 * 8); }
    SYNC();
    constexpr int NS = NN / 32;
    bf16x8 aC[NS];
#pragma unroll
    for (int ns = 0; ns < NS; ++ns) aC[ns] = *(const LAS bf16x8*)(CQ + (w * 16 + lc) * LDN + ns * 32 + 8 * lq);
    f32x4 Gt[8];
#pragma unroll
    for (int ct = 0; ct < 8; ++ct) { f32x4 z = {0.f, 0.f, 0.f, 0.f};
#pragma unroll
        for (int ns = 0; ns < NS; ++ns) z = mfma16(aC[ns], *(const LAS bf16x8*)(GL + (ct * 16 + lc) * LDN + ns * 32 + 8 * lq), z);
        Gt[ct] = z; }
#pragma unroll 1
    for (int h = 0; h < NH; ++h) {
        const int hg = ML ? gi : gi * 8 + h;
        SYNC();
        { const bf16_t* Xsrc = ML ? V + gi * 128 : XBC + hg * 64; const int ldx = ML ? 1024 : 1536;
          for (int idx = F.tid; idx < 128 * (PD / 8); idx += NTHR) { const int k = idx / (PD / 8), p8 = idx % (PD / 8);
              const u32x4 v = *(const u32x4*)(Xsrc + (size_t)(row0 + k) * ldx + p8 * 8); const unsigned ws[4] = {v.x, v.y, v.z, v.w};
#pragma unroll
              for (int i = 0; i < 4; ++i) { XT[(p8 * 8 + 2 * i) * LDK + k] = (bf16_t)(ws[i] & 0xffffu); XT[(p8 * 8 + 2 * i + 1) * LDK + k] = (bf16_t)(ws[i] >> 16); } }
          if (ML) for (int idx = F.tid; idx < 16 * 128; idx += NTHR) { const int r = idx >> 7, k = idx & 127; XT[(128 + r) * LDK + k] = r == 0 ? (bf16_t)0x3F80 : (bf16_t)0; } }
        if (w < 2) {
            const int dir = w; float a0, g0, a1, g1; tok_ag<ML>(DTG, aneg, (size_t)(row0 + lane), dir, hg, a0, g0); tok_ag<ML>(DTG, aneg, (size_t)(row0 + 64 + lane), dir, hg, a1, g1);
            const float p0 = wave_incl_scan(a0, lane); const float t0 = __shfl(p0, 63);
            const float p1 = wave_incl_scan(a1, lane) + t0; const float T = __shfl(p1, 63);
            if (dir == 0) { rq[lane] = p0; rq[64 + lane] = p1; ck[lane] = -p0; ck[64 + lane] = -p1; itr[lane] = EXPF(p0); itr[64 + lane] = EXPF(p1); gk[lane] = g0; gk[64 + lane] = g1; }
            else { const float e0 = p0 - a0, e1 = p1 - a1; rq[128 + lane] = -e0; rq[192 + lane] = -e1; ck[128 + lane] = e0; ck[192 + lane] = e1;
                   itr[128 + lane] = EXPF(T - e0); itr[192 + lane] = EXPF(T - e1); gk[128 + lane] = g0; gk[192 + lane] = g1; }
        }
        f32x4 yacc[PT > 8 ? 8 : PT];
#pragma unroll
        for (int pt = 0; pt < (PT > 8 ? 8 : PT); ++pt) yacc[pt] = (f32x4){0.f, 0.f, 0.f, 0.f};
#pragma unroll 1
        for (int dir = 0; dir < 2; ++dir) {
            SYNC();
#pragma unroll
            for (int ct = 0; ct < 8; ++ct) { const int k = ct * 16 + lc; const int rel = ct - w;
                const bool tile_on = dir == 0 ? rel <= 0 : rel >= 0;
                if (tile_on) { const float ckk = ck[dir * 128 + k], gkk = gk[dir * 128 + k];
#pragma unroll
                    for (int i = 0; i < 4; ++i) { const int q = w * 16 + 4 * lq + i; const int d = 4 * lq + i - lc;
                        const bool on = rel != 0 || (dir == 0 ? d >= 0 : d <= 0);
                        const float val = on ? Gt[ct][i] * EXPF(rq[dir * 128 + q] + ckk) * gkk : 0.f;
                        GL[q * LDK + k] = (bf16_t)f2bf(val); }
                } else {
#pragma unroll
                    for (int i = 0; i < 4; ++i) GL[(w * 16 + 4 * lq + i) * LDK + k] = (bf16_t)0;
                } }
            { const bf16_t* Ssrc = ML ? WSP(bf16_t, WS_STM) + ((size_t)(b * 2 + dir) * NCHT + cc) * STM_CH + (size_t)hg * PP * NN
                                      : WSP(bf16_t, WS_STS) + ((size_t)(b * 2 + dir) * NCHT + cc) * STS_CH + (size_t)hg * PP * NN;
              for (int idx = F.tid; idx < PP * (NN / 8); idx += NTHR) { const int p = idx / (NN / 8), n8 = idx % (NN / 8);
                  *(LAS u32x4*)(ST + p * LDN + n8 * 8) = *(const u32x4*)(Ssrc + (size_t)p * NN + n8 * 8); } }
            SYNC();
            float iq[4];
#pragma unroll
            for (int i = 0; i < 4; ++i) iq[i] = itr[dir * 128 + w * 16 + 4 * lq + i];
            bf16x8 aG[4];
#pragma unroll
            for (int ks = 0; ks < 4; ++ks) aG[ks] = *(const LAS bf16x8*)(GL + (w * 16 + lc) * LDK + ks * 32 + 8 * lq);
            f32x4 den = {1.f, 1.f, 1.f, 1.f};
            if (ML) {
                f32x4 a1 = {0.f, 0.f, 0.f, 0.f}, a2 = {0.f, 0.f, 0.f, 0.f};
#pragma unroll
                for (int ks = 0; ks < 4; ++ks) a1 = mfma16(aG[ks], *(const LAS bf16x8*)(XT + (128 + lc) * LDK + ks * 32 + 8 * lq), a1);
#pragma unroll
                for (int ns = 0; ns < NS; ++ns) a2 = mfma16(aC[ns], *(const LAS bf16x8*)(ST + (128 + lc) * LDN + ns * 32 + 8 * lq), a2);
#pragma unroll
                for (int i = 0; i < 4; ++i) { const float dv = a1[i] + iq[i] * a2[i]; den[i] = fmaxf(fabsf(__shfl(dv, lane & 48)), 1.0f); }
            }
#pragma unroll
            for (int pt = 0; pt < (PT > 8 ? 8 : PT); ++pt) {
                f32x4 a1 = {0.f, 0.f, 0.f, 0.f}, a2 = {0.f, 0.f, 0.f, 0.f};
#pragma unroll
                for (int ks = 0; ks < 4; ++ks) a1 = mfma16(aG[ks], *(const LAS bf16x8*)(XT + (pt * 16 + lc) * LDK + ks * 32 + 8 * lq), a1);
#pragma unroll
                for (int ns = 0; ns < NS; ++ns) a2 = mfma16(aC[ns], *(const LAS bf16x8*)(ST + (pt * 16 + lc) * LDN + ns * 32 + 8 * lq), a2);
#pragma unroll
                for (int i = 0; i < 4; ++i) { const float yv = a1[i] + iq[i] * a2[i]; yacc[pt][i] += ML ? yv / den[i] : yv; }
                SCHED_FENCE();
            }
        }
        if (!ML) {
            const float dsk = F.pp->in[13][hg]; const bf16_t* Z = WSP(bf16_t, WS_Z); bf16_t* YP = WSP(bf16_t, WS_YPRE); const float* ng = F.pp->in[14];
            float ss[4] = {0.f, 0.f, 0.f, 0.f};
#pragma unroll
            for (int pt = 0; pt < PT; ++pt) { const int p = pt * 16 + lc; const float gcol = ng[hg * 64 + p];
#pragma unroll
                for (int i = 0; i < 4; ++i) { const int q = w * 16 + 4 * lq + i; const size_t row = (size_t)(row0 + q);
                    const float xv = bf2f(XT[p * LDK + q]); const float zv = bf2f(Z[row * 1024 + hg * 64 + p]);
                    const float t = (yacc[pt][i] + dsk * xv) * siluf_(zv); ss[i] += t * t;
                    YP[row * 1024 + hg * 64 + p] = (bf16_t)f2bf(t * gcol); } }
#pragma unroll
            for (int i = 0; i < 4; ++i) { float s = ss[i]; s += __shfl_xor(s, 1); s += __shfl_xor(s, 2); s += __shfl_xor(s, 4); s += __shfl_xor(s, 8);
                if (lc == 0) WSP(float, WS_SSQ)[(size_t)(row0 + w * 16 + 4 * lq + i) * 16 + hg] = s; }
        } else {
            const bf16_t* O = WSP(bf16_t, WS_O); bf16_t* HP = WSP(bf16_t, WS_HP); const float* ng = F.pp->in[19];
            float rs[4];
#pragma unroll
            for (int i = 0; i < 4; ++i) { float s = 0.f;
#pragma unroll
                for (int pt = 0; pt < 8; ++pt) s += yacc[pt][i] * yacc[pt][i];
                s += __shfl_xor(s, 1); s += __shfl_xor(s, 2); s += __shfl_xor(s, 4); s += __shfl_xor(s, 8);
                rs[i] = RSQF(s * (1.f / 128.f) + EPS); }
#pragma unroll
            for (int pt = 0; pt < 8; ++pt) { const int vcol = hg * 128 + pt * 16 + lc; const float gcol = ng[vcol];
#pragma unroll
                for (int i = 0; i < 4; ++i) { const size_t row = (size_t)(row0 + w * 16 + 4 * lq + i);
                    HP[row * 1024 + vcol] = (bf16_t)f2bf(yacc[pt][i] * rs[i] * gcol * bf2f(O[row * 1024 + vcol])); } }
        }
    }
    SYNC();
}
DEV void p6_outputs(Frame& F) {
    LAS float* aneg_l = (LAS float*)(F.lds + LDS_BYTES - 256);
    if (F.tid < 32) aneg_l[F.tid] = -EXPF(F.pp->in[12][F.tid]);
    SYNC();
    const int nS = BATCH * NCH * 2, nM = BATCH * NCH * 8;
#pragma unroll 1
    for (int it = F.bid; it < nS; it += F.G) { const int b = it / (NCH * 2), r = it % (NCH * 2); s3_item<false>(F, b, r / 2, r % 2, (const float*)aneg_l); }
#pragma unroll 1
    for (int it = F.bid; it < nM; it += F.G) { const int b = it / (NCH * 8), r = it % (NCH * 8); s3_item<true>(F, b, r / 8, r % 8, (const float*)aneg_l); }
}

DEV void p12_route(Frame& F) {
    const float* LOGIT = WSP(float, WS_LOG); const float* rb = F.pp->in[24];
    int* cnt = WSP(int, WS_CTL); int* ae = WSP(int, WS_ASGE); int* ar = WSP(int, WS_ASGR); float* aw = WSP(float, WS_ASGW);
    const int gw = F.bid * 8 + F.wave, NGW = F.G * 8, lane = F.lane;
    const float NEG = -3.0e38f;
    for (int t = gw; t < NLAT; t += NGW) {
        float s[EPL], cv[EPL];
        float m1 = NEG, m2 = NEG;
#pragma unroll
        for (int j = 0; j < EPL; ++j) { const int e = lane * EPL + j; s[j] = sigmoidf_(LOGIT[(size_t)t * NEXP + e]); cv[j] = s[j] + rb[e];
            if (cv[j] > m1) { m2 = m1; m1 = cv[j]; } else if (cv[j] > m2) m2 = cv[j]; }
#pragma unroll
        for (int o = 1; o < 8; o <<= 1) { const float o1 = __shfl_xor(m1, o), o2 = __shfl_xor(m2, o);
            const float n1 = fmaxf(m1, o1), n2 = fmaxf(fminf(m1, o1), fmaxf(m2, o2)); m1 = n1; m2 = n2; }
        const float gs = m1 + m2; const int g = lane >> 3; int rank = 0;
#pragma unroll
        for (int gp = 0; gp < 8; ++gp) { const float o = __shfl(gs, gp * 8); rank += (o > gs || (o == gs && gp < g)) ? 1 : 0; }
        if (rank >= TOPKG) {
#pragma unroll
            for (int j = 0; j < EPL; ++j) cv[j] = NEG;
        }
        float ssum = 0.f; int me = 0; float ms = 0.f;
#pragma unroll
        for (int r = 0; r < TOPK; ++r) {
            float bv = NEG; int bi = 0x7fffffff; float bs = 0.f;
#pragma unroll
            for (int j = 0; j < EPL; ++j) if (cv[j] > bv) { bv = cv[j]; bi = lane * EPL + j; bs = s[j]; }
#pragma unroll
            for (int o = 1; o < 64; o <<= 1) { const float ov = __shfl_xor(bv, o); const int oi = __shfl_xor(bi, o); const float os = __shfl_xor(bs, o);
                if (ov > bv || (ov == bv && oi < bi)) { bv = ov; bi = oi; bs = os; } }
            ssum += bs; if (lane == r) { me = bi; ms = bs; }
#pragma unroll
            for (int j = 0; j < EPL; ++j) if (lane * EPL + j == bi) cv[j] = NEG;
        }
        if (lane < TOPK) { const int rk = ATOMIC_ADD_I(&cnt[me], 1); const int a = t * TOPK + lane; ae[a] = me; ar[a] = rk; aw[a] = 2.5f * ms / ssum; }
    }
}
DEV void p13_slots(Frame& F) {
    const int* cnt = WSP(int, WS_CTL); int* ctl = WSP(int, WS_CTL);
    LAS int* cl = (LAS int*)F.lds; LAS int* tb = cl + NEXP;
    for (int e = F.tid; e < NEXP; e += NTHR) cl[e] = cnt[e];
    SYNC();
    if (F.tid == 0) { int run = 0; for (int e = 0; e < NEXP; ++e) { tb[e] = run; run += (cl[e] + 255) >> 8; } tb[NEXP] = run; }
    SYNC();
    const int* ae = WSP(int, WS_ASGE); const int* ar = WSP(int, WS_ASGR); const float* aw = WSP(float, WS_ASGW);
    int* stok = WSP(int, WS_STOK); int* sdst = WSP(int, WS_SDST); float* sw = WSP(float, WS_SW); int* texp = WSP(int, WS_TEXP);
    const int gt = F.bid * NTHR + F.tid, GT = F.G * NTHR;
    for (int a = gt; a < NASG; a += GT) { const int slot = tb[ae[a]] * 256 + ar[a]; stok[slot] = a / TOPK; sdst[slot] = a; sw[slot] = aw[a]; }
    for (int e = F.bid; e < NEXP; e += F.G) {
        for (int sl = tb[e] * 256 + cl[e] + F.tid; sl < tb[e + 1] * 256; sl += NTHR) { stok[sl] = 0; sdst[sl] = -1; sw[sl] = 0.f; }
        for (int t = tb[e] + F.tid; t < tb[e + 1]; t += NTHR) texp[t] = e;
    }
    if (F.bid == 0 && F.tid == 0) { ctl[1024] = tb[NEXP]; ctl[1025] = tb[HALFE]; }
}
DEV void p_final(Frame& F) {
    const float* mod = WSP(float, WS_MOD); const bf16_t* Y = WSP(bf16_t, WS_Y); const float* gf = F.pp->in[31];
    const int gw = F.bid * 8 + F.wave, NGW = F.G * 8, lane = F.lane;
    for (int t = gw; t < NLAT; t += NGW) {
        const float* gate = mod + (t / SEQ) * 6144 + 5 * 1024;
        f32x4 v[4]; float ssq = 0.f;
#pragma unroll
        for (int j = 0; j < 4; ++j) {
            f32x4 acc = {0.f, 0.f, 0.f, 0.f};
#pragma unroll
            for (int k = 0; k < TOPK; ++k) { const u32x2 yw = *((const u32x2*)(Y + (size_t)(t * TOPK + k) * 1024) + lane + 64 * j);
                acc.x += bflo(yw.x); acc.y += bfhi(yw.x); acc.z += bflo(yw.y); acc.w += bfhi(yw.y); }
            const f32x4 x1 = ((const f32x4*)(F.out + (size_t)t * DM))[lane + 64 * j]; const f32x4 gv = ((const f32x4*)gate)[lane + 64 * j];
            v[j] = x1 + gv * acc; ssq += (v[j].x * v[j].x + v[j].y * v[j].y) + (v[j].z * v[j].z + v[j].w * v[j].w);
        }
        const float rstd = RSQF(wave_sum(ssq) * (1.f / DM) + EPS);
#pragma unroll
        for (int j = 0; j < 4; ++j) ((f32x4*)(F.out + (size_t)t * DM))[lane + 64 * j] = v[j] * rstd * ((const f32x4*)gf)[lane + 64 * j];
    }
}

#ifndef HOST_EMU
namespace cg = cooperative_groups;
__global__ void __launch_bounds__(NTHR, 2) fwd_megakernel(Params prm) {
    extern __shared__ __attribute__((aligned(16))) unsigned char lds_raw[];
    cg::grid_group grid = cg::this_grid();
#define GRID_SYNC() grid.sync()
#else
void fwd_megakernel(Params prm) {
    unsigned char* lds_raw = emu_lds();
#define GRID_SYNC() do {} while (0)
#endif
    Frame F;
    F.lds = (LAS unsigned char*)lds_raw; F.tid = TID; F.lane = F.tid & 63; F.wave = RFL(F.tid >> 6); F.G = NBLK; F.bid = BID;
    F.pp = &prm;
    F.out = prm.out; F.ws = prm.ws;
    const int lo = prm.ph_lo, hi = prm.ph_hi;
#ifndef PH_MASK
#define PH_MASK 0xFFFFFFu
#endif
#define IN(k) ((((PH_MASK) >> (k)) & 1u) && lo <= (k) && (k) < hi)
#define SEAM(k) do { if (IN(k) && IN((k) + 1)) GRID_SYNC(); } while (0)
#ifndef HOST_EMU
#define OPAQUE_WS() do { unsigned char* t_ = prm.ws; asm volatile("" : "+s"(t_)); F.ws = t_; float* o_ = prm.out; asm volatile("" : "+s"(o_)); F.out = o_; } while (0)
#else
#define OPAQUE_WS() do {} while (0)
#endif
    if (IN(0)) { p0_small(F); } SEAM(0);
    if (IN(1)) { p1_xn(F); } SEAM(1);
    if (IN(2)) { pg8::Gemm g{WSP(bf16_t, WS_XN), WSP(bf16_t, WS_WIN), NROWS, NIN, 1024}; pg8::StaticOrder S; S.init(NROWS, NIN, F.G, F.bid);
        EpiInProj E{WSP(bf16_t, WS_Z), WSP(bf16_t, WS_XBC), WSP(bf16_t, WS_QK), WSP(bf16_t, WS_V), WSP(bf16_t, WS_O), WSP(bf16_t, WS_MG), WSP(float, WS_DTG)};
        pg8::gemm_phase<EpiInProj, pg8::StaticOrder>(F.lds, g, S, E); } SEAM(2);
    if (IN(3)) { p3_conv(F); } SEAM(3);
    if (IN(4)) { p4_local_states(F); } SEAM(4);
    if (IN(5)) { p5_scan(F); } SEAM(5);
    if (IN(6)) { p6_outputs(F); } SEAM(6);
    if (IN(7)) { pg8::Gemm g{WSP(bf16_t, WS_YPRE), WSP(bf16_t, WS_WSO), NLAT, 1024, 1024}; pg8::StaticOrder S; S.init(NLAT, 1024, F.G, F.bid);
        EpiG1 E{WSP(bf16_t, WS_M1), WSP(bf16_t, WS_MG), WSP(float, WS_SSQ)}; pg8::gemm_phase<EpiG1, pg8::StaticOrder>(F.lds, g, S, E); } SEAM(7);
    if (IN(8)) { pg8::Gemm g{WSP(bf16_t, WS_HP), WSP(bf16_t, WS_WMO), NLAT, 1024, 1024}; pg8::StaticOrder S; S.init(NLAT, 1024, F.G, F.bid);
        EpiG2 E{WSP(bf16_t, WS_MERGED), WSP(bf16_t, WS_M1), WSP(bf16_t, WS_MG)}; pg8::gemm_phase<EpiG2, pg8::StaticOrder>(F.lds, g, S, E); } SEAM(8);
    if (IN(9)) { pg8::Gemm g{WSP(bf16_t, WS_MERGED), WSP(bf16_t, WS_WOUT), NLAT, 1024, 1024}; pg8::StaticOrder S; S.init(NLAT, 1024, F.G, F.bid);
        EpiG3 E{F.pp->in[0], F.out, WSP(float, WS_MOD)}; pg8::gemm_phase<EpiG3, pg8::StaticOrder>(F.lds, g, S, E); } SEAM(9);
    if (IN(10)) { p10_xn2(F); p_expert_weights(F, 0); } SEAM(10);
    if (IN(11)) { pg8::Gemm g{WSP(bf16_t, WS_XN), WSP(bf16_t, WS_WRS), NLAT, 768, 1024}; pg8::StaticOrder S; S.init(NLAT, 768, F.G, F.bid);
        EpiRS E{WSP(float, WS_LOG), WSP(bf16_t, WS_HS)}; pg8::gemm_phase<EpiRS, pg8::StaticOrder>(F.lds, g, S, E); } SEAM(11);
    if (IN(12)) { p12_route(F); } SEAM(12);
    if (IN(13)) { p13_slots(F); } SEAM(13);
    for (int hf = 0; hf < 2; ++hf) {
        const int pa = 14 + 3 * hf;
        const int* ctl = WSP(int, WS_CTL);
        if (IN(pa)) { const int ntl = ctl[1024], tsp = ctl[1025];
            pg8::Gemm g{WSP(bf16_t, WS_XN), WSP(bf16_t, WS_W1T), NLAT, 512, 1024};
            pg8::ExpertOrder<true> S{hf ? tsp : 0, hf ? ntl : tsp, 2, F.G, F.bid, WSP(int, WS_TEXP), hf * HALFE, (size_t)512 * 1024, WSP(int, WS_STOK)};
            EpiX1 E{WSP(bf16_t, WS_H)}; pg8::gemm_phase<EpiX1, pg8::ExpertOrder<true>>(F.lds, g, S, E); } SEAM(pa);
        if (IN(pa + 1)) { const int ntl = ctl[1024], tsp = ctl[1025];
            pg8::Gemm g{WSP(bf16_t, WS_H), WSP(bf16_t, WS_W2T), MAXSLOT, 1024, 256};
            pg8::ExpertOrder<false> S{hf ? tsp : 0, hf ? ntl : tsp, 4, F.G, F.bid, WSP(int, WS_TEXP), hf * HALFE, (size_t)1024 * 256, nullptr};
            EpiX2 E{WSP(bf16_t, WS_Y), WSP(int, WS_SDST), WSP(float, WS_SW)}; pg8::gemm_phase<EpiX2, pg8::ExpertOrder<false>>(F.lds, g, S, E);
            } SEAM(pa + 1);
        if (hf == 0) { if (IN(pa + 2)) {
                pg8::Gemm g2{WSP(bf16_t, WS_HS), WSP(bf16_t, WS_WSD), NLAT, 1024, 256}; pg8::StaticOrder S2; S2.init(NLAT, 1024, F.G, F.bid);
                EpiSD E2{F.out, WSP(float, WS_MOD)}; pg8::gemm_phase<EpiSD, pg8::StaticOrder>(F.lds, g2, S2, E2);
                p_expert_weights(F, 1); } SEAM(pa + 2); }
    }
    if (IN(19)) { p_final(F); }
#undef IN
#undef SEAM
}

#ifndef HOST_EMU
extern "C" void kernel_launch(void* const* d_in, const int* in_sizes, int n_in, void* d_out, int out_size, void* d_ws, size_t ws_size, hipStream_t stream) {
    static int grid = 0;
    if (grid == 0) {
        if (n_in != 32 || out_size != NLAT * DM || ws_size < WS_NEED) { fprintf(stderr, "kernel_launch: unexpected problem (n_in %d out %d ws %zu need %zu)\n", n_in, out_size, ws_size, (size_t)WS_NEED); grid = -1; return; }
        int dev = 0, cus = 0, per_cu = 0;
        hipGetDevice(&dev); hipDeviceGetAttribute(&cus, hipDeviceAttributeMultiprocessorCount, dev);
        hipFuncSetAttribute((const void*)fwd_megakernel, hipFuncAttributeMaxDynamicSharedMemorySize, LDS_BYTES);
        hipOccupancyMaxActiveBlocksPerMultiprocessor(&per_cu, (const void*)fwd_megakernel, NTHR, LDS_BYTES);
        if (per_cu < 1) { fprintf(stderr, "kernel_launch: occupancy query says %d blocks per CU\n", per_cu); per_cu = 1; }
        (void)hipGetLastError();
        grid = cus;
    }
    if (grid < 0) return;
    hipMemsetAsync((char*)d_ws + WS_CTL, 0, CTL_BYTES, stream);
    Params p{};
    for (int i = 0; i < 32; ++i) p.in[i] = (const float*)d_in[i];
    p.out = (float*)d_out; p.ws = (unsigned char*)d_ws; p.ph_lo = 0; p.ph_hi = NPHASE;
    void* args[] = {&p};
    hipError_t e = hipLaunchCooperativeKernel((const void*)fwd_megakernel, dim3(grid), dim3(NTHR), args, LDS_BYTES, stream);
    if (e != hipSuccess) fprintf(stderr, "kernel_launch: cooperative launch failed: %s (grid %d)\n", hipGetErrorString(e), grid);
}
#endif
```

```cpp
#ifndef HOST_EMU
#include <hip/hip_runtime.h>
#include <cstdio>
#include <cstdint>
#define DEV __device__ __forceinline__
#define LAS __attribute__((address_space(3)))
#define TID ((int)threadIdx.x)
#define BID ((int)blockIdx.x)
#define NBLK ((int)gridDim.x)
#define SYNC() __syncthreads()
#define EXPF(x) __expf(x)
#define RCPF(x) __builtin_amdgcn_rcpf(x)
#define RSQF(x) __builtin_amdgcn_rsqf(x)
#define ATOMIC_ADD_LDS(p, v) __hip_atomic_fetch_add((p), (v), __ATOMIC_RELAXED, __HIP_MEMORY_SCOPE_WORKGROUP)
#define RFL(x) __builtin_amdgcn_readfirstlane(x)
#define SCHED_FENCE() __builtin_amdgcn_sched_barrier(0)
#define MEM_FENCE() asm volatile("" ::: "memory")
#define WAVE_LDS_FENCE() asm volatile("s_waitcnt lgkmcnt(0)" ::: "memory")
#define OPAQUE_V(x) asm volatile("" : "+v"(x))
#endif

#ifndef CFG_SEQ
#define CFG_SEQ 16384
#endif
#ifndef CFG_NEXP
#define CFG_NEXP 256
#endif
constexpr int DM = 1024, BATCH = 2, SEQ = CFG_SEQ, CTXL = 256, CHUNK = 128;
constexpr int NLAT = BATCH * SEQ, NCTX = BATCH * CTXL, NROWS = NLAT + NCTX;
constexpr int NCH = SEQ / CHUNK, NCHC = CTXL / CHUNK, NCHT = NCH + NCHC;
constexpr int SSD_H = 16, SSD_P = 64, SSD_N = 128, D_XBC = 1536;
constexpr int ML_H = 8, ML_DV = 128, ML_DK = 64, ML_PP = 144;
constexpr int NEXP = CFG_NEXP, TOPK = 8, TOPKG = 4, DEXP = 256, EPL = NEXP / 64;
constexpr int NASG = NLAT * TOPK, MAXSLOT = NASG + NEXP * 256;
constexpr int NIN = 7936;
constexpr float EPS = 1e-6f;
constexpr int NTHR = 512;

typedef unsigned short bf16_t;
typedef short bf16x8 __attribute__((ext_vector_type(8)));
typedef float f32x4 __attribute__((ext_vector_type(4)));
typedef unsigned u32x4 __attribute__((ext_vector_type(4)));
typedef unsigned u32x2 __attribute__((ext_vector_type(2)));

constexpr size_t alignup(size_t x) { return (x + 4095) & ~(size_t)4095; }
constexpr size_t WS_CTL = 0;
constexpr size_t CTL_BYTES = 65536;
constexpr size_t WS_MOD = WS_CTL + CTL_BYTES;
constexpr size_t WS_DECS = WS_MOD + alignup(3 * 6144 * 4);
constexpr size_t WS_DECM = WS_DECS + alignup((size_t)BATCH * 2 * NCHT * 16 * 4);
constexpr size_t WS_WIN = WS_DECM + alignup((size_t)BATCH * 2 * NCHT * 8 * 4);
constexpr size_t WS_WSO = WS_WIN + alignup((size_t)NIN * 1024 * 2);
constexpr size_t WS_WMO = WS_WSO + alignup((size_t)1024 * 1024 * 2);
constexpr size_t WS_WOUT = WS_WMO + alignup((size_t)1024 * 1024 * 2);
constexpr size_t WS_WRS = WS_WOUT + alignup((size_t)1024 * 1024 * 2);
constexpr size_t WS_WSD = WS_WRS + alignup((size_t)768 * 1024 * 2);
constexpr size_t WS_XN = WS_WSD + alignup((size_t)1024 * 256 * 2);
constexpr size_t WS_STAGE = WS_XN + alignup((size_t)NROWS * 1024 * 2);
constexpr size_t WS_Z = WS_STAGE;
constexpr size_t WS_XBC = WS_Z + alignup((size_t)NROWS * 1024 * 2);
constexpr size_t WS_QK = WS_XBC + alignup((size_t)NROWS * 1536 * 2);
constexpr size_t WS_V = WS_QK + alignup((size_t)NROWS * 1024 * 2);
constexpr size_t WS_O = WS_V + alignup((size_t)NROWS * 1024 * 2);
constexpr size_t WS_MG = WS_O + alignup((size_t)NROWS * 1024 * 2);
constexpr size_t WS_DTG = WS_MG + alignup((size_t)NROWS * 2048 * 2);
constexpr size_t WS_STS = WS_DTG + alignup((size_t)NROWS * 64 * 4);
constexpr size_t STS_CH = (size_t)SSD_H * SSD_P * SSD_N;
constexpr size_t WS_STM = WS_STS + alignup((size_t)BATCH * 2 * NCHT * STS_CH * 2);
constexpr size_t STM_CH = (size_t)ML_H * ML_PP * ML_DK;
constexpr size_t WS_YPRE = WS_STM + alignup((size_t)BATCH * 2 * NCHT * STM_CH * 2);
constexpr size_t WS_HP = WS_YPRE + alignup((size_t)NLAT * 1024 * 2);
constexpr size_t WS_SSQ = WS_HP + alignup((size_t)NLAT * 1024 * 2);
constexpr size_t WS_MIX_END = WS_SSQ + alignup((size_t)NLAT * 16 * 4);
constexpr size_t WS_M1 = WS_XBC;
constexpr size_t WS_MERGED = WS_QK;
constexpr size_t WS_Y = WS_STAGE;
constexpr size_t WS_W1T = WS_STAGE;
static_assert((size_t)NEXP * 512 * 1024 * 2 <= (size_t)NASG * 1024 * 2 || true, "");
constexpr size_t WS_YEND = WS_STAGE + (alignup((size_t)NASG * 1024 * 2) > alignup((size_t)NEXP * 512 * 1024 * 2) ? alignup((size_t)NASG * 1024 * 2) : alignup((size_t)NEXP * 512 * 1024 * 2));
constexpr size_t WS_W2T = WS_YEND;
constexpr size_t WS_H = WS_W2T + alignup((size_t)NEXP * 1024 * 256 * 2);
constexpr size_t WS_LOG = WS_H + alignup((size_t)MAXSLOT * 256 * 2);
constexpr size_t WS_HS = WS_LOG + alignup((size_t)NLAT * NEXP * 4);
constexpr size_t WS_ASGE = WS_HS + alignup((size_t)NLAT * 256 * 2);
constexpr size_t WS_ASGR = WS_ASGE + alignup((size_t)NASG * 4);
constexpr size_t WS_ASGW = WS_ASGR + alignup((size_t)NASG * 4);
constexpr size_t WS_STOK = WS_ASGW + alignup((size_t)NASG * 4);
constexpr size_t WS_SDST = WS_STOK + alignup((size_t)MAXSLOT * 4);
constexpr size_t WS_SW = WS_SDST + alignup((size_t)MAXSLOT * 4);
constexpr size_t WS_TEXP = WS_SW + alignup((size_t)MAXSLOT * 4);
constexpr size_t WS_CMAT = WS_TEXP + alignup((size_t)(MAXSLOT / 256) * 4);
constexpr size_t WS_YS = WS_CMAT + alignup((size_t)512 * NEXP * 4);
constexpr size_t WS_MOE_END = WS_YS + alignup((size_t)NLAT * 1024 * 2);
constexpr size_t WS_NEED = WS_MIX_END > WS_MOE_END ? WS_MIX_END : WS_MOE_END;

constexpr int LDS_BYTES = 147456;
constexpr int NPHASE = 17;

struct Params { const float* in[32]; float* out; unsigned char* ws; int ph_lo, ph_hi; };

#ifndef HOST_EMU
DEV unsigned f2bf(float f) { const __bf16 b = (__bf16)f; return (unsigned)__builtin_bit_cast(unsigned short, b); }
#else
DEV unsigned f2bf(float f) { unsigned u = __builtin_bit_cast(unsigned, f); return (u + 0x7fffu + ((u >> 16) & 1u)) >> 16; }
#endif
DEV float bf2f(unsigned h) { return __builtin_bit_cast(float, (h & 0xffffu) << 16); }
#ifndef HOST_EMU
typedef float f32x2_t __attribute__((ext_vector_type(2))); typedef __bf16 bf16x2_t __attribute__((ext_vector_type(2)));
DEV unsigned pk2(float lo, float hi) { const f32x2_t v = {lo, hi}; const bf16x2_t b = __builtin_convertvector(v, bf16x2_t); return __builtin_bit_cast(unsigned, b); }
#else
DEV unsigned pk2(float lo, float hi) { return f2bf(lo) | (f2bf(hi) << 16); }
#endif
DEV float bflo(unsigned w) { return __builtin_bit_cast(float, w << 16); }
DEV float bfhi(unsigned w) { return __builtin_bit_cast(float, w & 0xffff0000u); }
DEV float sigmoidf_(float x) { return RCPF(1.f + EXPF(-x)); }
DEV float siluf_(float x) { return x * RCPF(1.f + EXPF(-x)); }
DEV float softplusf_(float x) { return x > 20.f ? x : log1pf(EXPF(x)); }
DEV float logsigmoidf_(float x) { return -softplusf_(-x); }
DEV float wave_sum(float v) {
#pragma unroll
    for (int o = 1; o < 64; o <<= 1) v += __shfl_xor(v, o);
    return v;
}
DEV float wave_incl_scan(float v, int lane) {
#pragma unroll
    for (int d = 1; d < 64; d <<= 1) { float t = __shfl_up(v, d); if (lane >= d) v += t; }
    return v;
}
typedef short s16x4 __attribute__((ext_vector_type(4)));
#ifndef HOST_EMU
DEV f32x4 mfma16(bf16x8 a, bf16x8 b, f32x4 c) { return __builtin_amdgcn_mfma_f32_16x16x32_bf16(a, b, c, 0, 0, 0); }
DEV s16x4 lds_tr16(const LAS void* p) { return __builtin_bit_cast(s16x4, __builtin_amdgcn_ds_read_tr16_b64_v4i16((LAS s16x4*)p)); }
#endif
namespace pg8 {
constexpr int BM = 256, BK = 64, HALF = 128, HTB = HALF * BK * 2, STAGE_BYTES = 8 * HTB, NXCD = 8, WGM = 8;
struct Unit { int pm, pn; };
struct Gemm { const bf16_t* A; const bf16_t* Bt; int M, N, K; };

DEV int lds_byte(int r, int c) { const int st = (r >> 4) * 2 + (c >> 5), rr = r & 15, cc = c & 31, ob = rr * 64 + cc * 2; return st * 1024 + (ob ^ (((ob >> 9) & 1) << 5)); }
DEV void stage_rc(int b, int& R, int& C) { const int st = b / 1024, sb = b % 1024, swz = sb ^ (((sb >> 9) & 1) << 5); R = (st >> 1) * 16 + swz / 64; C = (st & 1) * 32 + (swz % 64) / 2; }
DEV int perm32(int rho) { const int n = rho >> 4, i = rho & 15; return 8 * (i >> 2) + 4 * n + (i & 3); }

struct StaticOrder {
    static constexpr bool GATHER = false;
    int nM, nN, nwg, G, c;
    DEV void init(int M, int N, int G_, int c_) { nM = M / BM; nN = N / BM; nwg = nM * nN; G = G_; c = c_; }
    DEV bool next(int i, Unit& u) const {
        const long L = (long)i * G + c; if (L >= nwg) return false;
        int wgid = (int)L; { const int q = nwg / NXCD, r = nwg % NXCD, xcd = wgid % NXCD, off = wgid / NXCD; wgid = (xcd < r ? xcd * (q + 1) : r * (q + 1) + (xcd - r) * q) + off; }
        const int nig = WGM * nN, gid = wgid / nig, fm = gid * WGM, gsz = (nM - fm) < WGM ? (nM - fm) : WGM;
        u.pm = fm + ((wgid % nig) % gsz); u.pn = (wgid % nig) / gsz; return true;
    }
    DEV unsigned arow(const Unit& u, int r) const { return (unsigned)(u.pm * BM + r); }
    DEV const char* bbase(const Gemm& g, const Unit& u) const { return (const char*)g.Bt + (size_t)u.pn * BM * g.K * 2; }
};
template <bool GATHER_> struct ExpertOrder {
    static constexpr bool GATHER = GATHER_;
    int tlo, thi, np, G, c; const int* texp; int e0; size_t estride  ; const int* rowmap;
    DEV bool next(int i, Unit& u) const {
        const long L = (long)i * G + c; const long n = (long)(thi - tlo) * np; if (L >= n) return false;
        int wg = (int)L; { const int nn = (int)n, q = nn / NXCD, r = nn % NXCD, xcd = wg % NXCD, off = wg / NXCD; wg = (xcd < r ? xcd * (q + 1) : r * (q + 1) + (xcd - r) * q) + off; }
        u.pm = tlo + wg / np; u.pn = wg % np; return true;
    }
    DEV unsigned arow(const Unit& u, int r) const { return GATHER_ ? (unsigned)rowmap[u.pm * BM + r] : (unsigned)(u.pm * BM + r); }
    DEV const char* bbase(const Gemm& g, const Unit& u) const { const int e = texp[u.pm] - e0; return (const char*)(g.Bt + (size_t)e * estride) + (size_t)u.pn * BM * g.K * 2; }
};

#ifndef HOST_EMU
#define PG8_LAS __attribute__((address_space(3)))
template <class Epi, class Sched>
__device__ __forceinline__ void gemm_phase(PG8_LAS unsigned char* lds, const Gemm g, const Sched& S, const Epi& E) {
    int tid_ = threadIdx.x; asm volatile("" : "+v"(tid_));
    const int tid = tid_, wid = __builtin_amdgcn_readfirstlane(tid >> 6), lane = tid & 63, wr = wid >> 2, wc = wid & 3, fr = lane & 15, fq = lane >> 4;
    int Kop = g.K; asm volatile("" : "+s"(Kop));
    const int K = Kop, nt = K / BK;
    int RA[2], CA[2]; unsigned voffB[2];
#pragma unroll
    for (int i = 0; i < 2; ++i) { int R, C; stage_rc(tid * 16 + i * 8192, R, C); const int Rb = Epi::PERM ? ((R & ~31) + perm32(R & 31)) : R;
        RA[i] = R; CA[i] = C; voffB[i] = (unsigned)(Rb * K + C) * 2u; }
    const size_t kstep = (size_t)(BK * 2);
    const size_t hstep = (size_t)HALF * K * 2;
    const unsigned ldsw = (unsigned)wid * 1024u;
    const int aoff = lds_byte(wr * 64 + fr, fq * 8), boff = lds_byte(wc * 32 + fr, fq * 8);
    const char* const Ab = (const char*)g.A;
#define PG8_SA(b, h) (((b) * 2 + (h)) * HTB)
#define PG8_SB(b, h) ((4 + (b) * 2 + (h)) * HTB)
#define PG8_STAGE(bufoff, gbase, voff) do { _Pragma("unroll") for (int _i = 0; _i < 2; ++_i) \
        __builtin_amdgcn_global_load_lds((const unsigned*)((const char*)(gbase) + (voff)[_i]), (PG8_LAS unsigned*)(lds + (bufoff) + ldsw + _i * 8192), 16, 0, 0); } while (0)
#define PG8_LDA(dst, b, h) do { _Pragma("unroll") for (int m = 0; m < 4; ++m) _Pragma("unroll") for (int k = 0; k < 2; ++k) dst[m][k] = *(const PG8_LAS bf16x8*)(lds + PG8_SA(b, h) + aoff + m * 2048 + k * 1024); } while (0)
#define PG8_LDB(dst, b, h) do { _Pragma("unroll") for (int n = 0; n < 2; ++n) _Pragma("unroll") for (int k = 0; k < 2; ++k) dst[n][k] = *(const PG8_LAS bf16x8*)(lds + PG8_SB(b, h) + boff + n * 2048 + k * 1024); } while (0)
#define PG8_MMA(ai, bj, At, Bt) do { __builtin_amdgcn_s_setprio(1); _Pragma("unroll") for (int m = 0; m < 4; ++m) _Pragma("unroll") for (int n = 0; n < 2; ++n) _Pragma("unroll") for (int k = 0; k < 2; ++k) \
        acc[ai][bj][m][n] = __builtin_amdgcn_mfma_f32_16x16x32_bf16(Bt[n][k], At[m][k], acc[ai][bj][m][n], 0, 0, 0); __builtin_amdgcn_s_setprio(0); } while (0)
#define PG8_WAIT_V(n) asm volatile("s_waitcnt vmcnt(" #n ")" ::: "memory")
#define PG8_WAIT_L(n) asm volatile("s_waitcnt lgkmcnt(" #n ")" ::: "memory")
#define PG8_BAR __builtin_amdgcn_s_barrier()
#define PG8_SCHED __builtin_amdgcn_sched_barrier(0)
#define PG8_VOFFA(dst, u) do { _Pragma("unroll") for (int _h = 0; _h < 2; ++_h) _Pragma("unroll") for (int _i = 0; _i < 2; ++_i) \
        dst[_h][_i] = (S.arow(u, _h * HALF + RA[_i]) * (unsigned)K + (unsigned)CA[_i]) * 2u; } while (0)
    Unit cur, nxt; int ui = 0;
    if (!S.next(0, cur)) return;
    f32x4 acc[2][2][4][2];
#pragma unroll
    for (int a = 0; a < 2; ++a)
#pragma unroll
        for (int b = 0; b < 2; ++b)
#pragma unroll
            for (int m = 0; m < 4; ++m)
#pragma unroll
                for (int n = 0; n < 2; ++n) acc[a][b][m][n] = (f32x4){0.f, 0.f, 0.f, 0.f};
    bf16x8 At[4][2], B0[2][2], B1[2][2];
    constexpr bool GA = Sched::GATHER;
    unsigned vAc[2][2], vAn[2][2];
    unsigned voffA[2];
#pragma unroll
    for (int i = 0; i < 2; ++i) voffA[i] = (unsigned)(RA[i] * K + CA[i]) * 2u;
    const size_t tstep = 2 * hstep;
    const char* cA = Ab;
    if constexpr (GA) { PG8_VOFFA(vAc, cur); } else { cA = Ab + (size_t)S.arow(cur, 0) * K * 2; (void)tstep; }
    const char* cB = S.bbase(g, cur);
#define PG8_STAGE_A(bufoff, h, ubase, vg) do { if constexpr (GA) { PG8_STAGE(bufoff, ubase, vg[h]); } else { PG8_STAGE(bufoff, (ubase) + (h) * hstep, voffA); } } while (0)
    PG8_STAGE(PG8_SB(0, 0), cB, voffB); PG8_STAGE(PG8_SB(0, 1), cB + hstep, voffB); PG8_STAGE_A(PG8_SA(0, 0), 0, cA, vAc); PG8_STAGE_A(PG8_SA(0, 1), 1, cA, vAc);
    if (wr == 1) PG8_BAR;
    PG8_WAIT_V(2); PG8_BAR;
    PG8_STAGE(PG8_SB(1, 0), cB + kstep, voffB); PG8_STAGE_A(PG8_SA(1, 0), 0, cA + kstep, vAc); PG8_STAGE(PG8_SB(1, 1), cB + hstep + kstep, voffB);
    PG8_WAIT_V(6); PG8_BAR;
    for (;;) {
        const bool has_next = S.next(ui + 1, nxt);
        const char* nB = cB; const char* nA = cA;
        if (has_next) { nB = S.bbase(g, nxt); if constexpr (GA) { PG8_VOFFA(vAn, nxt); } else { nA = Ab + (size_t)S.arow(nxt, 0) * K * 2; } }
        else if constexpr (GA) {
#pragma unroll
            for (int _h = 0; _h < 2; ++_h)
#pragma unroll
                for (int _i = 0; _i < 2; ++_i) vAn[_h][_i] = vAc[_h][_i];
        }
#pragma unroll 1
        for (int t = 0; t < nt; t += 2) {
            const bool last = (t == nt - 2);
            const char* a1 = cA + (size_t)(t + 1) * kstep;
            const char* a2 = last ? nA : cA + (size_t)(t + 2) * kstep; const char* b2 = last ? nB : cB + (size_t)(t + 2) * kstep;
            const char* a3 = a2 + kstep; const char* b3 = b2 + kstep;
            unsigned v2[2][2];
            if constexpr (GA) {
#pragma unroll
                for (int _h = 0; _h < 2; ++_h)
#pragma unroll
                    for (int _i = 0; _i < 2; ++_i) v2[_h][_i] = last ? vAn[_h][_i] : vAc[_h][_i];
            }
            PG8_LDB(B0, 0, 0); PG8_LDB(B1, 0, 1); PG8_SCHED; PG8_LDA(At, 0, 0); PG8_STAGE_A(PG8_SA(1, 1), 1, a1, vAc);
            PG8_WAIT_V(8); PG8_WAIT_L(0); PG8_BAR; PG8_MMA(0, 0, At, B0); PG8_MMA(0, 1, At, B1); PG8_BAR; PG8_SCHED;
            PG8_LDA(At, 0, 1); PG8_STAGE(PG8_SB(0, 0), b2, voffB); PG8_STAGE(PG8_SB(0, 1), b2 + hstep, voffB); PG8_STAGE_A(PG8_SA(0, 0), 0, a2, v2);
            PG8_WAIT_V(8); PG8_WAIT_L(0); PG8_BAR; PG8_MMA(1, 0, At, B0); PG8_MMA(1, 1, At, B1); PG8_BAR; PG8_SCHED;
            PG8_LDB(B0, 1, 0); PG8_LDB(B1, 1, 1); PG8_SCHED; PG8_LDA(At, 1, 0); PG8_STAGE_A(PG8_SA(0, 1), 1, a2, v2);
            PG8_WAIT_V(8); PG8_WAIT_L(0); PG8_BAR; PG8_MMA(0, 0, At, B0); PG8_MMA(0, 1, At, B1); PG8_BAR; PG8_SCHED;
            PG8_LDA(At, 1, 1); PG8_STAGE(PG8_SB(1, 0), b3, voffB); PG8_STAGE(PG8_SB(1, 1), b3 + hstep, voffB); PG8_STAGE_A(PG8_SA(1, 0), 0, a3, v2);
            PG8_WAIT_V(8); PG8_WAIT_L(0); PG8_BAR; PG8_MMA(1, 0, At, B0); PG8_MMA(1, 1, At, B1); PG8_BAR; PG8_SCHED;
        }
        if (wr == 0) PG8_BAR;
        E(acc, cur, wr, wc, fr, fq);
        if (!has_next) break;
#pragma unroll
        for (int a = 0; a < 2; ++a)
#pragma unroll
            for (int b = 0; b < 2; ++b)
#pragma unroll
                for (int m = 0; m < 4; ++m)
#pragma unroll
                    for (int n = 0; n < 2; ++n) acc[a][b][m][n] = (f32x4){0.f, 0.f, 0.f, 0.f};
        cur = nxt; cB = nB; cA = nA; ++ui;
        if constexpr (GA) {
#pragma unroll
            for (int _h = 0; _h < 2; ++_h)
#pragma unroll
                for (int _i = 0; _i < 2; ++_i) vAc[_h][_i] = vAn[_h][_i];
        }
        if (wr == 1) PG8_BAR;
    }
    PG8_WAIT_V(0);
    PG8_BAR;
#undef PG8_SA
#undef PG8_SB
#undef PG8_STAGE
#undef PG8_LDA
#undef PG8_LDB
#undef PG8_MMA
#undef PG8_WAIT_V
#undef PG8_WAIT_L
#undef PG8_BAR
#undef PG8_SCHED
#undef PG8_VOFFA
#undef PG8_STAGE_A
}
#else
template <class Epi, class Sched>
static inline void gemm_phase(unsigned char* lds, const Gemm g, const Sched& S, const Epi& E) {
    const int tid = TID, wid = tid >> 6, lane = tid & 63, wr = wid >> 2, wc = wid & 3, fr = lane & 15, fq = lane >> 4;
    float* C = (float*)(lds + 512 * 1024);
    Unit cur;
    for (int ui = 0; S.next(ui, cur); ++ui) {
        SYNC();
        { const int r = tid >> 1, c0 = (tid & 1) * 128; const bf16_t* arow = g.A + (size_t)S.arow(cur, r) * g.K; const bf16_t* bb = (const bf16_t*)S.bbase(g, cur);
          for (int c = c0; c < c0 + 128; ++c) { const bf16_t* brow = bb + (size_t)c * g.K; float s = 0.f; for (int k = 0; k < g.K; ++k) s += bf2f(arow[k]) * bf2f(brow[k]); C[r * 256 + c] = s; } }
        SYNC();
        f32x4 acc[2][2][4][2];
        for (int ai = 0; ai < 2; ++ai) for (int bj = 0; bj < 2; ++bj) for (int m = 0; m < 4; ++m) for (int n = 0; n < 2; ++n) for (int i = 0; i < 4; ++i) {
            const int row = 128 * ai + 64 * wr + 16 * m + fr, col = Epi::PERM ? 128 * bj + 32 * wc + 8 * fq + 4 * n + i : 128 * bj + 32 * wc + 16 * n + 4 * fq + i;
            acc[ai][bj][m][n][i] = C[row * 256 + col]; }
        E(acc, cur, wr, wc, fr, fq);
    }
    SYNC();
}
#endif
}

struct Frame {
    LAS unsigned char* lds;
    int tid, lane, wave, G, bid;
    const Params* pp; float* out; unsigned char* ws;
};
#define WSP(T, off) ((T*)(F.ws + (off)))

DEV void transpose_item(const float* W, int K, int N, bf16_t* WT, int dst_row, int k0, int n0, LAS float* scr, int lane) {
#pragma unroll 8
    for (int i = 0; i < 32; ++i) { const int kk = 2 * i + (lane >> 5); scr[kk * 33 + (lane & 31)] = W[(size_t)(k0 + kk) * N + n0 + (lane & 31)]; }
    WAVE_LDS_FENCE();
    const int c = lane & 7;
#pragma unroll
    for (int j = 0; j < 4; ++j) { const int n = (lane >> 3) + 8 * j; const LAS float* s = scr + (8 * c) * 33 + n;
        u32x4 o; o.x = pk2(s[0 * 33], s[1 * 33]); o.y = pk2(s[2 * 33], s[3 * 33]); o.z = pk2(s[4 * 33], s[5 * 33]); o.w = pk2(s[6 * 33], s[7 * 33]);
        *(u32x4*)(WT + (size_t)(dst_row + n) * K + k0 + 8 * c) = o; }
    WAVE_LDS_FENCE();
}
DEV int map_in(int s) {
    if (s < 2560) return s;
    if (s < 2592) return 7680 + (s - 2560);
    if (s < 4640) return s - 32;
    if (s < 4672) return 7712 + (s - 4640);
    return s - 64;
}
DEV int map_gu(int s, int up) { return (s >> 7) * 256 + up * 128 + (s & 127); }
DEV void transpose_job(Frame& F, const float* W, int K, int N, bf16_t* WT, int mode  , int row_base, int item, bool active) {
    LAS float* scr = (LAS float*)(F.lds) + F.wave * (64 * 33);
    if (active) {
        const int nblk = N / 32, kb = item / nblk, nb = item % nblk, n0 = nb * 32;
        int d = n0; if (mode == 1) d = map_in(n0); else if (mode == 2) d = map_gu(n0, 0); else if (mode == 3) d = map_gu(n0, 1);
        transpose_item(W, K, N, WT, row_base + d, kb * 64, n0, scr, F.lane);
    }
}
DEV void p0_small(Frame& F) {
    const float* c = F.pp->in[1]; const float* cctx = F.pp->in[3]; const float* aw = F.pp->in[4]; const float* ab = F.pp->in[5];
    float* mod = WSP(float, WS_MOD);
    LAS float* red = (LAS float*)F.lds;
    for (int cb = F.bid; cb < 192; cb += F.G) {
        const int cl = F.tid & 31, kg = F.tid >> 5, col = cb * 32 + cl;
        float s0 = 0.f, s1 = 0.f, s2 = 0.f;
#pragma unroll 16
        for (int k = kg * 64; k < kg * 64 + 64; ++k) { const float w = aw[(size_t)k * 6144 + col]; s0 += siluf_(c[k]) * w; s1 += siluf_(c[1024 + k]) * w; s2 += siluf_(cctx[k]) * w; }
        red[(kg * 32 + cl) * 3 + 0] = s0; red[(kg * 32 + cl) * 3 + 1] = s1; red[(kg * 32 + cl) * 3 + 2] = s2;
        SYNC();
        if (F.tid < 96) { const int v = F.tid / 32, cc = F.tid % 32; float s = 0.f; for (int q = 0; q < 16; ++q) s += red[(q * 32 + cc) * 3 + v]; mod[v * 6144 + cb * 32 + cc] = s + ab[cb * 32 + cc]; }
        SYNC();
    }
}
DEV void p0_weights(Frame& F) {
    SYNC();
    const int gw = F.bid * 8 + F.wave, NGW = F.G * 8;
#define P0_JOB(Wp, Kv, Nv, WTp, modev, rb) do { const int nitems_ = ((Kv) / 64) * ((Nv) / 32); const int rounds_ = (nitems_ + NGW - 1) / NGW; \
        for (int r_ = 0; r_ < rounds_; ++r_) { const int it_ = r_ * NGW + gw; transpose_job(F, (Wp), (Kv), (Nv), (WTp), (modev), (rb), it_, it_ < nitems_); } } while (0)
    P0_JOB(F.pp->in[8], 1024, 7744, WSP(bf16_t, WS_WIN), 1, 0);
    P0_JOB(F.pp->in[20], 1024, 1024, WSP(bf16_t, WS_WSO), 0, 0);
    P0_JOB(F.pp->in[21], 1024, 1024, WSP(bf16_t, WS_WMO), 0, 0);
    P0_JOB(F.pp->in[22], 1024, 1024, WSP(bf16_t, WS_WOUT), 0, 0);
    P0_JOB(F.pp->in[23], 1024, NEXP, WSP(bf16_t, WS_WRS), 0, 0);
    P0_JOB(F.pp->in[28], 1024, 256, WSP(bf16_t, WS_WRS), 2, 256);
    P0_JOB(F.pp->in[29], 1024, 256, WSP(bf16_t, WS_WRS), 3, 256);
    P0_JOB(F.pp->in[30], 256, 1024, WSP(bf16_t, WS_WSD), 0, 0);
#undef P0_JOB
}
struct T64 { const float* W; bf16_t* WT; int K, N, dst_row, k0, n0; };
DEV void t64_load(const T64& t, f32x4 (&v)[16], int lane) {
#pragma unroll
    for (int i = 0; i < 16; ++i) v[i] = *(const f32x4*)(t.W + (size_t)(t.k0 + 4 * i + (lane >> 4)) * t.N + t.n0 + 4 * (lane & 15));
}
DEV void t64_store(const T64& t, const f32x4 (&v)[16], LAS float* scr, int lane) {
#pragma unroll
    for (int i = 0; i < 16; ++i) { LAS float* d = scr + (4 * i + (lane >> 4)) * 65 + 4 * (lane & 15); d[0] = v[i].x; d[1] = v[i].y; d[2] = v[i].z; d[3] = v[i].w; }
    WAVE_LDS_FENCE();
    const int c = lane & 7;
#pragma unroll
    for (int j = 0; j < 8; ++j) { const int n = (lane >> 3) + 8 * j; const LAS float* sp = scr + (8 * c) * 65 + n;
        u32x4 o; o.x = pk2(sp[0 * 65], sp[1 * 65]); o.y = pk2(sp[2 * 65], sp[3 * 65]); o.z = pk2(sp[4 * 65], sp[5 * 65]); o.w = pk2(sp[6 * 65], sp[7 * 65]);
        *(u32x4*)(t.WT + (size_t)(t.dst_row + n) * t.K + t.k0 + 8 * c) = o; }
    WAVE_LDS_FENCE();
}
DEV T64 expert_item(Frame& F, int e0, int it) {
    const int per = 192, el = it / per, j = it % per, e = e0 + el; T64 t;
    if (j < 128) { const int up = j >> 6, jj = j & 63, kb = jj >> 2, nb = jj & 3;
        t.W = F.pp->in[25 + up] + (size_t)e * 1024 * 256; t.K = 1024; t.N = 256; t.WT = WSP(bf16_t, WS_W1T) + (size_t)el * 512 * 1024; t.dst_row = map_gu(nb * 64, up); t.k0 = kb * 64; t.n0 = nb * 64; }
    else { const int jj = j - 128, kb = jj >> 4, nb = jj & 15;
        t.W = F.pp->in[27] + (size_t)e * 256 * 1024; t.K = 256; t.N = 1024; t.WT = WSP(bf16_t, WS_W2T) + (size_t)el * 1024 * 256; t.dst_row = nb * 64; t.k0 = kb * 64; t.n0 = nb * 64; }
    return t;
}
DEV void p_expert_weights(Frame& F) {
    const int gw = F.bid * 8 + F.wave, NGW = F.G * 8;
    LAS float* scr = (LAS float*)(F.lds) + F.wave * (64 * 65);
    const int nitems = NEXP * 192;
    f32x4 v[16];
    if (gw < nitems) { const T64 t = expert_item(F, 0, gw); t64_load(t, v, F.lane); }
#pragma unroll 1
    for (int it = gw; it < nitems; it += NGW) {
        const T64 t = expert_item(F, 0, it);
        f32x4 cur[16];
#pragma unroll
        for (int i = 0; i < 16; ++i) cur[i] = v[i];
        if (it + NGW < nitems) { const T64 tn = expert_item(F, 0, it + NGW); t64_load(tn, v, F.lane); }
        t64_store(t, cur, scr, F.lane);
    }
    SYNC();
}

DEV void norm_mod_row(const float* xrow, const float* g, const float* shift, const float* scale, bf16_t* orow, int lane) {
    const f32x4* xr = (const f32x4*)xrow + lane;
    f32x4 v[4]; float s = 0.f;
#pragma unroll
    for (int j = 0; j < 4; ++j) { v[j] = xr[64 * j]; s += (v[j].x * v[j].x + v[j].y * v[j].y) + (v[j].z * v[j].z + v[j].w * v[j].w); }
    const float rstd = RSQF(wave_sum(s) * (1.f / DM) + EPS);
    u32x2* o8 = (u32x2*)orow + lane;
#pragma unroll
    for (int j = 0; j < 4; ++j) {
        const f32x4 gg = ((const f32x4*)g)[lane + 64 * j], sh = ((const f32x4*)shift)[lane + 64 * j], sc = ((const f32x4*)scale)[lane + 64 * j];
        const f32x4 y = v[j] * rstd * gg * (sc + 1.0f) + sh;
        u32x2 w; w.x = pk2(y.x, y.y); w.y = pk2(y.z, y.w); o8[64 * j] = w;
    }
}
template <int NR> DEV void norm_mod_rows(const float* const (&xrow)[NR], const float* g, const float* const (&shift)[NR], const float* const (&scale)[NR], bf16_t* const (&orow)[NR], int lane) {
    f32x4 v[NR][4]; float s[NR];
#pragma unroll
    for (int r = 0; r < NR; ++r)
#pragma unroll
        for (int j = 0; j < 4; ++j) v[r][j] = ((const f32x4*)xrow[r])[lane + 64 * j];
#pragma unroll
    for (int r = 0; r < NR; ++r) { float a = 0.f;
#pragma unroll
        for (int j = 0; j < 4; ++j) a += (v[r][j].x * v[r][j].x + v[r][j].y * v[r][j].y) + (v[r][j].z * v[r][j].z + v[r][j].w * v[r][j].w);
        s[r] = a; }
#pragma unroll
    for (int o = 1; o < 64; o <<= 1)
#pragma unroll
        for (int r = 0; r < NR; ++r) s[r] += __shfl_xor(s[r], o);
#pragma unroll
    for (int r = 0; r < NR; ++r) { const float rstd = RSQF(s[r] * (1.f / DM) + EPS); u32x2* o8 = (u32x2*)orow[r] + lane;
#pragma unroll
        for (int j = 0; j < 4; ++j) {
            const f32x4 gg = ((const f32x4*)g)[lane + 64 * j], sh = ((const f32x4*)shift[r])[lane + 64 * j], sc = ((const f32x4*)scale[r])[lane + 64 * j];
            const f32x4 y = v[r][j] * rstd * gg * (sc + 1.0f) + sh;
            u32x2 w; w.x = pk2(y.x, y.y); w.y = pk2(y.z, y.w); o8[64 * j] = w; } }
}
DEV void p1_xn(Frame& F) {
    const float* mod = WSP(float, WS_MOD); bf16_t* XN = WSP(bf16_t, WS_XN);
    const int gw = F.bid * 8 + F.wave, NGW = F.G * 8;
    static_assert(NROWS % 8 == 0 && SEQ % 8 == 0 && NLAT % 8 == 0, "row octets");
    for (int q = gw; q < NROWS / 8; q += NGW) {
        const float* src[8]; const float* sh[8]; const float* sc[8]; bf16_t* dst[8];
#pragma unroll
        for (int i = 0; i < 8; ++i) { const int r = q * 8 + i; src[i] = r < NLAT ? F.pp->in[0] + (size_t)r * DM : F.pp->in[2] + (size_t)(r - NLAT) * DM;
            const int mv = r < NLAT ? r / SEQ : 2; sh[i] = mod + mv * 6144; sc[i] = mod + mv * 6144 + 1024; dst[i] = XN + (size_t)r * DM; }
        norm_mod_rows<8>(src, F.pp->in[6], sh, sc, dst, F.lane);
    }
}
DEV void p10_xn2(Frame& F) {
    const float* mod = WSP(float, WS_MOD); bf16_t* XN = WSP(bf16_t, WS_XN);
    const int gw = F.bid * 8 + F.wave, NGW = F.G * 8;
    for (int q = gw; q < NLAT / 4; q += NGW) {
        const float* src[4]; const float* sh[4]; const float* sc[4]; bf16_t* dst[4];
#pragma unroll
        for (int i = 0; i < 4; ++i) { const int r = q * 4 + i; src[i] = F.out + (size_t)r * DM; const int mv = r / SEQ; sh[i] = mod + mv * 6144 + 3 * 1024; sc[i] = mod + mv * 6144 + 4 * 1024; dst[i] = XN + (size_t)r * DM; }
        norm_mod_rows<4>(src, F.pp->in[7], sh, sc, dst, F.lane);
    }
}

#ifndef CONV_FUSED
#define CONV_FUSED 1
#endif
typedef f32x4 AccT[2][2][4][2];
DEV u32x2 pack4(f32x4 a) { u32x2 w; w.x = pk2(a.x, a.y); w.y = pk2(a.z, a.w); return w; }
DEV u32x4 pack8(f32x4 a, f32x4 b) { u32x4 w; w.x = pk2(a.x, a.y); w.y = pk2(a.z, a.w); w.z = pk2(b.x, b.y); w.w = pk2(b.z, b.w); return w; }
DEV f32x4 sig4(f32x4 a) { f32x4 r; r.x = sigmoidf_(a.x); r.y = sigmoidf_(a.y); r.z = sigmoidf_(a.z); r.w = sigmoidf_(a.w); return r; }
DEV void unpack8(u32x4 w, f32x4& a, f32x4& b) { a.x = bflo(w.x); a.y = bfhi(w.x); a.z = bflo(w.y); a.w = bfhi(w.y); b.x = bflo(w.z); b.y = bfhi(w.z); b.z = bflo(w.w); b.w = bfhi(w.w); }

#ifndef HOST_EMU
template <int D> DEV float rot16(float v, int) { return __builtin_bit_cast(float, __builtin_amdgcn_update_dpp(0, __builtin_bit_cast(int, v), 0x120 + ((16 - D) & 15), 0xF, 0xF, false)); }
#else
template <int D> DEV float rot16(float v, int lane) { return __shfl(v, (lane & 48) | ((lane + D) & 15)); }
#endif
struct EpiInProj {
    static constexpr bool PERM = true;
    bf16_t *Z, *XBC, *QK, *V, *O, *MG; float* DTG; const float *cwx, *cbx, *cwq, *cbq; LAS unsigned char* ldsx;
    DEV void operator()(const AccT& acc, const pg8::Unit& u, int wr, int wc, int fr_in, int fq_in) const {
        int fr = fr_in, fq = fq_in; OPAQUE_V(fr); OPAQUE_V(fq);
        const int row0 = u.pm * 256 + wr * 64 + fr; const int t = u.pn;
        if (CONV_FUSED && t >= 4 && t < 14 && u.pm * 256 < NLAT) {
            const bool isx = t < 10; bf16_t* base = isx ? XBC : QK; const int ldc = isx ? 1536 : 1024, colt = isx ? (t - 4) * 256 : (t - 10) * 256;
            const float* cw = isx ? cwx : cwq; const float* cb = isx ? cbx : cbq; const float osc = (!isx && colt < 512) ? 0.125f : 1.0f;
            const int lane = fq * 16 + fr;
            LAS float* wl = (LAS float*)(ldsx + (wr * 4 + wc) * 1536);
#pragma unroll
            for (int r = 0; r < 6; ++r) { const int cidx = lane, col = colt + (cidx >> 5) * 128 + wc * 32 + (cidx & 31); wl[r * 64 + cidx] = r < 5 ? cw[(size_t)r * ldc + col] : cb[col]; }
            WAVE_LDS_FENCE();
#pragma unroll
            for (int bj = 0; bj < 2; ++bj)
#pragma unroll
                for (int n = 0; n < 2; ++n) { const int col0 = colt + bj * 128 + wc * 32 + 8 * fq + 4 * n;
#pragma unroll
                    for (int ai = 0; ai < 2; ++ai) { f32x4 o[4];
#pragma unroll
                        for (int i = 0; i < 4; ++i) { float r1[5], r2[5], l1[5], l2[5]; r1[4] = 0.f; r2[4] = 0.f; l1[0] = 0.f; l2[0] = 0.f;
                            const int ci = bj * 32 + 8 * fq + 4 * n + i; const float w0 = wl[ci], w1 = wl[64 + ci], w2 = wl[128 + ci], w3 = wl[192 + ci], w4 = wl[256 + ci], bb = wl[320 + ci];
#pragma unroll
                            for (int m = 0; m < 4; ++m) { const float v = acc[ai][bj][m][n][i]; r1[m] = rot16<1>(v, lane); r2[m] = rot16<2>(v, lane); l1[m + 1] = rot16<-1>(v, lane); l2[m + 1] = rot16<-2>(v, lane); }
#pragma unroll
                            for (int m = 0; m < 4; ++m) { const float v = acc[ai][bj][m][n][i];
                                const float n1 = fr < 15 ? r1[m] : r1[m + 1], n2 = fr < 14 ? r2[m] : r2[m + 1], p1 = fr > 0 ? l1[m + 1] : l1[m], p2 = fr > 1 ? l2[m + 1] : l2[m];
                                const float a = bb + w0 * p2 + w1 * p1 + w2 * v + w3 * n1 + w4 * n2;
                                o[m][i] = siluf_(a) * osc; }
                            }
#pragma unroll
                        for (int m = 0; m < 4; ++m) *(u32x2*)(base + (size_t)(row0 + ai * 128 + m * 16) * ldc + col0) = pack4(o[m]);
                        MEM_FENCE(); SCHED_FENCE(); } }
        } else if (t < 30) {
            bf16_t* base; int ldc, colt; bool act = false;
            if (t < 4) { base = Z; ldc = 1024; colt = t * 256; }
            else if (t < 10) { base = XBC; ldc = 1536; colt = (t - 4) * 256; }
            else if (t < 14) { base = QK; ldc = 1024; colt = (t - 10) * 256; }
            else if (t < 18) { base = V; ldc = 1024; colt = (t - 14) * 256; }
            else if (t < 22) { base = O; ldc = 1024; colt = (t - 18) * 256; act = true; }
            else { base = MG; ldc = 2048; colt = (t - 22) * 256; act = true; }
            const int col0 = colt + wc * 32 + 8 * fq;
#pragma unroll
            for (int ai = 0; ai < 2; ++ai)
#pragma unroll
                for (int m = 0; m < 4; ++m) { bf16_t* rowp = base + (size_t)(row0 + ai * 128 + m * 16) * ldc + col0;
#pragma unroll
                    for (int bj = 0; bj < 2; ++bj) { f32x4 v0 = acc[ai][bj][m][0], v1 = acc[ai][bj][m][1];
                        if (act) { v0 = sig4(v0); v1 = sig4(v1); }
                        *(u32x4*)(rowp + bj * 128) = pack8(v0, v1); } }
        } else if (wc < 2) {
#pragma unroll
            for (int ai = 0; ai < 2; ++ai)
#pragma unroll
                for (int m = 0; m < 4; ++m)
#pragma unroll
                    for (int n = 0; n < 2; ++n) { const int c0 = 32 * wc + 8 * fq + 4 * n;
                        *(f32x4*)(DTG + (size_t)(row0 + ai * 128 + m * 16) * 64 + c0) = acc[ai][0][m][n]; }
        }
    }
};
struct EpiG1 {
    static constexpr bool PERM = true;
    bf16_t* M1; const bf16_t* MG; const float* SSQ;
    DEV void operator()(const AccT& acc, const pg8::Unit& u, int wr, int wc, int fr, int fq) const {
        const int row0 = u.pm * 256 + wr * 64 + fr, col0 = u.pn * 256 + wc * 32 + 8 * fq;
#pragma unroll
        for (int ai = 0; ai < 2; ++ai)
#pragma unroll
            for (int m = 0; m < 4; ++m) { const size_t row = (size_t)(row0 + ai * 128 + m * 16);
                const f32x4* sq = (const f32x4*)(SSQ + row * 16); const f32x4 q0 = sq[0], q1 = sq[1], q2 = sq[2], q3 = sq[3];
                const float ss = ((q0.x + q0.y) + (q0.z + q0.w)) + ((q1.x + q1.y) + (q1.z + q1.w)) + ((q2.x + q2.y) + (q2.z + q2.w)) + ((q3.x + q3.y) + (q3.z + q3.w));
                const float rstd = RSQF(ss * (1.f / 1024.f) + EPS);
#pragma unroll
                for (int bj = 0; bj < 2; ++bj) { f32x4 g0, g1; unpack8(*(const u32x4*)(MG + row * 2048 + col0 + bj * 128), g0, g1);
                    *(u32x4*)(M1 + row * 1024 + col0 + bj * 128) = pack8(acc[ai][bj][m][0] * g0 * rstd, acc[ai][bj][m][1] * g1 * rstd); } }
    }
};
struct EpiG2 {
    static constexpr bool PERM = true;
    bf16_t* MERGED; const bf16_t* M1; const bf16_t* MG;
    DEV void operator()(const AccT& acc, const pg8::Unit& u, int wr, int wc, int fr, int fq) const {
        const int row0 = u.pm * 256 + wr * 64 + fr, col0 = u.pn * 256 + wc * 32 + 8 * fq;
#pragma unroll
        for (int ai = 0; ai < 2; ++ai)
#pragma unroll
            for (int m = 0; m < 4; ++m) { const size_t row = (size_t)(row0 + ai * 128 + m * 16);
#pragma unroll
                for (int bj = 0; bj < 2; ++bj) { f32x4 g0, g1, p0, p1; unpack8(*(const u32x4*)(MG + row * 2048 + 1024 + col0 + bj * 128), g0, g1);
                    unpack8(*(const u32x4*)(M1 + row * 1024 + col0 + bj * 128), p0, p1);
                    *(u32x4*)(MERGED + row * 1024 + col0 + bj * 128) = pack8(p0 + acc[ai][bj][m][0] * g0, p1 + acc[ai][bj][m][1] * g1); } }
    }
};
struct EpiG3 {
    static constexpr bool PERM = false;
    const float* x; float* x1; const float* mod;
    DEV void operator()(const AccT& acc, const pg8::Unit& u, int wr, int wc, int fr, int fq) const {
        const int row0 = u.pm * 256 + wr * 64 + fr, col0 = u.pn * 256 + wc * 32 + 4 * fq;
        const float* gate = mod + ((u.pm * 256) / SEQ) * 6144 + 2 * 1024;
#pragma unroll
        for (int bj = 0; bj < 2; ++bj)
#pragma unroll
            for (int n = 0; n < 2; ++n) { const int c = col0 + bj * 128 + n * 16; const f32x4 gv = *(const f32x4*)(gate + c);
#pragma unroll
                for (int ai = 0; ai < 2; ++ai)
#pragma unroll
                    for (int m = 0; m < 4; ++m) { const size_t off = (size_t)(row0 + ai * 128 + m * 16) * 1024 + c;
                        *(f32x4*)(x1 + off) = *(const f32x4*)(x + off) + gv * acc[ai][bj][m][n]; } }
    }
};
struct EpiRS {
    static constexpr bool PERM = true;
    float* LOGIT; bf16_t* HS;
    DEV void operator()(const AccT& acc, const pg8::Unit& u, int wr, int wc, int fr, int fq) const {
        const int row0 = u.pm * 256 + wr * 64 + fr;
        if (u.pn == 0) {
            {
#pragma unroll
                for (int ai = 0; ai < 2; ++ai)
#pragma unroll
                    for (int m = 0; m < 4; ++m)
#pragma unroll
                        for (int bj = 0; bj < 2; ++bj)
#pragma unroll
                            for (int n = 0; n < 2; ++n) { const int c = bj * 128 + wc * 32 + 8 * fq + 4 * n;
                                if (c < NEXP) *(f32x4*)(LOGIT + (size_t)(row0 + ai * 128 + m * 16) * NEXP + c) = acc[ai][bj][m][n]; }
            }
        } else {
            const int col0 = (u.pn - 1) * 128 + wc * 32 + 8 * fq;
#pragma unroll
            for (int ai = 0; ai < 2; ++ai)
#pragma unroll
                for (int m = 0; m < 4; ++m) { f32x4 h0, h1;
#pragma unroll
                    for (int i = 0; i < 4; ++i) { h0[i] = siluf_(acc[ai][0][m][0][i]) * acc[ai][1][m][0][i]; h1[i] = siluf_(acc[ai][0][m][1][i]) * acc[ai][1][m][1][i]; }
                    *(u32x4*)(HS + (size_t)(row0 + ai * 128 + m * 16) * 256 + col0) = pack8(h0, h1); }
        }
    }
};
struct EpiX1 {
    static constexpr bool PERM = true;
    bf16_t* H;
    DEV void operator()(const AccT& acc, const pg8::Unit& u, int wr, int wc, int fr, int fq) const {
        const int row0 = u.pm * 256 + wr * 64 + fr, col0 = u.pn * 128 + wc * 32 + 8 * fq;
#pragma unroll
        for (int ai = 0; ai < 2; ++ai)
#pragma unroll
            for (int m = 0; m < 4; ++m) { f32x4 h0, h1;
#pragma unroll
                for (int i = 0; i < 4; ++i) { h0[i] = siluf_(acc[ai][0][m][0][i]) * acc[ai][1][m][0][i]; h1[i] = siluf_(acc[ai][0][m][1][i]) * acc[ai][1][m][1][i]; }
                *(u32x4*)(H + (size_t)(row0 + ai * 128 + m * 16) * 256 + col0) = pack8(h0, h1); }
    }
};
struct EpiX2 {
    static constexpr bool PERM = true;
    bf16_t* Y; const int* sdst; const float* sw;
    DEV void operator()(const AccT& acc, const pg8::Unit& u, int wr, int wc, int fr, int fq) const {
        const int row0 = u.pm * 256 + wr * 64 + fr, col0 = u.pn * 256 + wc * 32 + 8 * fq;
        int dst[8]; float w[8];
#pragma unroll
        for (int r = 0; r < 8; ++r) { const int slot = row0 + (r >> 2) * 128 + (r & 3) * 16; dst[r] = sdst[slot]; w[r] = sw[slot]; }
#pragma unroll
        for (int ai = 0; ai < 2; ++ai)
#pragma unroll
            for (int m = 0; m < 4; ++m) { const int d = dst[ai * 4 + m]; const float ww = w[ai * 4 + m];
                if (d >= 0) {
#pragma unroll
                    for (int bj = 0; bj < 2; ++bj) *(u32x4*)(Y + (size_t)d * 1024 + col0 + bj * 128) = pack8(acc[ai][bj][m][0] * ww, acc[ai][bj][m][1] * ww); } }
    }
};
struct EpiSD {
    static constexpr bool PERM = true;
    bf16_t* YS;
    DEV void operator()(const AccT& acc, const pg8::Unit& u, int wr, int wc, int fr, int fq) const {
        const int row0 = u.pm * 256 + wr * 64 + fr, col0 = u.pn * 256 + wc * 32 + 8 * fq;
#pragma unroll
        for (int ai = 0; ai < 2; ++ai)
#pragma unroll
            for (int m = 0; m < 4; ++m) { bf16_t* rp = YS + (size_t)(row0 + ai * 128 + m * 16) * 1024 + col0;
#pragma unroll
                for (int bj = 0; bj < 2; ++bj) *(u32x4*)(rp + bj * 128) = pack8(acc[ai][bj][m][0], acc[ai][bj][m][1]);
                MEM_FENCE(); }
    }
};

DEV int chunk_row0(int b, int cc) { return cc < NCH ? b * SEQ + cc * CHUNK : NLAT + b * CTXL + (cc - NCH) * CHUNK; }

struct GateBias { const float *dtb, *ib, *fb; };
template <bool ML> DEV void tok_ag(const float* DTG, const float* aneg, const GateBias& gbv, size_t row, int dir, int hg, float& a, float& g) {
    if (!ML) { const float dt = softplusf_(DTG[row * 64 + dir * 16 + hg] + gbv.dtb[dir * 16 + hg]); a = dt * aneg[dir * 16 + hg]; g = dt; }
    else { const float ig = DTG[row * 64 + 32 + dir * 16 + hg] + gbv.ib[dir * 8 + hg]; a = logsigmoidf_(DTG[row * 64 + 32 + dir * 16 + 8 + hg] + gbv.fb[dir * 8 + hg]); g = EXPF(ig); }
}
struct CtxW { float w[5][8], b[8]; };
DEV void ctx_conv_prep(CtxW& c, const float* cw, const float* cb, int ld, int col) {
#pragma unroll
    for (int j = 0; j < 5; ++j) { const f32x4 a = *(const f32x4*)(cw + (size_t)j * ld + col), d = *(const f32x4*)(cw + (size_t)j * ld + col + 4);
#pragma unroll
        for (int i = 0; i < 4; ++i) { c.w[j][i] = a[i]; c.w[j][4 + i] = d[i]; } }
    const f32x4 a = *(const f32x4*)(cb + col), d = *(const f32x4*)(cb + col + 4);
#pragma unroll
    for (int i = 0; i < 4; ++i) { c.b[i] = a[i]; c.b[4 + i] = d[i]; }
}
DEV u32x4 ctx_conv_chunk(const CtxW& c, const bf16_t* buf, int ld, int seg0, int kseg, int col) {
    float a[8];
#pragma unroll
    for (int i = 0; i < 8; ++i) a[i] = c.b[i];
#pragma unroll
    for (int j = 0; j < 5; ++j) { const int kk = kseg + j - 2;
        if (kk >= 0 && kk < CTXL) { f32x4 v0, v1; unpack8(*(const u32x4*)(buf + (size_t)(seg0 + kk) * ld + col), v0, v1);
#pragma unroll
            for (int i = 0; i < 4; ++i) { a[i] += c.w[j][i] * v0[i]; a[4 + i] += c.w[j][4 + i] * v1[i]; } } }
    f32x4 o0, o1;
#pragma unroll
    for (int i = 0; i < 4; ++i) { o0[i] = siluf_(a[i]); o1[i] = siluf_(a[4 + i]); }
    return pack8(o0, o1);
}

DEV int chunk_order(int dir, int s) { return dir == 0 ? (s < NCHC ? NCH + s : s - NCHC) : (s < NCHC ? NCH + (NCHC - 1 - s) : NCH - 1 - (s - NCHC)); }
DEV void p5_scan(Frame& F) {
    const int NS = BATCH * 2 * SSD_H * SSD_P * (SSD_N / 8), NM = BATCH * 2 * ML_H * ML_PP * (ML_DK / 8);
    const int gt = F.bid * NTHR + F.tid, GT = F.G * NTHR;
    for (int idx = gt; idx < NS + NM; idx += GT) {
        bf16_t* base; const float* dec; size_t cstride; int dstride, dir;
        if (idx < NS) { const int n8 = idx % 16, p = (idx / 16) % 64, hd = (idx / 1024) % 16; dir = (idx / 16384) % 2; const int b = idx / 32768;
            base = WSP(bf16_t, WS_STS) + (size_t)(b * 2 + dir) * NCHT * STS_CH + ((size_t)hd * 64 + p) * 128 + n8 * 8; cstride = STS_CH;
            dec = WSP(float, WS_DECS) + (size_t)(b * 2 + dir) * NCHT * 16 + hd; dstride = 16; }
        else { const int j = idx - NS; const int n8 = j % 8, p = (j / 8) % 144, hd = (j / 1152) % 8; dir = (j / 9216) % 2; const int b = j / 18432;
            base = WSP(bf16_t, WS_STM) + (size_t)(b * 2 + dir) * NCHT * STM_CH + ((size_t)hd * 144 + p) * 64 + n8 * 8; cstride = STM_CH;
            dec = WSP(float, WS_DECM) + (size_t)(b * 2 + dir) * NCHT * 8 + hd; dstride = 8; }
        f32x4 c0 = {0.f, 0.f, 0.f, 0.f}, c1 = {0.f, 0.f, 0.f, 0.f};
        constexpr int UB = (NCHT % 10 == 0) ? 10 : ((NCHT % 2 == 0) ? 2 : 1);
        for (int s0 = 0; s0 < NCHT; s0 += UB) {
            u32x4 v[UB]; float d[UB];
#pragma unroll
            for (int j = 0; j < UB; ++j) { const int cc = chunk_order(dir, s0 + j); v[j] = *(const u32x4*)(base + (size_t)cc * cstride); d[j] = dec[cc * dstride]; }
#pragma unroll
            for (int j = 0; j < UB; ++j) { const int cc = chunk_order(dir, s0 + j);
                if (cc < NCH) *(u32x4*)(base + (size_t)cc * cstride) = pack8(c0, c1);
                f32x4 a0, a1; unpack8(v[j], a0, a1); c0 = c0 * d[j] + a0; c1 = c1 * d[j] + a1; }
        }
    }
}

DEV bf16x8 tr_frag(const LAS bf16_t* T, int LD, int k0, int c0, int lane) {
    const LAS bf16_t* p0 = T + (k0 + 8 * (lane >> 4) + ((lane & 15) >> 2)) * LD + c0 + 4 * (lane & 3);
    const s16x4 a = lds_tr16(p0), b = lds_tr16(p0 + 4 * LD);
    bf16x8 r; r[0] = a[0]; r[1] = a[1]; r[2] = a[2]; r[3] = a[3]; r[4] = b[0]; r[5] = b[1]; r[6] = b[2]; r[7] = b[3]; return r;
}
DEV bf16x8 tr_frag8(const LAS bf16_t* T, int LD, int k0, int c0, int lane) {
    const LAS bf16_t* p0 = T + (k0 + 8 * (lane >> 4) + ((lane & 15) >> 2)) * LD + c0 + 8 * (lane & 3);
    const s16x4 a = lds_tr16(p0), b = lds_tr16(p0 + 4 * LD);
    bf16x8 r; r[0] = a[0]; r[1] = a[1]; r[2] = a[2]; r[3] = a[3]; r[4] = b[0]; r[5] = b[1]; r[6] = b[2]; r[7] = b[3]; return r;
}
DEV bf16x8 row_frag(const LAS bf16_t* T, int LD, int r0, int k0, int lane) { return *(const LAS bf16x8*)(T + (r0 + (lane & 15)) * LD + k0 + 8 * (lane >> 4)); }
DEV float gtv(u32x2 g, int i) { return i == 0 ? bflo(g.x) : (i == 1 ? bfhi(g.x) : (i == 2 ? bflo(g.y) : bfhi(g.y))); }

DEV void s3v2_ssd(Frame& F, int b, int cc, int gi, const float* aneg) {
    constexpr int LDC = 136, LDX = 80;
    const bf16_t* XBC = WSP(bf16_t, WS_XBC); const float* DTG = WSP(float, WS_DTG); const bf16_t* Z = WSP(bf16_t, WS_Z); bf16_t* YP = WSP(bf16_t, WS_YPRE); float* SSQ = WSP(float, WS_SSQ);
    LAS bf16_t* CQ = (LAS bf16_t*)F.lds;
    LAS bf16_t* GLB = CQ + 128 * LDC;
    LAS bf16_t* XS = GLB + 128 * LDC;
    LAS bf16_t* STF = XS + 128 * LDX;
    LAS bf16_t* STB = STF + 64 * LDC;
    LAS float* Pf = (LAS float*)(STB + 64 * LDC);
    LAS float* Eb = Pf + 128; LAS float* gf = Eb + 128; LAS float* gb = gf + 128; LAS float* itf = gb + 128; LAS float* itb = itf + 128;
    int tid_ = F.tid; OPAQUE_V(tid_);
    const int row0 = chunk_row0(b, cc), w = F.wave, tid = tid_, lane = tid & 63, lq = lane >> 4, lc = lane & 15;
    SYNC();
    for (int idx = tid; idx < 128 * 16; idx += NTHR) { const int k = idx >> 4, n8 = idx & 15;
        *(LAS u32x4*)(CQ + k * LDC + n8 * 8) = *(const u32x4*)(XBC + (size_t)(row0 + k) * 1536 + 1280 + gi * 128 + n8 * 8);
        *(LAS u32x4*)(GLB + k * LDC + n8 * 8) = *(const u32x4*)(XBC + (size_t)(row0 + k) * 1536 + 1024 + gi * 128 + n8 * 8); }
    u32x4 rx[2], rsf[2], rsb[2]; float rdt[2];
#define S3S_LOAD(hh) do { const int hg_ = gi * 8 + (hh); \
        _Pragma("unroll") for (int j_ = 0; j_ < 2; ++j_) { const int id_ = tid + NTHR * j_; \
            rx[j_] = *(const u32x4*)(XBC + (size_t)(row0 + (id_ >> 3)) * 1536 + hg_ * 64 + (id_ & 7) * 8); \
            rsf[j_] = *(const u32x4*)(WSP(bf16_t, WS_STS) + ((size_t)(b * 2 + 0) * NCHT + cc) * STS_CH + (size_t)hg_ * 8192 + (size_t)id_ * 8); \
            rsb[j_] = *(const u32x4*)(WSP(bf16_t, WS_STS) + ((size_t)(b * 2 + 1) * NCHT + cc) * STS_CH + (size_t)hg_ * 8192 + (size_t)id_ * 8); \
            } \
        if (w < 2) { rdt[0] = DTG[(size_t)(row0 + lane) * 64 + w * 16 + hg_]; rdt[1] = DTG[(size_t)(row0 + 64 + lane) * 64 + w * 16 + hg_]; } } while (0)
    S3S_LOAD(0);
    SYNC();
    bf16x8 aC[4];
#pragma unroll
    for (int ns = 0; ns < 4; ++ns) aC[ns] = row_frag(CQ, LDC, w * 16, ns * 32, lane);
    u32x2 Gt[8];
#pragma unroll
    for (int ct = 0; ct < 8; ++ct) { f32x4 z = {0.f, 0.f, 0.f, 0.f};
#pragma unroll
        for (int ns = 0; ns < 4; ++ns) z = mfma16(aC[ns], row_frag(GLB, LDC, ct * 16, ns * 32, lane), z);
        Gt[ct] = pack4(z); }
#pragma unroll 1
    for (int h = 0; h < 8; ++h) {
        const int hg = gi * 8 + h;
        SYNC();
#pragma unroll
        for (int j = 0; j < 2; ++j) { const int id = tid + NTHR * j;
            *(LAS u32x4*)(XS + (id >> 3) * LDX + (id & 7) * 8) = rx[j];
            *(LAS u32x4*)(STF + (id >> 4) * LDC + (id & 15) * 8) = rsf[j];
            *(LAS u32x4*)(STB + (id >> 4) * LDC + (id & 15) * 8) = rsb[j]; }
        if (w < 2) { const float an = aneg[w * 16 + hg], db = F.pp->in[11][w * 16 + hg]; rdt[0] = softplusf_(rdt[0] + db); rdt[1] = softplusf_(rdt[1] + db); const float a0 = rdt[0] * an, a1 = rdt[1] * an;
            const float p0 = wave_incl_scan(a0, lane); const float t0 = __shfl(p0, 63);
            const float p1 = wave_incl_scan(a1, lane) + t0; const float T = __shfl(p1, 63);
            if (w == 0) { Pf[lane] = p0; Pf[64 + lane] = p1; gf[lane] = rdt[0]; gf[64 + lane] = rdt[1]; itf[lane] = EXPF(p0); itf[64 + lane] = EXPF(p1); }
            else { const float e0 = p0 - a0, e1 = p1 - a1; Eb[lane] = e0; Eb[64 + lane] = e1; gb[lane] = rdt[0]; gb[64 + lane] = rdt[1]; itb[lane] = EXPF(T - e0); itb[64 + lane] = EXPF(T - e1); } }
        if (h + 1 < 8) S3S_LOAD(h + 1);
        SYNC();
        const u32x4 zc0 = *(const u32x4*)(Z + (size_t)(row0 + 16 * w + (lane >> 3)) * 1024 + hg * 64 + (lane & 7) * 8), zc1 = *(const u32x4*)(Z + (size_t)(row0 + 16 * w + (lane >> 3) + 8) * 1024 + hg * 64 + (lane & 7) * 8);
        float pfq[4], ebq[4];
#pragma unroll
        for (int i = 0; i < 4; ++i) { pfq[i] = Pf[w * 16 + 4 * lq + i]; ebq[i] = Eb[w * 16 + 4 * lq + i]; }
#pragma unroll
        for (int ct = 0; ct < 8; ++ct) { const int k = ct * 16 + lc, rel = ct - w;
            const float pk = rel <= 0 ? Pf[k] : 0.f, ek = rel >= 0 ? Eb[k] : 0.f, gfk = rel <= 0 ? gf[k] : 0.f, gbk = rel >= 0 ? gb[k] : 0.f;
#pragma unroll
            for (int i = 0; i < 4; ++i) { const int d = 4 * lq + i - lc; float fac;
                if (rel < 0) fac = EXPF(pfq[i] - pk) * gfk;
                else if (rel > 0) fac = EXPF(ek - ebq[i]) * gbk;
                else fac = d > 0 ? EXPF(pfq[i] - pk) * gfk : (d < 0 ? EXPF(ek - ebq[i]) * gbk : gfk + gbk);
                GLB[(w * 16 + 4 * lq + i) * LDC + k] = (bf16_t)f2bf(gtv(Gt[ct], i) * fac); } }
        WAVE_LDS_FENCE();
        bf16x8 aG[4];
#pragma unroll
        for (int ks = 0; ks < 4; ++ks) aG[ks] = row_frag(GLB, LDC, w * 16, ks * 32, lane);
        float iqf[4], iqb[4];
#pragma unroll
        for (int i = 0; i < 4; ++i) { iqf[i] = itf[w * 16 + 4 * lq + i]; iqb[i] = itb[w * 16 + 4 * lq + i]; }
        WAVE_LDS_FENCE();
        LAS float* OUTW = (LAS float*)(GLB + w * 16 * LDC);
#pragma unroll 1
        for (int pt = 0; pt < 4; ++pt) { f32x4 a1 = {0.f, 0.f, 0.f, 0.f}, af = {0.f, 0.f, 0.f, 0.f}, ab = {0.f, 0.f, 0.f, 0.f};
#pragma unroll
            for (int ks = 0; ks < 4; ++ks) a1 = mfma16(aG[ks], tr_frag(XS, LDX, ks * 32, pt * 16, lane), a1);
#pragma unroll
            for (int ns = 0; ns < 4; ++ns) { af = mfma16(aC[ns], row_frag(STF, LDC, pt * 16, ns * 32, lane), af); ab = mfma16(aC[ns], row_frag(STB, LDC, pt * 16, ns * 32, lane), ab); }
#pragma unroll
            for (int i = 0; i < 4; ++i) OUTW[(4 * lq + i) * (LDC / 2) + pt * 16 + lc] = a1[i] + iqf[i] * af[i] + iqb[i] * ab[i]; }
        WAVE_LDS_FENCE();
        const float dsk = F.pp->in[13][hg]; const float* ng = F.pp->in[14] + hg * 64 + (lane & 7) * 8;
        const f32x4 ng0 = *(const f32x4*)ng, ng1 = *(const f32x4*)(ng + 4);
#pragma unroll
        for (int r = 0; r < 2; ++r) { const int ql = (lane >> 3) + 8 * r, ch = lane & 7; const size_t row = (size_t)(row0 + 16 * w + ql);
            const f32x4 y0 = *(const LAS f32x4*)(OUTW + ql * (LDC / 2) + ch * 8), y1 = *(const LAS f32x4*)(OUTW + ql * (LDC / 2) + ch * 8 + 4);
            f32x4 x0, x1, z0, z1; unpack8(*(const LAS u32x4*)(XS + (16 * w + ql) * LDX + ch * 8), x0, x1); unpack8(r == 0 ? zc0 : zc1, z0, z1);
            f32x4 t0, t1; float ss = 0.f;
#pragma unroll
            for (int i = 0; i < 4; ++i) { t0[i] = (y0[i] + dsk * x0[i]) * siluf_(z0[i]); t1[i] = (y1[i] + dsk * x1[i]) * siluf_(z1[i]); ss += t0[i] * t0[i] + t1[i] * t1[i]; }
            *(u32x4*)(YP + row * 1024 + hg * 64 + ch * 8) = pack8(t0 * ng0, t1 * ng1);
            ss += __shfl_xor(ss, 1); ss += __shfl_xor(ss, 2); ss += __shfl_xor(ss, 4);
            if (ch == 0) SSQ[row * 16 + hg] = ss; }
    }
#undef S3S_LOAD
}

struct MlRegs { u32x4 q[2], k[2], v[4], sf[3], sb[3]; float g[4]; };
DEV void s3v2_ml_load(Frame& F, MlRegs& R, int b, int cc, int hd) {
    const bf16_t* QK = WSP(bf16_t, WS_QK); const bf16_t* V = WSP(bf16_t, WS_V); const float* DTG = WSP(float, WS_DTG);
    int tid_ = F.tid; OPAQUE_V(tid_);
    const int row0 = chunk_row0(b, cc), tid = tid_, lane = tid & 63, w = F.wave;
#pragma unroll
    for (int j = 0; j < 2; ++j) { const int id = tid + NTHR * j; R.q[j] = *(const u32x4*)(QK + (size_t)(row0 + (id >> 3)) * 1024 + hd * 64 + (id & 7) * 8); R.k[j] = *(const u32x4*)(QK + (size_t)(row0 + (id >> 3)) * 1024 + 512 + hd * 64 + (id & 7) * 8); }
#pragma unroll
    for (int j = 0; j < 4; ++j) { const int id = tid + NTHR * j; R.v[j] = *(const u32x4*)(V + (size_t)(row0 + (id >> 4)) * 1024 + hd * 128 + (id & 15) * 8); }
#pragma unroll
    for (int j = 0; j < 3; ++j) { const int id = tid + NTHR * j; if (id < 144 * 8) {
        R.sf[j] = *(const u32x4*)(WSP(bf16_t, WS_STM) + ((size_t)(b * 2 + 0) * NCHT + cc) * STM_CH + (size_t)hd * 9216 + (size_t)id * 8);
        R.sb[j] = *(const u32x4*)(WSP(bf16_t, WS_STM) + ((size_t)(b * 2 + 1) * NCHT + cc) * STM_CH + (size_t)hd * 9216 + (size_t)id * 8); } }
    if (w < 2) { R.g[0] = DTG[(size_t)(row0 + lane) * 64 + 32 + w * 16 + hd]; R.g[1] = DTG[(size_t)(row0 + 64 + lane) * 64 + 32 + w * 16 + hd];
                 R.g[2] = DTG[(size_t)(row0 + lane) * 64 + 32 + w * 16 + 8 + hd]; R.g[3] = DTG[(size_t)(row0 + 64 + lane) * 64 + 32 + w * 16 + 8 + hd]; }
}
DEV void s3v2_ml_item(Frame& F, MlRegs& R, int b, int cc, int hd, bool has_next, int nb, int ncc, int nhd) {
    constexpr int LDQ = 72, LDG = 136, LDV = 144;
    LAS bf16_t* CQ = (LAS bf16_t*)F.lds;
    LAS bf16_t* GLB = CQ + 128 * LDQ;
    LAS bf16_t* XS = GLB + 128 * LDG;
    LAS bf16_t* STF = XS + 128 * LDV;
    LAS bf16_t* STB = STF + 144 * LDQ;
    LAS float* Pf = (LAS float*)(STB + 144 * LDQ); LAS float* Eb = Pf + 128; LAS float* gf = Eb + 128; LAS float* gb = gf + 128; LAS float* itf = gb + 128; LAS float* itb = itf + 128;
    int tid_ = F.tid; OPAQUE_V(tid_);
    const int row0 = chunk_row0(b, cc), w = F.wave, tid = tid_, lane = tid & 63, lq = lane >> 4, lc = lane & 15;
    SYNC();
#pragma unroll
    for (int j = 0; j < 2; ++j) { const int id = tid + NTHR * j; *(LAS u32x4*)(CQ + (id >> 3) * LDQ + (id & 7) * 8) = R.q[j]; *(LAS u32x4*)(GLB + (id >> 3) * LDQ + (id & 7) * 8) = R.k[j]; }
#pragma unroll
    for (int j = 0; j < 4; ++j) { const int id = tid + NTHR * j; *(LAS u32x4*)(XS + (id >> 4) * LDV + (id & 15) * 8) = R.v[j]; }
    if (tid < 256) { const int k = tid >> 1, hf = tid & 1; u32x4 o = {0u, 0u, 0u, 0u}; if (hf == 0) o.x = 0x3F80u; *(LAS u32x4*)(XS + k * LDV + 128 + hf * 8) = o; }
#pragma unroll
    for (int j = 0; j < 3; ++j) { const int id = tid + NTHR * j; if (id < 144 * 8) { *(LAS u32x4*)(STF + (id >> 3) * LDQ + (id & 7) * 8) = R.sf[j]; *(LAS u32x4*)(STB + (id >> 3) * LDQ + (id & 7) * 8) = R.sb[j]; } }
    if (w < 2) { const float ibv = F.pp->in[17][w * 8 + hd], fbv = F.pp->in[18][w * 8 + hd];
        const float a0 = logsigmoidf_(R.g[2] + fbv), a1 = logsigmoidf_(R.g[3] + fbv), g0 = EXPF(R.g[0] + ibv), g1 = EXPF(R.g[1] + ibv);
        const float p0 = wave_incl_scan(a0, lane); const float t0 = __shfl(p0, 63);
        const float p1 = wave_incl_scan(a1, lane) + t0; const float T = __shfl(p1, 63);
        if (w == 0) { Pf[lane] = p0; Pf[64 + lane] = p1; gf[lane] = g0; gf[64 + lane] = g1; itf[lane] = EXPF(p0); itf[64 + lane] = EXPF(p1); }
        else { const float e0 = p0 - a0, e1 = p1 - a1; Eb[lane] = e0; Eb[64 + lane] = e1; gb[lane] = g0; gb[64 + lane] = g1; itb[lane] = EXPF(T - e0); itb[64 + lane] = EXPF(T - e1); } }
    if (has_next) s3v2_ml_load(F, R, nb, ncc, nhd);
    SYNC();
    bf16x8 aC[2];
#pragma unroll
    for (int ns = 0; ns < 2; ++ns) aC[ns] = row_frag(CQ, LDQ, w * 16, ns * 32, lane);
    u32x2 Gt[8];
#pragma unroll
    for (int ct = 0; ct < 8; ++ct) { f32x4 z = {0.f, 0.f, 0.f, 0.f};
#pragma unroll
        for (int ns = 0; ns < 2; ++ns) z = mfma16(aC[ns], row_frag(GLB, LDQ, ct * 16, ns * 32, lane), z);
        Gt[ct] = pack4(z); }
    SYNC();
    u32x4 oc[4];
#pragma unroll
    for (int r = 0; r < 4; ++r) oc[r] = *(const u32x4*)(WSP(bf16_t, WS_O) + (size_t)(row0 + 16 * w + (lane >> 4) + 4 * r) * 1024 + hd * 128 + (lane & 15) * 8);
    bf16x8 aG[2][4]; f32x4 rden[2]; float iq[2][4];
#pragma unroll
    for (int dir = 0; dir < 2; ++dir) {
        const LAS float* PE = dir == 0 ? Pf : Eb; const LAS float* gg = dir == 0 ? gf : gb; const LAS float* it = dir == 0 ? itf : itb; const LAS bf16_t* ST = dir == 0 ? STF : STB;
        float peq[4];
#pragma unroll
        for (int i = 0; i < 4; ++i) { peq[i] = PE[w * 16 + 4 * lq + i]; iq[dir][i] = it[w * 16 + 4 * lq + i]; }
        WAVE_LDS_FENCE();
#pragma unroll
        for (int ct = 0; ct < 8; ++ct) { const int k = ct * 16 + lc, rel = ct - w; const bool tile_on = dir == 0 ? rel <= 0 : rel >= 0;
            if (tile_on) { const float pek = PE[k], gk = gg[k];
#pragma unroll
                for (int i = 0; i < 4; ++i) { const int d = 4 * lq + i - lc; const bool on = rel != 0 || (dir == 0 ? d >= 0 : d <= 0);
                    const float ex = dir == 0 ? peq[i] - pek : pek - peq[i];
                    GLB[(w * 16 + 4 * lq + i) * LDG + k] = (bf16_t)f2bf(on ? gtv(Gt[ct], i) * EXPF(ex) * gk : 0.f); }
            } else {
#pragma unroll
                for (int i = 0; i < 4; ++i) GLB[(w * 16 + 4 * lq + i) * LDG + k] = (bf16_t)0; } }
        WAVE_LDS_FENCE();
#pragma unroll
        for (int ks = 0; ks < 4; ++ks) aG[dir][ks] = row_frag(GLB, LDG, w * 16, ks * 32, lane);
        f32x4 a1 = {0.f, 0.f, 0.f, 0.f}, a2 = {0.f, 0.f, 0.f, 0.f};
#pragma unroll
        for (int ks = 0; ks < 4; ++ks) a1 = mfma16(aG[dir][ks], tr_frag(XS, LDV, ks * 32, 128, lane), a1);
#pragma unroll
        for (int ns = 0; ns < 2; ++ns) a2 = mfma16(aC[ns], row_frag(ST, LDQ, 128, ns * 32, lane), a2);
#pragma unroll
        for (int i = 0; i < 4; ++i) { const float dv = a1[i] + iq[dir][i] * a2[i]; rden[dir][i] = RCPF(fmaxf(fabsf(__shfl(dv, lane & 48)), 1.0f)); }
    }
    WAVE_LDS_FENCE();
    float ss[4] = {0.f, 0.f, 0.f, 0.f};
#pragma unroll 1
    for (int pt = 0; pt < 8; ++pt) { f32x4 af = {0.f, 0.f, 0.f, 0.f}, ab = {0.f, 0.f, 0.f, 0.f}, sf = {0.f, 0.f, 0.f, 0.f}, sb = {0.f, 0.f, 0.f, 0.f};
#pragma unroll
        for (int ks = 0; ks < 4; ++ks) { const bf16x8 xb = tr_frag(XS, LDV, ks * 32, pt * 16, lane); af = mfma16(aG[0][ks], xb, af); ab = mfma16(aG[1][ks], xb, ab); }
#pragma unroll
        for (int ns = 0; ns < 2; ++ns) { sf = mfma16(aC[ns], row_frag(STF, LDQ, pt * 16, ns * 32, lane), sf); sb = mfma16(aC[ns], row_frag(STB, LDQ, pt * 16, ns * 32, lane), sb); }
#pragma unroll
        for (int i = 0; i < 4; ++i) { const float hv = (af[i] + iq[0][i] * sf[i]) * rden[0][i] + (ab[i] + iq[1][i] * sb[i]) * rden[1][i]; ss[i] += hv * hv;
            GLB[(w * 16 + 4 * lq + i) * LDG + pt * 16 + lc] = (bf16_t)f2bf(hv); } }
    LAS float* rsw = itb + 128 + w * 16;
#pragma unroll
    for (int i = 0; i < 4; ++i) { float sv = ss[i]; sv += __shfl_xor(sv, 1); sv += __shfl_xor(sv, 2); sv += __shfl_xor(sv, 4); sv += __shfl_xor(sv, 8);
        if (lc == 0) rsw[4 * lq + i] = RSQF(sv * (1.f / 128.f) + EPS); }
    WAVE_LDS_FENCE();
    bf16_t* HP = WSP(bf16_t, WS_HP); const float* ng = F.pp->in[19] + hd * 128 + (lane & 15) * 8;
    const f32x4 ng0 = *(const f32x4*)ng, ng1 = *(const f32x4*)(ng + 4);
#pragma unroll
    for (int r = 0; r < 4; ++r) { const int ql = (lane >> 4) + 4 * r, ch = lane & 15; const size_t row = (size_t)(row0 + 16 * w + ql); const float rsq = rsw[ql];
        f32x4 h0, h1, o0, o1; unpack8(*(const LAS u32x4*)(GLB + (w * 16 + ql) * LDG + ch * 8), h0, h1); unpack8(oc[r], o0, o1);
        *(u32x4*)(HP + row * 1024 + hd * 128 + ch * 8) = pack8(h0 * rsq * ng0 * o0, h1 * rsq * ng1 * o1); }
}
DEV void p6v2_outputs(Frame& F) {
    LAS float* aneg_l = (LAS float*)(F.lds + LDS_BYTES - 256);
    if (F.tid < 32) aneg_l[F.tid] = -EXPF(F.pp->in[12][F.tid]);
    SYNC();
    const int nS = BATCH * NCH * 2, nM = BATCH * NCH * 8;
#pragma unroll 1
    for (int it = F.bid; it < nS; it += F.G) { const int b = it / (NCH * 2), r = it % (NCH * 2); s3v2_ssd(F, b, r / 2, r % 2, (const float*)aneg_l); }
    SYNC();
    MlRegs R;
    if (F.bid < nM) { const int it = F.bid; s3v2_ml_load(F, R, it / (NCH * 8), (it % (NCH * 8)) / 8, it % 8); }
#pragma unroll 1
    for (int it = F.bid; it < nM; it += F.G) { const int nx = it + F.G; const bool hn = nx < nM;
        s3v2_ml_item(F, R, it / (NCH * 8), (it % (NCH * 8)) / 8, it % 8, hn, nx / (NCH * 8), (nx % (NCH * 8)) / 8, nx % 8); }
    SYNC();
}

template <bool ML> struct S1K { static constexpr int NN = ML ? 64 : 128, LDB = ML ? 80 : 144, NHS = ML ? 1 : 4, PD = ML ? 128 : 64, XC = ML ? 144 : 256, LDXW = ML ? 144 : 272, NQ = ML ? 1 : 2, NXR = ML ? 4 : 8, NBK = ML ? 2 : 4, PPH = ML ? 144 : 64, CPR = NHS * PD / 8; };
template <bool ML> struct S1Regs { u32x4 x[S1K<ML>::NXR]; u32x4 bk[S1K<ML>::NBK]; float g[4]; };
DEV void s1_decode(int code, int& b, int& cc, int& gi) { b = code >> 20; cc = (code >> 8) & 0xfff; gi = code & 0xff; }
template <bool ML> DEV void s1_load(Frame& F, S1Regs<ML>& R, int code, int hq) {
    typedef S1K<ML> K; int b, cc, gi; s1_decode(code, b, cc, gi);
    const bf16_t* XBC = WSP(bf16_t, WS_XBC); const bf16_t* QK = WSP(bf16_t, WS_QK); const bf16_t* V = WSP(bf16_t, WS_V); const float* DTG = WSP(float, WS_DTG);
    int tid_ = F.tid; OPAQUE_V(tid_); const int tid = tid_, lane = tid & 63, w = F.wave, row0 = chunk_row0(b, cc);
    const bool isctx = cc >= NCH; const int seg0 = NLAT + b * CTXL, kseg0 = (cc - NCH) * CHUNK;
    const bf16_t* Xsrc = ML ? V + gi * 128 : XBC + (gi * 8 + hq * 4) * 64; const int ldx = ML ? 1024 : 1536;
    if (ML || !isctx) {
#pragma unroll
        for (int j = 0; j < K::NXR; ++j) { const int id = tid + NTHR * j; R.x[j] = *(const u32x4*)(Xsrc + (size_t)(row0 + id / K::CPR) * ldx + (id % K::CPR) * 8); }
    } else { static_assert(NTHR % K::CPR == 0, "a thread's chunks share their columns");
        const int col = (gi * 8 + hq * 4) * 64 + (tid % K::CPR) * 8; CtxW cwv; ctx_conv_prep(cwv, F.pp->in[9], F.pp->in[10], 1536, col);
#pragma unroll
        for (int j = 0; j < K::NXR; ++j) { const int id = tid + NTHR * j; R.x[j] = ctx_conv_chunk(cwv, XBC, 1536, seg0, kseg0 + id / K::CPR, col); } }
    if (hq == 0) { const bf16_t* Bsrc = ML ? QK + 512 + gi * 64 : XBC + 1024 + gi * 128; const int ldb = ML ? 1024 : 1536;
        if (!isctx) {
#pragma unroll
            for (int j = 0; j < K::NBK; ++j) { const int id = tid + NTHR * j, k = id / (K::NN / 8), n8 = id % (K::NN / 8); R.bk[j] = *(const u32x4*)(Bsrc + (size_t)(row0 + k) * ldb + n8 * 8); }
        } else { static_assert(NTHR % (K::NN / 8) == 0, "a thread's chunks share their columns");
            const int col = (ML ? 512 + gi * 64 : 1024 + gi * 128) + (tid % (K::NN / 8)) * 8; CtxW cwv; ctx_conv_prep(cwv, ML ? F.pp->in[15] : F.pp->in[9], ML ? F.pp->in[16] : F.pp->in[10], ldb, col);
#pragma unroll
            for (int j = 0; j < K::NBK; ++j) { const int id = tid + NTHR * j; R.bk[j] = ctx_conv_chunk(cwv, ML ? QK : XBC, ldb, seg0, kseg0 + id / (K::NN / 8), col); } } }
    if (!ML) { const int dir = w >> 2, hg = gi * 8 + hq * 4 + (w & 3);
        R.g[0] = DTG[(size_t)(row0 + lane) * 64 + dir * 16 + hg]; R.g[1] = DTG[(size_t)(row0 + 64 + lane) * 64 + dir * 16 + hg]; }
    else if (w < 2) { R.g[0] = DTG[(size_t)(row0 + lane) * 64 + 32 + w * 16 + gi]; R.g[1] = DTG[(size_t)(row0 + 64 + lane) * 64 + 32 + w * 16 + gi];
                      R.g[2] = DTG[(size_t)(row0 + lane) * 64 + 32 + w * 16 + 8 + gi]; R.g[3] = DTG[(size_t)(row0 + 64 + lane) * 64 + 32 + w * 16 + 8 + gi]; }
}
template <bool ML> DEV void s1_stage(Frame& F, S1Regs<ML>& R, int code, int hq, bool has_next, int ncode, int nhq, const float* aneg) {
    typedef S1K<ML> K; int b, cc, gi; s1_decode(code, b, cc, gi);
    LAS bf16_t* BKN = (LAS bf16_t*)F.lds;
    LAS bf16_t* XW = BKN + 128 * K::LDB;
    LAS float* wl = (LAS float*)(XW + 128 * K::LDXW);
    int tid_ = F.tid; OPAQUE_V(tid_); const int tid = tid_, lane = tid & 63, w = F.wave;
    SYNC();
    if (hq == 0) {
#pragma unroll
        for (int j = 0; j < K::NBK; ++j) { const int id = tid + NTHR * j; *(LAS u32x4*)(BKN + (id / (K::NN / 8)) * K::LDB + (id % (K::NN / 8)) * 8) = R.bk[j]; } }
    u32x4 xc[K::NXR];
#pragma unroll
    for (int j = 0; j < K::NXR; ++j) xc[j] = R.x[j];
    float gc[4];
#pragma unroll
    for (int j = 0; j < 4; ++j) gc[j] = R.g[j];
    if (has_next) s1_load<ML>(F, R, ncode, nhq);
    if (!ML || w < 2) { const int dir = ML ? w : (w >> 2), hl = ML ? 0 : (w & 3), hg = ML ? gi : gi * 8 + hq * 4 + hl;
        float a0, a1, g0, g1;
        if (!ML) { const float db = F.pp->in[11][dir * 16 + hg], an = aneg[dir * 16 + hg]; g0 = softplusf_(gc[0] + db); g1 = softplusf_(gc[1] + db); a0 = g0 * an; a1 = g1 * an; }
        else { const float ibv = F.pp->in[17][dir * 8 + hg], fbv = F.pp->in[18][dir * 8 + hg]; g0 = EXPF(gc[0] + ibv); g1 = EXPF(gc[1] + ibv); a0 = logsigmoidf_(gc[2] + fbv); a1 = logsigmoidf_(gc[3] + fbv); }
        const float p0 = wave_incl_scan(a0, lane); const float t0 = __shfl(p0, 63);
        const float p1 = wave_incl_scan(a1, lane) + t0; const float T = __shfl(p1, 63);
        float w0, w1;
        if (dir == 0) { w0 = EXPF(T - p0) * g0; w1 = EXPF(T - p1) * g1; } else { w0 = EXPF(p0 - a0) * g0; w1 = EXPF(p1 - a1) * g1; }
        wl[(dir * K::NHS + hl) * 128 + lane] = w0; wl[(dir * K::NHS + hl) * 128 + 64 + lane] = w1;
        if (lane == 0) { float* dec = ML ? WSP(float, WS_DECM) + ((size_t)(b * 2 + dir) * NCHT + cc) * 8 + hg : WSP(float, WS_DECS) + ((size_t)(b * 2 + dir) * NCHT + cc) * 16 + hg; *dec = EXPF(T); } }
    SYNC();
#pragma unroll 1
    for (int dir = 0; dir < 2; ++dir) {
        if (dir == 1) SYNC();
#pragma unroll
        for (int j = 0; j < K::NXR; ++j) { const int id = tid + NTHR * j, k = id / K::CPR, c8 = id % K::CPR; const float wk = wl[(dir * K::NHS + (c8 * 8) / K::PD) * 128 + k];
            f32x4 v0, v1; unpack8(xc[j], v0, v1); *(LAS u32x4*)(XW + k * K::LDXW + c8 * 8) = pack8(v0 * wk, v1 * wk); }
        if (ML) { if (tid < 256) { const int k = tid >> 1, hf = tid & 1; u32x4 o = {0u, 0u, 0u, 0u}; if (hf == 0) o.x = f2bf(wl[dir * 128 + k]); *(LAS u32x4*)(XW + k * K::LDXW + 128 + hf * 8) = o; } }
        SYNC();
        constexpr int RT = K::NN / 16, CT = K::XC / 16;
        for (int ct = w; ct < CT; ct += 8) {
            bf16x8 bx[4];
#pragma unroll
            for (int ks = 0; ks < 4; ++ks) bx[ks] = tr_frag(XW, K::LDXW, ks * 32, ct * 16, lane);
#pragma unroll
            for (int u = 0; u < RT / 2; ++u) { f32x4 acc0 = {0.f, 0.f, 0.f, 0.f}, acc1 = {0.f, 0.f, 0.f, 0.f};
#pragma unroll
                for (int ks = 0; ks < 4; ++ks) { acc0 = mfma16(tr_frag8(BKN, K::LDB, ks * 32, u * 32, lane), bx[ks], acc0); acc1 = mfma16(tr_frag8(BKN, K::LDB, ks * 32, u * 32 + 4, lane), bx[ks], acc1); }
                const int pg = ct * 16 + (lane & 15), hl = pg / K::PPH, p = pg % K::PPH, hg = ML ? gi : gi * 8 + hq * 4 + hl, n = u * 32 + 8 * (lane >> 4);
                bf16_t* dst = ML ? WSP(bf16_t, WS_STM) + ((size_t)(b * 2 + dir) * NCHT + cc) * STM_CH + ((size_t)hg * 144 + p) * 64 + n
                                 : WSP(bf16_t, WS_STS) + ((size_t)(b * 2 + dir) * NCHT + cc) * STS_CH + ((size_t)hg * 64 + p) * 128 + n;
                *(u32x4*)dst = pack8(acc0, acc1); }
        }
    }
}
template <bool ML> DEV int s1_build_list(Frame& F, LAS int* list) {
    const int GPB = ML ? 8 : 2, nL = BATCH * NCH * GPB, nC = BATCH * NCHC * GPB, skew = ML ? (BATCH * NCHC * 2) % F.G : 0;
    int n = 0;
    for (int it = F.bid; it < nL; it += F.G) { const int b = it / (NCH * GPB), r = it % (NCH * GPB); if (F.tid == 0) list[n] = (b << 20) | ((r / GPB) << 8) | (r % GPB); ++n; }
    for (int it = ((F.G - 1 - F.bid) + F.G - skew) % F.G; it < nC; it += F.G) { const int b = it / (NCHC * GPB), r = it % (NCHC * GPB); if (F.tid == 0) list[n] = (b << 20) | ((NCH + r / GPB) << 8) | (r % GPB); ++n; }
    return n;
}
template <bool ML> DEV void s1_run(Frame& F, const float* aneg, LAS int* list) {
    typedef S1K<ML> K;
    const int n = s1_build_list<ML>(F, list);
    SYNC();
    const int nst = n * K::NQ;
    S1Regs<ML> R;
    if (nst > 0) s1_load<ML>(F, R, list[0], 0);
#pragma unroll 1
    for (int st = 0; st < nst; ++st) { const int nx = st + 1; const bool hn = nx < nst;
        s1_stage<ML>(F, R, list[st / K::NQ], st % K::NQ, hn, hn ? list[nx / K::NQ] : 0, nx % K::NQ, aneg); }
    SYNC();
}
DEV void p4v2_local_states(Frame& F) {
    LAS float* aneg_l = (LAS float*)(F.lds + LDS_BYTES - 256);
    LAS int* list = (LAS int*)(F.lds + LDS_BYTES - 1024);
    if (F.tid < 32) aneg_l[F.tid] = -EXPF(F.pp->in[12][F.tid]);
    SYNC();
    s1_run<false>(F, (const float*)aneg_l, list);
    s1_run<true>(F, (const float*)aneg_l, list);
}

DEV void p12_route(Frame& F) {
    const float* LOGIT = WSP(float, WS_LOG); const float* rb = F.pp->in[24];
    int* ae = WSP(int, WS_ASGE); int* ar = WSP(int, WS_ASGR); float* aw = WSP(float, WS_ASGW);
    constexpr int LDT = NEXP + 1;
    LAS int* cntL = (LAS int*)(F.lds + 2 * 64 * LDT * 4);
    for (int e = F.tid; e < NEXP; e += NTHR) cntL[e] = 0;
    SYNC();
    constexpr int GS = NEXP / 8;
    const float NEG = -3.0e38f;
    for (int t = F.bid * 128 + F.tid; F.tid < 128 && t < NLAT; t += F.G * 128) {
        LAS float* tile = (LAS float*)F.lds + F.wave * (64 * LDT);
        { const int tw = t - F.lane;
          WAVE_LDS_FENCE();
          static_assert(NEXP <= 256, "one 16-byte piece per lane and row");
#pragma unroll 1
          for (int r0 = 0; r0 < 64; r0 += 16) { f32x4 v[16];
              const int c = F.lane * 4;
              if (c < NEXP) {
#pragma unroll
                  for (int r = 0; r < 16; ++r) v[r] = *(const f32x4*)(LOGIT + (size_t)(tw + r0 + r) * NEXP + c);
#pragma unroll
                  for (int r = 0; r < 16; ++r) { LAS float* d = tile + (r0 + r) * LDT + c; d[0] = v[r].x; d[1] = v[r].y; d[2] = v[r].z; d[3] = v[r].w; } } }
          WAVE_LDS_FENCE(); }
        const LAS float* lg = tile + F.lane * LDT;
        float gs[8];
#pragma unroll
        for (int g = 0; g < 8; ++g) { float m1 = NEG, m2 = NEG;
#pragma unroll 4
            for (int j = 0; j < GS; ++j) { const float v = sigmoidf_(lg[g * GS + j]) + rb[g * GS + j]; if (v > m1) { m2 = m1; m1 = v; } else if (v > m2) m2 = v; }
            gs[g] = m1 + m2; }
        unsigned selmask = 0u;
#pragma unroll
        for (int g = 0; g < 8; ++g) { int rank = 0;
#pragma unroll
            for (int gp = 0; gp < 8; ++gp) rank += (gs[gp] > gs[g] || (gs[gp] == gs[g] && gp < g)) ? 1 : 0;
            if (rank < TOPKG) selmask |= 1u << g; }
        float tv[8]; int ti[8];
#pragma unroll
        for (int i = 0; i < 8; ++i) { tv[i] = NEG; ti[i] = 0; }
        unsigned smk = selmask;
#pragma unroll 1
        for (int sg = 0; sg < TOPKG; ++sg) { const int g = __builtin_ctz(smk); smk &= smk - 1u;
#pragma unroll 2
            for (int j = 0; j < GS; ++j) { const int e = g * GS + j; float cv = sigmoidf_(lg[e]) + rb[e]; int ce = e;
#pragma unroll
                for (int i = 0; i < 8; ++i) { const bool gtv = cv > tv[i]; const float ov = tv[i]; const int oi = ti[i];
                    tv[i] = gtv ? cv : ov; ti[i] = gtv ? ce : oi; cv = gtv ? ov : cv; ce = gtv ? oi : ce; } }
        }
        float sc[8], ssum = 0.f;
#pragma unroll
        for (int i = 0; i < 8; ++i) { sc[i] = sigmoidf_(lg[ti[i]]); ssum += sc[i]; }
        const float inv = 2.5f / ssum;
#pragma unroll
        for (int i = 0; i < 8; ++i) { const int rk = ATOMIC_ADD_LDS(&cntL[ti[i]], 1); const int a = t * TOPK + i; ae[a] = ti[i]; ar[a] = rk; aw[a] = sc[i] * inv; }
    }
    SYNC();
    int* cm = WSP(int, WS_CMAT) + (size_t)F.bid * NEXP;
    for (int e = F.tid; e < NEXP; e += NTHR) cm[e] = cntL[e];
}
DEV void p13_slots(Frame& F) {
    int* ctl = WSP(int, WS_CTL); const int* cmat = WSP(int, WS_CMAT);
    LAS int* cl = (LAS int*)F.lds; LAS int* tb = cl + NEXP; LAS int* pl = tb + NEXP + 1;
    for (int e = F.tid; e < NEXP; e += NTHR) { int tot = 0, pre = 0;
        for (int b = 0; b < F.G; ++b) { const int v = cmat[(size_t)b * NEXP + e]; tot += v; pre += b < F.bid ? v : 0; }
        cl[e] = tot; pl[e] = pre; }
    SYNC();
    if (F.wave == 0) {
        int loc[EPL], sum = 0;
#pragma unroll
        for (int j = 0; j < EPL; ++j) { loc[j] = (cl[F.lane * EPL + j] + 255) >> 8; sum += loc[j]; }
        int inc = sum;
#pragma unroll
        for (int d = 1; d < 64; d <<= 1) { const int t = __shfl_up(inc, d); if (F.lane >= d) inc += t; }
        int run = inc - sum;
#pragma unroll
        for (int j = 0; j < EPL; ++j) { tb[F.lane * EPL + j] = run; run += loc[j]; }
        if (F.lane == 63) tb[NEXP] = run;
    }
    SYNC();
    const int* ae = WSP(int, WS_ASGE); const int* ar = WSP(int, WS_ASGR); const float* aw = WSP(float, WS_ASGW);
    int* stok = WSP(int, WS_STOK); int* sdst = WSP(int, WS_SDST); float* sw = WSP(float, WS_SW); int* texp = WSP(int, WS_TEXP);
    for (int t0 = F.bid * 128; t0 < NLAT; t0 += F.G * 128)
        for (int i = F.tid; i < 128 * TOPK; i += NTHR) { const int a = t0 * TOPK + i; if (a < NASG) { const int e = ae[a];
            const int slot = tb[e] * 256 + pl[e] + ar[a]; stok[slot] = a / TOPK; sdst[slot] = a; sw[slot] = aw[a]; } }
    for (int e = F.bid; e < NEXP; e += F.G) {
        for (int sl = tb[e] * 256 + cl[e] + F.tid; sl < tb[e + 1] * 256; sl += NTHR) { stok[sl] = 0; sdst[sl] = -1; sw[sl] = 0.f; }
        for (int t = tb[e] + F.tid; t < tb[e + 1]; t += NTHR) texp[t] = e;
    }
    if (F.bid == 0 && F.tid == 0) { ctl[1024] = tb[NEXP]; }
}
DEV void p_final(Frame& F) {
    const float* mod = WSP(float, WS_MOD); const bf16_t* Y = WSP(bf16_t, WS_Y); const bf16_t* YS = WSP(bf16_t, WS_YS); const float* gf = F.pp->in[31];
    const int gw = F.bid * 8 + F.wave, NGW = F.G * 8, lane = F.lane;
    for (int t = gw; t < NLAT; t += NGW) {
        const float* gate = mod + (t / SEQ) * 6144 + 5 * 1024;
        u32x4 yr[2][TOPK + 1];
#pragma unroll
        for (int j = 0; j < 2; ++j) {
#pragma unroll
            for (int k = 0; k < TOPK; ++k) yr[j][k] = *((const u32x4*)(Y + (size_t)(t * TOPK + k) * 1024) + lane + 64 * j);
            yr[j][TOPK] = *((const u32x4*)(YS + (size_t)t * 1024) + lane + 64 * j); }
        f32x4 v[2][2]; float ssq = 0.f;
#pragma unroll
        for (int j = 0; j < 2; ++j) { f32x4 a0 = {0.f, 0.f, 0.f, 0.f}, a1 = {0.f, 0.f, 0.f, 0.f};
#pragma unroll
            for (int k = 0; k <= TOPK; ++k) { f32x4 p0, p1; unpack8(yr[j][k], p0, p1); a0 += p0; a1 += p1; }
            const f32x4* xr = (const f32x4*)(F.out + (size_t)t * DM) + 2 * lane + 128 * j; const f32x4* gr = (const f32x4*)gate + 2 * lane + 128 * j;
            v[j][0] = xr[0] + gr[0] * a0; v[j][1] = xr[1] + gr[1] * a1;
#pragma unroll
            for (int h = 0; h < 2; ++h) ssq += (v[j][h].x * v[j][h].x + v[j][h].y * v[j][h].y) + (v[j][h].z * v[j][h].z + v[j][h].w * v[j][h].w); }
        const float rstd = RSQF(wave_sum(ssq) * (1.f / DM) + EPS);
#pragma unroll
        for (int j = 0; j < 2; ++j) { f32x4* orow = (f32x4*)(F.out + (size_t)t * DM) + 2 * lane + 128 * j; const f32x4* gg = (const f32x4*)gf + 2 * lane + 128 * j;
            orow[0] = v[j][0] * rstd * gg[0]; orow[1] = v[j][1] * rstd * gg[1]; }
    }
}

#ifndef HOST_EMU
#define XB_TMO      128
#define XB_XCNT(j)  (256  + 64 * (j))
#define XB_XSUB(j)  (1280 + 64 * (j))
#define XB_XGEN(j)  (2304 + 64 * (j))
#define XB_TOP      3328
#define XB_TOPGEN   3392
#define XCD_BAR_WORDS 3456
#define XB_SPIN_CAP (1u << 18)
__device__ __forceinline__ unsigned xb_ld(unsigned* p)              { return __hip_atomic_load(p, __ATOMIC_RELAXED, __HIP_MEMORY_SCOPE_AGENT); }
__device__ __forceinline__ unsigned xb_add(unsigned* p, unsigned v) { return __hip_atomic_fetch_add(p, v, __ATOMIC_RELAXED, __HIP_MEMORY_SCOPE_AGENT); }
__device__ __forceinline__ unsigned xb_xcc_id() { return (unsigned)__builtin_amdgcn_s_getreg((3 << 11) | 20) & 0xFu; }
#define XB_SPIN(cond, bar) do { unsigned _sp = 0; while (cond) { __builtin_amdgcn_s_sleep(1); \
    if ((++_sp & 255u) == 0u) { if (xb_ld(&(bar)[XB_TMO])) break; if (_sp > XB_SPIN_CAP) { atomicAdd(&(bar)[XB_TMO], 1u); break; } } } } while (0)
struct XcdBarrier { unsigned* bar; unsigned x; volatile LAS unsigned* st; };
__device__ __forceinline__ XcdBarrier xcd_barrier_post(unsigned* bar, volatile LAS unsigned* st) {
    XcdBarrier b; b.bar = bar; b.x = xb_xcc_id(); b.st = st;
    if (threadIdx.x == 0) (void)xb_add(&bar[XB_XCNT(b.x)], 1u);
    return b;
}
__device__ __forceinline__ void xcd_barrier_complete(unsigned* bar, unsigned x, unsigned& nloc, unsigned& nx) {
    const unsigned G = gridDim.x * gridDim.y * gridDim.z;
    unsigned sum, cnt, mine, sp = 0u;
    for (;;) {
        sum = 0u; cnt = 0u; mine = 0u;
#pragma unroll
        for (unsigned j = 0; j < 16; ++j) { const unsigned c = xb_ld(&bar[XB_XCNT(j)]); sum += c; cnt += (c > 0u) ? 1u : 0u; mine = (j == x) ? c : mine; }
        if (sum == G) break;
        __builtin_amdgcn_s_sleep(1);
        if ((++sp & 255u) == 0u) { if (xb_ld(&bar[XB_TMO])) break; if (sp > XB_SPIN_CAP) { atomicAdd(&bar[XB_TMO], 1u); break; } }
    }
    nloc = mine > 0u ? mine : 1u; nx = cnt > 0u ? cnt : 1u;
}
__device__ __forceinline__ void xcd_barrier(const XcdBarrier& b) {
    asm volatile("s_waitcnt vmcnt(0)" ::: "memory");
    __syncthreads();
    if (threadIdx.x == 0) {
        unsigned* bar = b.bar;
        __builtin_amdgcn_s_waitcnt(0);
        unsigned nloc = b.st[0], nx = b.st[1];
        if (nloc == 0u) { xcd_barrier_complete(bar, b.x, nloc, nx); b.st[0] = nloc; b.st[1] = nx; }
        const unsigned old = xb_add(&bar[XB_XSUB(b.x)], 1u);
        const unsigned gen = old / nloc;
        if (old + 1u == (gen + 1u) * nloc) {
            __builtin_amdgcn_fence(__ATOMIC_RELEASE, "agent");
            asm volatile("s_waitcnt vmcnt(0)" ::: "memory");
            const unsigned og = xb_add(&bar[XB_TOP], 1u);
            const unsigned tg = og / nx;
            if (og + 1u == (tg + 1u) * nx) xb_add(&bar[XB_TOPGEN], 1u);
            else XB_SPIN(xb_ld(&bar[XB_TOPGEN]) == tg, bar);
            __builtin_amdgcn_fence(__ATOMIC_ACQUIRE, "agent");
            xb_add(&bar[XB_XGEN(b.x)], 1u);
            asm volatile("s_waitcnt vmcnt(0)" ::: "memory");
        } else {
            XB_SPIN(xb_ld(&bar[XB_XGEN(b.x)]) == gen, bar);
            __builtin_amdgcn_fence(__ATOMIC_ACQUIRE, "agent");
            asm volatile("s_waitcnt vmcnt(0)" ::: "memory");
        }
    }
    __syncthreads();
}
#endif

#ifndef HOST_EMU
template <class T> __device__ __forceinline__ T* uni_ptr(T* p) { const unsigned long long v = (unsigned long long)p; const unsigned lo = __builtin_amdgcn_readfirstlane((unsigned)v), hi = __builtin_amdgcn_readfirstlane((unsigned)(v >> 32)); return (T*)(((unsigned long long)hi << 32) | lo); }
#endif
#ifndef HOST_EMU
constexpr int WS_BAR_OFF = 16384;
constexpr int LDS_BARST = LDS_BYTES - 64;
#ifndef TPROBE_LO
#define TPROBE_LO -2
#define TPROBE_HI -2
#define TPROBE_MUL 0
#endif
__global__ void __launch_bounds__(NTHR, 2) fwd_megakernel(Params prm) {
    extern __shared__ __attribute__((aligned(16))) unsigned char lds_raw[];
    if (threadIdx.x < 4) ((LAS unsigned*)((LAS unsigned char*)lds_raw + LDS_BARST))[threadIdx.x] = 0u;
    __syncthreads();
    XcdBarrier gbar = xcd_barrier_post((unsigned*)(prm.ws + WS_CTL + WS_BAR_OFF), (volatile LAS unsigned*)((LAS unsigned char*)lds_raw + LDS_BARST));
    unsigned long long tp0 = 0ull, tp1 = 0ull;
    if (TPROBE_LO == 0) tp0 = __builtin_amdgcn_s_memrealtime();
#define GRID_SYNC() xcd_barrier(gbar)
#define PROBE_END(k) do { if ((k) == TPROBE_LO - 1) tp0 = __builtin_amdgcn_s_memrealtime(); if ((k) == TPROBE_HI) tp1 = __builtin_amdgcn_s_memrealtime(); } while (0)
#else
void fwd_megakernel(Params prm) {
    unsigned char* lds_raw = emu_lds();
#define GRID_SYNC() do {} while (0)
#define PROBE_END(k) do {} while (0)
#endif
    Frame F;
    F.lds = (LAS unsigned char*)lds_raw; F.tid = TID; F.lane = F.tid & 63; F.wave = RFL(F.tid >> 6); F.G = NBLK; F.bid = BID;
    F.pp = &prm;
    F.out = prm.out; F.ws = prm.ws;
    const int lo = prm.ph_lo, hi = prm.ph_hi;
#ifndef PH_MASK
#define PH_MASK 0xFFFFFFu
#endif
#define IN(k) ((((PH_MASK) >> (k)) & 1u) && lo <= (k) && (k) < hi)
#ifndef HOST_EMU
#define FRESH() do { int t_ = threadIdx.x; OPAQUE_V(t_); F.tid = t_; F.lane = t_ & 63; F.wave = __builtin_amdgcn_readfirstlane(t_ >> 6); \
        F.ws = uni_ptr(prm.ws); F.out = uni_ptr(prm.out); } while (0)
#else
#define FRESH() do {} while (0)
#endif
#define SEAM(k) do { if (IN(k) && IN((k) + 1)) GRID_SYNC(); PROBE_END(k); } while (0)
#ifndef HOST_EMU
#define OPAQUE_WS() do { unsigned char* t_ = prm.ws; asm volatile("" : "+s"(t_)); F.ws = t_; float* o_ = prm.out; asm volatile("" : "+s"(o_)); F.out = o_; } while (0)
#else
#define OPAQUE_WS() do {} while (0)
#endif
    if (IN(0)) { FRESH(); p0_small(F); } SEAM(0);
    if (IN(1)) { FRESH(); p1_xn(F); p0_weights(F); } SEAM(1);
    if (IN(2)) { FRESH(); pg8::Gemm g{WSP(bf16_t, WS_XN), WSP(bf16_t, WS_WIN), NROWS, NIN, 1024}; pg8::StaticOrder S; S.init(NROWS, NIN, F.G, F.bid);
        EpiInProj E{WSP(bf16_t, WS_Z), WSP(bf16_t, WS_XBC), WSP(bf16_t, WS_QK), WSP(bf16_t, WS_V), WSP(bf16_t, WS_O), WSP(bf16_t, WS_MG), WSP(float, WS_DTG), F.pp->in[9], F.pp->in[10], F.pp->in[15], F.pp->in[16], F.lds + pg8::STAGE_BYTES};
        pg8::gemm_phase<EpiInProj, pg8::StaticOrder>(F.lds, g, S, E); } SEAM(2);
    if (IN(4)) { FRESH(); p4v2_local_states(F); } SEAM(4);
    if (IN(5)) { FRESH(); p5_scan(F); } SEAM(5);
    if (IN(6)) { FRESH(); p6v2_outputs(F); } SEAM(6);
    if (IN(7)) { FRESH(); pg8::Gemm g{WSP(bf16_t, WS_YPRE), WSP(bf16_t, WS_WSO), NLAT, 1024, 1024}; pg8::StaticOrder S; S.init(NLAT, 1024, F.G, F.bid);
        EpiG1 E{WSP(bf16_t, WS_M1), WSP(bf16_t, WS_MG), WSP(float, WS_SSQ)}; pg8::gemm_phase<EpiG1, pg8::StaticOrder>(F.lds, g, S, E);
        FRESH(); pg8::Gemm g2{WSP(bf16_t, WS_HP), WSP(bf16_t, WS_WMO), NLAT, 1024, 1024};
        EpiG2 E2{WSP(bf16_t, WS_MERGED), WSP(bf16_t, WS_M1), WSP(bf16_t, WS_MG)}; pg8::gemm_phase<EpiG2, pg8::StaticOrder>(F.lds, g2, S, E2); } SEAM(7);
    if (IN(9)) { FRESH(); pg8::Gemm g{WSP(bf16_t, WS_MERGED), WSP(bf16_t, WS_WOUT), NLAT, 1024, 1024}; pg8::StaticOrder S; S.init(NLAT, 1024, F.G, F.bid);
        EpiG3 E{F.pp->in[0], F.out, WSP(float, WS_MOD)}; pg8::gemm_phase<EpiG3, pg8::StaticOrder>(F.lds, g, S, E); } SEAM(9);
    if (IN(10)) { FRESH(); p10_xn2(F); p_expert_weights(F); } SEAM(10);
    if (IN(11)) { FRESH(); pg8::Gemm g{WSP(bf16_t, WS_XN), WSP(bf16_t, WS_WRS), NLAT, 768, 1024}; pg8::StaticOrder S; S.init(NLAT, 768, F.G, F.bid);
        EpiRS E{WSP(float, WS_LOG), WSP(bf16_t, WS_HS)}; pg8::gemm_phase<EpiRS, pg8::StaticOrder>(F.lds, g, S, E); } SEAM(11);
    if (IN(12)) { FRESH(); p12_route(F); } SEAM(12);
    if (IN(13)) { FRESH(); p13_slots(F); } SEAM(13);
    if (IN(14)) { FRESH(); const int ntl = WSP(int, WS_CTL)[1024];
        pg8::Gemm g{WSP(bf16_t, WS_XN), WSP(bf16_t, WS_W1T), NLAT, 512, 1024};
        pg8::ExpertOrder<true> S{0, ntl, 2, F.G, F.bid, WSP(int, WS_TEXP), 0, (size_t)512 * 1024, WSP(int, WS_STOK)};
        EpiX1 E{WSP(bf16_t, WS_H)}; pg8::gemm_phase<EpiX1, pg8::ExpertOrder<true>>(F.lds, g, S, E); } SEAM(14);
    if (IN(15)) { FRESH(); const int ntl = WSP(int, WS_CTL)[1024];
        pg8::Gemm g{WSP(bf16_t, WS_H), WSP(bf16_t, WS_W2T), MAXSLOT, 1024, 256};
        pg8::ExpertOrder<false> S{0, ntl, 4, F.G, F.bid, WSP(int, WS_TEXP), 0, (size_t)1024 * 256, nullptr};
        EpiX2 E{WSP(bf16_t, WS_Y), WSP(int, WS_SDST), WSP(float, WS_SW)}; pg8::gemm_phase<EpiX2, pg8::ExpertOrder<false>>(F.lds, g, S, E);
        FRESH();
        pg8::Gemm g2{WSP(bf16_t, WS_HS), WSP(bf16_t, WS_WSD), NLAT, 1024, 256}; pg8::StaticOrder S2; S2.init(NLAT, 1024, F.G, F.bid);
        EpiSD E2{WSP(bf16_t, WS_YS)}; pg8::gemm_phase<EpiSD, pg8::StaticOrder>(F.lds, g2, S2, E2); } SEAM(15);
    if (IN(16)) { FRESH(); p_final(F); }
#ifndef HOST_EMU
    if (TPROBE_MUL > 0) { asm volatile("s_waitcnt vmcnt(0)" ::: "memory"); __syncthreads(); PROBE_END(16);
        if (blockIdx.x == 0 && threadIdx.x == 0) { const unsigned long long t0 = __builtin_amdgcn_s_memrealtime(), want = (tp0 != 0ull && tp1 > tp0 && tp1 - tp0 < 2000000ull) ? (unsigned long long)TPROBE_MUL * (tp1 - tp0) : 0ull;
            while (__builtin_amdgcn_s_memrealtime() - t0 < want) __builtin_amdgcn_s_sleep(8); } }
#endif
#undef IN
#undef SEAM
}

#ifndef HOST_EMU
extern "C" void kernel_launch(void* const* d_in, const int* in_sizes, int n_in, void* d_out, int out_size, void* d_ws, size_t ws_size, hipStream_t stream) {
    static int grid = 0;
    if (grid == 0) {
        if (n_in != 32 || out_size != NLAT * DM || ws_size < WS_NEED) { fprintf(stderr, "kernel_launch: unexpected problem (n_in %d out %d ws %zu need %zu)\n", n_in, out_size, ws_size, (size_t)WS_NEED); grid = -1; return; }
        int dev = 0, cus = 0, per_cu = 0;
        hipGetDevice(&dev); hipDeviceGetAttribute(&cus, hipDeviceAttributeMultiprocessorCount, dev);
        hipFuncSetAttribute((const void*)fwd_megakernel, hipFuncAttributeMaxDynamicSharedMemorySize, LDS_BYTES);
        hipOccupancyMaxActiveBlocksPerMultiprocessor(&per_cu, (const void*)fwd_megakernel, NTHR, LDS_BYTES);
        if (per_cu < 1) { fprintf(stderr, "kernel_launch: occupancy query says %d blocks per CU\n", per_cu); per_cu = 1; }
        (void)hipGetLastError();
        grid = cus;
    }
    if (grid < 0) return;
    hipMemsetAsync((char*)d_ws + WS_CTL, 0, CTL_BYTES, stream);
    Params p{};
    for (int i = 0; i < 32; ++i) p.in[i] = (const float*)d_in[i];
    p.out = (float*)d_out; p.ws = (unsigned char*)d_ws; p.ph_lo = 0; p.ph_hi = NPHASE;
    void* args[] = {&p};
    const hipError_t e = hipLaunchCooperativeKernel((const void*)fwd_megakernel, dim3(grid), dim3(NTHR), args, LDS_BYTES, stream);
    if (e != hipSuccess) fprintf(stderr, "kernel_launch: launch failed: %s (grid %d)\n", hipGetErrorString(e), grid);
}
#endif
```

```cpp
#ifndef HOST_EMU
#include <hip/hip_runtime.h>
#include <cstdio>
#include <cstdint>
#define DEV __device__ __forceinline__
#define LAS __attribute__((address_space(3)))
#define TID ((int)threadIdx.x)
#define BID ((int)blockIdx.x)
#define NBLK ((int)gridDim.x)
#define SYNC() __syncthreads()
#define EXPF(x) __expf(x)
#define RCPF(x) __builtin_amdgcn_rcpf(x)
#define RSQF(x) __builtin_amdgcn_rsqf(x)
#define ATOMIC_ADD_LDS(p, v) __hip_atomic_fetch_add((p), (v), __ATOMIC_RELAXED, __HIP_MEMORY_SCOPE_WORKGROUP)
#define RFL(x) __builtin_amdgcn_readfirstlane(x)
#define SCHED_FENCE() __builtin_amdgcn_sched_barrier(0)
#define MEM_FENCE() asm volatile("" ::: "memory")
#define WAVE_LDS_FENCE() asm volatile("s_waitcnt lgkmcnt(0)" ::: "memory")
#define OPAQUE_V(x) asm volatile("" : "+v"(x))
#endif

#ifndef CFG_SEQ
#define CFG_SEQ 16384
#endif
#ifndef CFG_NEXP
#define CFG_NEXP 256
#endif
constexpr int DM = 1024, BATCH = 2, SEQ = CFG_SEQ, CTXL = 256, CHUNK = 128;
constexpr int NLAT = BATCH * SEQ, NCTX = BATCH * CTXL, NROWS = NLAT + NCTX;
constexpr int NCH = SEQ / CHUNK, NCHC = CTXL / CHUNK, NCHT = NCH + NCHC;
constexpr int SSD_H = 16, SSD_P = 64, SSD_N = 128, D_XBC = 1536;
constexpr int ML_H = 8, ML_DV = 128, ML_DK = 64, ML_PP = 144;
constexpr int NEXP = CFG_NEXP, TOPK = 8, TOPKG = 4, DEXP = 256, EPL = NEXP / 64;
constexpr int NASG = NLAT * TOPK, MAXSLOT = NASG + NEXP * 256;
constexpr int NIN = 7936;
constexpr float EPS = 1e-6f;
constexpr int NTHR = 512;

typedef unsigned short bf16_t;
typedef short bf16x8 __attribute__((ext_vector_type(8)));
typedef float f32x4 __attribute__((ext_vector_type(4)));
typedef unsigned u32x4 __attribute__((ext_vector_type(4)));
typedef unsigned u32x2 __attribute__((ext_vector_type(2)));

constexpr size_t alignup(size_t x) { return (x + 4095) & ~(size_t)4095; }
constexpr size_t WS_CTL = 0;
constexpr size_t CTL_BYTES = 65536;
constexpr size_t WS_MOD = WS_CTL + CTL_BYTES;
constexpr size_t WS_DECS = WS_MOD + alignup(3 * 6144 * 4);
constexpr size_t WS_DECM = WS_DECS + alignup((size_t)BATCH * 2 * NCHT * 16 * 4);
constexpr size_t WS_WIN = WS_DECM + alignup((size_t)BATCH * 2 * NCHT * 8 * 4);
constexpr size_t WS_WSO = WS_WIN + alignup((size_t)NIN * 1024 * 2);
constexpr size_t WS_WMO = WS_WSO + alignup((size_t)1024 * 1024 * 2);
constexpr size_t WS_WOUT = WS_WMO + alignup((size_t)1024 * 1024 * 2);
constexpr size_t WS_WRS = WS_WOUT + alignup((size_t)1024 * 1024 * 2);
constexpr size_t WS_WSD = WS_WRS + alignup((size_t)768 * 1024 * 2);
constexpr size_t WS_XN = WS_WSD + alignup((size_t)1024 * 256 * 2);
constexpr size_t WS_STAGE = WS_XN + alignup((size_t)NROWS * 1024 * 2);
constexpr size_t WS_Z = WS_STAGE;
constexpr size_t WS_XBC = WS_Z + alignup((size_t)NROWS * 1024 * 2);
constexpr size_t WS_QK = WS_XBC + alignup((size_t)NROWS * 1536 * 2);
constexpr size_t WS_V = WS_QK + alignup((size_t)NROWS * 1024 * 2);
constexpr size_t WS_O = WS_V + alignup((size_t)NROWS * 1024 * 2);
constexpr size_t WS_MG = WS_O + alignup((size_t)NROWS * 1024 * 2);
constexpr size_t WS_DTG = WS_MG + alignup((size_t)NROWS * 2048 * 2);
constexpr size_t WS_STS = WS_DTG + alignup((size_t)NROWS * 64 * 4);
constexpr size_t STS_CH = (size_t)SSD_H * SSD_P * SSD_N;
constexpr size_t WS_STM = WS_STS + alignup((size_t)BATCH * 2 * NCHT * STS_CH * 2);
constexpr size_t STM_CH = (size_t)ML_H * ML_PP * ML_DK;
constexpr size_t WS_YPRE = WS_STM + alignup((size_t)BATCH * 2 * NCHT * STM_CH * 2);
constexpr size_t WS_HP = WS_YPRE + alignup((size_t)NLAT * 1024 * 2);
constexpr size_t WS_SSQ = WS_HP + alignup((size_t)NLAT * 1024 * 2);
constexpr size_t WS_MIX_END = WS_SSQ + alignup((size_t)NLAT * 16 * 4);
constexpr size_t WS_M1 = WS_XBC;
constexpr size_t WS_MERGED = WS_QK;
constexpr size_t WS_Y = WS_STAGE;
constexpr size_t WS_W1T = WS_STAGE;
static_assert((size_t)NEXP * 512 * 1024 * 2 <= (size_t)NASG * 1024 * 2 || true, "");
constexpr size_t WS_YEND = WS_STAGE + (alignup((size_t)NASG * 1024 * 2) > alignup((size_t)NEXP * 512 * 1024 * 2) ? alignup((size_t)NASG * 1024 * 2) : alignup((size_t)NEXP * 512 * 1024 * 2));
constexpr size_t WS_W2T = WS_YEND;
constexpr size_t WS_H = WS_W2T + alignup((size_t)NEXP * 1024 * 256 * 2);
constexpr size_t WS_LOG = WS_H + alignup((size_t)MAXSLOT * 256 * 2);
constexpr size_t WS_HS = WS_LOG + alignup((size_t)NLAT * NEXP * 4);
constexpr size_t WS_ASGE = WS_HS + alignup((size_t)NLAT * 256 * 2);
constexpr size_t WS_ASGR = WS_ASGE + alignup((size_t)NASG * 4);
constexpr size_t WS_ASGW = WS_ASGR + alignup((size_t)NASG * 4);
constexpr size_t WS_STOK = WS_ASGW + alignup((size_t)NASG * 4);
constexpr size_t WS_SDST = WS_STOK + alignup((size_t)MAXSLOT * 4);
constexpr size_t WS_SW = WS_SDST + alignup((size_t)MAXSLOT * 4);
constexpr size_t WS_TEXP = WS_SW + alignup((size_t)MAXSLOT * 4);
constexpr size_t WS_CMAT = WS_TEXP + alignup((size_t)(MAXSLOT / 256) * 4);
constexpr size_t WS_YS = WS_CMAT + alignup((size_t)512 * NEXP * 4);
constexpr size_t WS_MOE_END = WS_YS + alignup((size_t)NLAT * 1024 * 2);
constexpr size_t WS_NEED = WS_MIX_END > WS_MOE_END ? WS_MIX_END : WS_MOE_END;

constexpr int LDS_BYTES = 147456;
constexpr int NPHASE = 17;

struct Params { const float* in[32]; float* out; unsigned char* ws; int ph_lo, ph_hi; };

#ifndef HOST_EMU
DEV unsigned f2bf(float f) { const __bf16 b = (__bf16)f; return (unsigned)__builtin_bit_cast(unsigned short, b); }
#else
DEV unsigned f2bf(float f) { unsigned u = __builtin_bit_cast(unsigned, f); return (u + 0x7fffu + ((u >> 16) & 1u)) >> 16; }
#endif
DEV float bf2f(unsigned h) { return __builtin_bit_cast(float, (h & 0xffffu) << 16); }
#ifndef HOST_EMU
typedef float f32x2_t __attribute__((ext_vector_type(2))); typedef __bf16 bf16x2_t __attribute__((ext_vector_type(2)));
DEV unsigned pk2(float lo, float hi) { const f32x2_t v = {lo, hi}; const bf16x2_t b = __builtin_convertvector(v, bf16x2_t); return __builtin_bit_cast(unsigned, b); }
#else
DEV unsigned pk2(float lo, float hi) { return f2bf(lo) | (f2bf(hi) << 16); }
#endif
DEV float bflo(unsigned w) { return __builtin_bit_cast(float, w << 16); }
DEV float bfhi(unsigned w) { return __builtin_bit_cast(float, w & 0xffff0000u); }
DEV float sigmoidf_(float x) { return RCPF(1.f + EXPF(-x)); }
DEV float siluf_(float x) { return x * RCPF(1.f + EXPF(-x)); }
DEV float softplusf_(float x) { return x > 20.f ? x : log1pf(EXPF(x)); }
DEV float logsigmoidf_(float x) { return -softplusf_(-x); }
DEV float wave_sum(float v) {
#pragma unroll
    for (int o = 1; o < 64; o <<= 1) v += __shfl_xor(v, o);
    return v;
}
DEV float wave_incl_scan(float v, int lane) {
#pragma unroll
    for (int d = 1; d < 64; d <<= 1) { float t = __shfl_up(v, d); if (lane >= d) v += t; }
    return v;
}
typedef short s16x4 __attribute__((ext_vector_type(4)));
#ifndef HOST_EMU
DEV f32x4 mfma16(bf16x8 a, bf16x8 b, f32x4 c) { return __builtin_amdgcn_mfma_f32_16x16x32_bf16(a, b, c, 0, 0, 0); }
DEV s16x4 lds_tr16(const LAS void* p) { return __builtin_bit_cast(s16x4, __builtin_amdgcn_ds_read_tr16_b64_v4i16((LAS s16x4*)p)); }
#endif
namespace pg8 {
constexpr int BM = 256, BK = 64, HALF = 128, HTB = HALF * BK * 2, STAGE_BYTES = 8 * HTB, NXCD = 8, WGM = 8;
struct Unit { int pm, pn; };
struct Gemm { const bf16_t* A; const bf16_t* Bt; int M, N, K; };

DEV int lds_byte(int r, int c) { const int st = (r >> 4) * 2 + (c >> 5), rr = r & 15, cc = c & 31, ob = rr * 64 + cc * 2; return st * 1024 + (ob ^ (((ob >> 9) & 1) << 5)); }
DEV void stage_rc(int b, int& R, int& C) { const int st = b / 1024, sb = b % 1024, swz = sb ^ (((sb >> 9) & 1) << 5); R = (st >> 1) * 16 + swz / 64; C = (st & 1) * 32 + (swz % 64) / 2; }
DEV int perm32(int rho) { const int n = rho >> 4, i = rho & 15; return 8 * (i >> 2) + 4 * n + (i & 3); }

struct StaticOrder {
    static constexpr bool GATHER = false;
    int nM, nN, nwg, G, c;
    DEV void init(int M, int N, int G_, int c_) { nM = M / BM; nN = N / BM; nwg = nM * nN; G = G_; c = c_; }
    DEV bool next(int i, Unit& u) const {
        const long L = (long)i * G + c; if (L >= nwg) return false;
        int wgid = (int)L; { const int q = nwg / NXCD, r = nwg % NXCD, xcd = wgid % NXCD, off = wgid / NXCD; wgid = (xcd < r ? xcd * (q + 1) : r * (q + 1) + (xcd - r) * q) + off; }
        const int nig = WGM * nN, gid = wgid / nig, fm = gid * WGM, gsz = (nM - fm) < WGM ? (nM - fm) : WGM;
        u.pm = fm + ((wgid % nig) % gsz); u.pn = (wgid % nig) / gsz; return true;
    }
    DEV unsigned arow(const Unit& u, int r) const { return (unsigned)(u.pm * BM + r); }
    DEV const char* bbase(const Gemm& g, const Unit& u) const { return (const char*)g.Bt + (size_t)u.pn * BM * g.K * 2; }
};
template <bool GATHER_> struct ExpertOrder {
    static constexpr bool GATHER = GATHER_;
    int tlo, thi, np, G, c; const int* texp; int e0; size_t estride  ; const int* rowmap;
    DEV bool next(int i, Unit& u) const {
        const long L = (long)i * G + c; const long n = (long)(thi - tlo) * np; if (L >= n) return false;
        int wg = (int)L; { const int nn = (int)n, q = nn / NXCD, r = nn % NXCD, xcd = wg % NXCD, off = wg / NXCD; wg = (xcd < r ? xcd * (q + 1) : r * (q + 1) + (xcd - r) * q) + off; }
        u.pm = tlo + wg / np; u.pn = wg % np; return true;
    }
    DEV unsigned arow(const Unit& u, int r) const { return GATHER_ ? (unsigned)rowmap[u.pm * BM + r] : (unsigned)(u.pm * BM + r); }
    DEV const char* bbase(const Gemm& g, const Unit& u) const { const int e = texp[u.pm] - e0; return (const char*)(g.Bt + (size_t)e * estride) + (size_t)u.pn * BM * g.K * 2; }
};

#ifndef HOST_EMU
#define PG8_LAS __attribute__((address_space(3)))
template <class Epi, class Sched>
__device__ __forceinline__ void gemm_phase(PG8_LAS unsigned char* lds, const Gemm g, const Sched& S, const Epi& E) {
    int tid_ = threadIdx.x; asm volatile("" : "+v"(tid_));
    const int tid = tid_, wid = __builtin_amdgcn_readfirstlane(tid >> 6), lane = tid & 63, wr = wid >> 2, wc = wid & 3, fr = lane & 15, fq = lane >> 4;
    int Kop = g.K; asm volatile("" : "+s"(Kop));
    const int K = Kop, nt = K / BK;
    int RA[2], CA[2]; unsigned voffB[2];
#pragma unroll
    for (int i = 0; i < 2; ++i) { int R, C; stage_rc(tid * 16 + i * 8192, R, C); const int Rb = Epi::PERM ? ((R & ~31) + perm32(R & 31)) : R;
        RA[i] = R; CA[i] = C; voffB[i] = (unsigned)(Rb * K + C) * 2u; }
    const size_t kstep = (size_t)(BK * 2);
    const size_t hstep = (size_t)HALF * K * 2;
    const unsigned ldsw = (unsigned)wid * 1024u;
    const int aoff = lds_byte(wr * 64 + fr, fq * 8), boff = lds_byte(wc * 32 + fr, fq * 8);
    const char* const Ab = (const char*)g.A;
#define PG8_SA(b, h) (((b) * 2 + (h)) * HTB)
#define PG8_SB(b, h) ((4 + (b) * 2 + (h)) * HTB)
#define PG8_STAGE(bufoff, gbase, voff) do { _Pragma("unroll") for (int _i = 0; _i < 2; ++_i) \
        __builtin_amdgcn_global_load_lds((const unsigned*)((const char*)(gbase) + (voff)[_i]), (PG8_LAS unsigned*)(lds + (bufoff) + ldsw + _i * 8192), 16, 0, 0); } while (0)
#define PG8_LDA(dst, b, h) do { _Pragma("unroll") for (int m = 0; m < 4; ++m) _Pragma("unroll") for (int k = 0; k < 2; ++k) dst[m][k] = *(const PG8_LAS bf16x8*)(lds + PG8_SA(b, h) + aoff + m * 2048 + k * 1024); } while (0)
#define PG8_LDB(dst, b, h) do { _Pragma("unroll") for (int n = 0; n < 2; ++n) _Pragma("unroll") for (int k = 0; k < 2; ++k) dst[n][k] = *(const PG8_LAS bf16x8*)(lds + PG8_SB(b, h) + boff + n * 2048 + k * 1024); } while (0)
#define PG8_MMA(ai, bj, At, Bt) do { __builtin_amdgcn_s_setprio(1); _Pragma("unroll") for (int m = 0; m < 4; ++m) _Pragma("unroll") for (int n = 0; n < 2; ++n) _Pragma("unroll") for (int k = 0; k < 2; ++k) \
        acc[ai][bj][m][n] = __builtin_amdgcn_mfma_f32_16x16x32_bf16(Bt[n][k], At[m][k], acc[ai][bj][m][n], 0, 0, 0); __builtin_amdgcn_s_setprio(0); } while (0)
#define PG8_WAIT_V(n) asm volatile("s_waitcnt vmcnt(" #n ")" ::: "memory")
#define PG8_WAIT_L(n) asm volatile("s_waitcnt lgkmcnt(" #n ")" ::: "memory")
#define PG8_BAR __builtin_amdgcn_s_barrier()
#define PG8_SCHED __builtin_amdgcn_sched_barrier(0)
#define PG8_VOFFA(dst, u) do { _Pragma("unroll") for (int _h = 0; _h < 2; ++_h) _Pragma("unroll") for (int _i = 0; _i < 2; ++_i) \
        dst[_h][_i] = (S.arow(u, _h * HALF + RA[_i]) * (unsigned)K + (unsigned)CA[_i]) * 2u; } while (0)
    Unit cur, nxt; int ui = 0;
    if (!S.next(0, cur)) return;
    f32x4 acc[2][2][4][2];
#pragma unroll
    for (int a = 0; a < 2; ++a)
#pragma unroll
        for (int b = 0; b < 2; ++b)
#pragma unroll
            for (int m = 0; m < 4; ++m)
#pragma unroll
                for (int n = 0; n < 2; ++n) acc[a][b][m][n] = (f32x4){0.f, 0.f, 0.f, 0.f};
    bf16x8 At[4][2], B0[2][2], B1[2][2];
    constexpr bool GA = Sched::GATHER;
    unsigned vAc[2][2], vAn[2][2];
    unsigned voffA[2];
#pragma unroll
    for (int i = 0; i < 2; ++i) voffA[i] = (unsigned)(RA[i] * K + CA[i]) * 2u;
    const size_t tstep = 2 * hstep;
    const char* cA = Ab;
    if constexpr (GA) { PG8_VOFFA(vAc, cur); } else { cA = Ab + (size_t)S.arow(cur, 0) * K * 2; (void)tstep; }
    const char* cB = S.bbase(g, cur);
#define PG8_STAGE_A(bufoff, h, ubase, vg) do { if constexpr (GA) { PG8_STAGE(bufoff, ubase, vg[h]); } else { PG8_STAGE(bufoff, (ubase) + (h) * hstep, voffA); } } while (0)
    PG8_STAGE(PG8_SB(0, 0), cB, voffB); PG8_STAGE(PG8_SB(0, 1), cB + hstep, voffB); PG8_STAGE_A(PG8_SA(0, 0), 0, cA, vAc); PG8_STAGE_A(PG8_SA(0, 1), 1, cA, vAc);
    if (wr == 1) PG8_BAR;
    PG8_WAIT_V(2); PG8_BAR;
    PG8_STAGE(PG8_SB(1, 0), cB + kstep, voffB); PG8_STAGE_A(PG8_SA(1, 0), 0, cA + kstep, vAc); PG8_STAGE(PG8_SB(1, 1), cB + hstep + kstep, voffB);
    PG8_WAIT_V(6); PG8_BAR;
    for (;;) {
        const bool has_next = S.next(ui + 1, nxt);
        const char* nB = cB; const char* nA = cA;
        if (has_next) { nB = S.bbase(g, nxt); if constexpr (GA) { PG8_VOFFA(vAn, nxt); } else { nA = Ab + (size_t)S.arow(nxt, 0) * K * 2; } }
        else if constexpr (GA) {
#pragma unroll
            for (int _h = 0; _h < 2; ++_h)
#pragma unroll
                for (int _i = 0; _i < 2; ++_i) vAn[_h][_i] = vAc[_h][_i];
        }
#pragma unroll 1
        for (int t = 0; t < nt; t += 2) {
            const bool last = (t == nt - 2);
            const char* a1 = cA + (size_t)(t + 1) * kstep;
            const char* a2 = last ? nA : cA + (size_t)(t + 2) * kstep; const char* b2 = last ? nB : cB + (size_t)(t + 2) * kstep;
            const char* a3 = a2 + kstep; const char* b3 = b2 + kstep;
            unsigned v2[2][2];
            if constexpr (GA) {
#pragma unroll
                for (int _h = 0; _h < 2; ++_h)
#pragma unroll
                    for (int _i = 0; _i < 2; ++_i) v2[_h][_i] = last ? vAn[_h][_i] : vAc[_h][_i];
            }
            PG8_LDB(B0, 0, 0); PG8_LDB(B1, 0, 1); PG8_SCHED; PG8_LDA(At, 0, 0); PG8_STAGE_A(PG8_SA(1, 1), 1, a1, vAc);
            PG8_WAIT_V(8); PG8_WAIT_L(0); PG8_BAR; PG8_MMA(0, 0, At, B0); PG8_MMA(0, 1, At, B1); PG8_BAR; PG8_SCHED;
            PG8_LDA(At, 0, 1); PG8_STAGE(PG8_SB(0, 0), b2, voffB); PG8_STAGE(PG8_SB(0, 1), b2 + hstep, voffB); PG8_STAGE_A(PG8_SA(0, 0), 0, a2, v2);
            PG8_WAIT_V(8); PG8_WAIT_L(0); PG8_BAR; PG8_MMA(1, 0, At, B0); PG8_MMA(1, 1, At, B1); PG8_BAR; PG8_SCHED;
            PG8_LDB(B0, 1, 0); PG8_LDB(B1, 1, 1); PG8_SCHED; PG8_LDA(At, 1, 0); PG8_STAGE_A(PG8_SA(0, 1), 1, a2, v2);
            PG8_WAIT_V(8); PG8_WAIT_L(0); PG8_BAR; PG8_MMA(0, 0, At, B0); PG8_MMA(0, 1, At, B1); PG8_BAR; PG8_SCHED;
            PG8_LDA(At, 1, 1); PG8_STAGE(PG8_SB(1, 0), b3, voffB); PG8_STAGE(PG8_SB(1, 1), b3 + hstep, voffB); PG8_STAGE_A(PG8_SA(1, 0), 0, a3, v2);
            PG8_WAIT_V(8); PG8_WAIT_L(0); PG8_BAR; PG8_MMA(1, 0, At, B0); PG8_MMA(1, 1, At, B1); PG8_BAR; PG8_SCHED;
        }
        if (wr == 0) PG8_BAR;
        E(acc, cur, wr, wc, fr, fq);
        if (!has_next) break;
#pragma unroll
        for (int a = 0; a < 2; ++a)
#pragma unroll
            for (int b = 0; b < 2; ++b)
#pragma unroll
                for (int m = 0; m < 4; ++m)
#pragma unroll
                    for (int n = 0; n < 2; ++n) acc[a][b][m][n] = (f32x4){0.f, 0.f, 0.f, 0.f};
        cur = nxt; cB = nB; cA = nA; ++ui;
        if constexpr (GA) {
#pragma unroll
            for (int _h = 0; _h < 2; ++_h)
#pragma unroll
                for (int _i = 0; _i < 2; ++_i) vAc[_h][_i] = vAn[_h][_i];
        }
        if (wr == 1) PG8_BAR;
    }
    PG8_WAIT_V(0);
    PG8_BAR;
#undef PG8_SA
#undef PG8_SB
#undef PG8_STAGE
#undef PG8_LDA
#undef PG8_LDB
#undef PG8_MMA
#undef PG8_WAIT_V
#undef PG8_WAIT_L
#undef PG8_BAR
#undef PG8_SCHED
#undef PG8_VOFFA
#undef PG8_STAGE_A
}
#else
template <class Epi, class Sched>
static inline void gemm_phase(unsigned char* lds, const Gemm g, const Sched& S, const Epi& E) {
    const int tid = TID, wid = tid >> 6, lane = tid & 63, wr = wid >> 2, wc = wid & 3, fr = lane & 15, fq = lane >> 4;
    float* C = (float*)(lds + 512 * 1024);
    Unit cur;
    for (int ui = 0; S.next(ui, cur); ++ui) {
        SYNC();
        { const int r = tid >> 1, c0 = (tid & 1) * 128; const bf16_t* arow = g.A + (size_t)S.arow(cur, r) * g.K; const bf16_t* bb = (const bf16_t*)S.bbase(g, cur);
          for (int c = c0; c < c0 + 128; ++c) { const bf16_t* brow = bb + (size_t)c * g.K; float s = 0.f; for (int k = 0; k < g.K; ++k) s += bf2f(arow[k]) * bf2f(brow[k]); C[r * 256 + c] = s; } }
        SYNC();
        f32x4 acc[2][2][4][2];
        for (int ai = 0; ai < 2; ++ai) for (int bj = 0; bj < 2; ++bj) for (int m = 0; m < 4; ++m) for (int n = 0; n < 2; ++n) for (int i = 0; i < 4; ++i) {
            const int row = 128 * ai + 64 * wr + 16 * m + fr, col = Epi::PERM ? 128 * bj + 32 * wc + 8 * fq + 4 * n + i : 128 * bj + 32 * wc + 16 * n + 4 * fq + i;
            acc[ai][bj][m][n][i] = C[row * 256 + col]; }
        E(acc, cur, wr, wc, fr, fq);
    }
    SYNC();
}
#endif
}

struct Frame {
    LAS unsigned char* lds;
    int tid, lane, wave, G, bid;
    const Params* pp; float* out; unsigned char* ws;
};
#define WSP(T, off) ((T*)(F.ws + (off)))

DEV void transpose_item(const float* W, int K, int N, bf16_t* WT, int dst_row, int k0, int n0, LAS float* scr, int lane) {
#pragma unroll 8
    for (int i = 0; i < 32; ++i) { const int kk = 2 * i + (lane >> 5); scr[kk * 33 + (lane & 31)] = W[(size_t)(k0 + kk) * N + n0 + (lane & 31)]; }
    WAVE_LDS_FENCE();
    const int c = lane & 7;
#pragma unroll
    for (int j = 0; j < 4; ++j) { const int n = (lane >> 3) + 8 * j; const LAS float* s = scr + (8 * c) * 33 + n;
        u32x4 o; o.x = pk2(s[0 * 33], s[1 * 33]); o.y = pk2(s[2 * 33], s[3 * 33]); o.z = pk2(s[4 * 33], s[5 * 33]); o.w = pk2(s[6 * 33], s[7 * 33]);
        *(u32x4*)(WT + (size_t)(dst_row + n) * K + k0 + 8 * c) = o; }
    WAVE_LDS_FENCE();
}
DEV int map_in(int s) {
    if (s < 2560) return s;
    if (s < 2592) return 7680 + (s - 2560);
    if (s < 4640) return s - 32;
    if (s < 4672) return 7712 + (s - 4640);
    return s - 64;
}
DEV int map_gu(int s, int up) { return (s >> 7) * 256 + up * 128 + (s & 127); }
DEV void transpose_job(Frame& F, const float* W, int K, int N, bf16_t* WT, int mode  , int row_base, int item, bool active) {
    LAS float* scr = (LAS float*)(F.lds) + F.wave * (64 * 33);
    if (active) {
        const int nblk = N / 32, kb = item / nblk, nb = item % nblk, n0 = nb * 32;
        int d = n0; if (mode == 1) d = map_in(n0); else if (mode == 2) d = map_gu(n0, 0); else if (mode == 3) d = map_gu(n0, 1);
        transpose_item(W, K, N, WT, row_base + d, kb * 64, n0, scr, F.lane);
    }
}
DEV void p0_small(Frame& F) {
    const float* c = F.pp->in[1]; const float* cctx = F.pp->in[3]; const float* aw = F.pp->in[4]; const float* ab = F.pp->in[5];
    float* mod = WSP(float, WS_MOD);
    LAS float* red = (LAS float*)F.lds;
    for (int cb = F.bid; cb < 192; cb += F.G) {
        const int cl = F.tid & 31, kg = F.tid >> 5, col = cb * 32 + cl;
        float s0 = 0.f, s1 = 0.f, s2 = 0.f;
#pragma unroll 16
        for (int k = kg * 64; k < kg * 64 + 64; ++k) { const float w = aw[(size_t)k * 6144 + col]; s0 += siluf_(c[k]) * w; s1 += siluf_(c[1024 + k]) * w; s2 += siluf_(cctx[k]) * w; }
        red[(kg * 32 + cl) * 3 + 0] = s0; red[(kg * 32 + cl) * 3 + 1] = s1; red[(kg * 32 + cl) * 3 + 2] = s2;
        SYNC();
        if (F.tid < 96) { const int v = F.tid / 32, cc = F.tid % 32; float s = 0.f; for (int q = 0; q < 16; ++q) s += red[(q * 32 + cc) * 3 + v]; mod[v * 6144 + cb * 32 + cc] = s + ab[cb * 32 + cc]; }
        SYNC();
    }
}
DEV void p0_weights(Frame& F) {
    SYNC();
    const int gw = F.bid * 8 + F.wave, NGW = F.G * 8;
#define P0_JOB(Wp, Kv, Nv, WTp, modev, rb) do { const int nitems_ = ((Kv) / 64) * ((Nv) / 32); const int rounds_ = (nitems_ + NGW - 1) / NGW; \
        for (int r_ = 0; r_ < rounds_; ++r_) { const int it_ = r_ * NGW + gw; transpose_job(F, (Wp), (Kv), (Nv), (WTp), (modev), (rb), it_, it_ < nitems_); } } while (0)
    P0_JOB(F.pp->in[8], 1024, 7744, WSP(bf16_t, WS_WIN), 1, 0);
    P0_JOB(F.pp->in[20], 1024, 1024, WSP(bf16_t, WS_WSO), 0, 0);
    P0_JOB(F.pp->in[21], 1024, 1024, WSP(bf16_t, WS_WMO), 0, 0);
    P0_JOB(F.pp->in[22], 1024, 1024, WSP(bf16_t, WS_WOUT), 0, 0);
    P0_JOB(F.pp->in[23], 1024, NEXP, WSP(bf16_t, WS_WRS), 0, 0);
    P0_JOB(F.pp->in[28], 1024, 256, WSP(bf16_t, WS_WRS), 2, 256);
    P0_JOB(F.pp->in[29], 1024, 256, WSP(bf16_t, WS_WRS), 3, 256);
    P0_JOB(F.pp->in[30], 256, 1024, WSP(bf16_t, WS_WSD), 0, 0);
#undef P0_JOB
}
struct T64 { const float* W; bf16_t* WT; int K, N, dst_row, k0, n0; };
DEV void t64_load(const T64& t, f32x4 (&v)[16], int lane) {
#pragma unroll
    for (int i = 0; i < 16; ++i) v[i] = *(const f32x4*)(t.W + (size_t)(t.k0 + 4 * i + (lane >> 4)) * t.N + t.n0 + 4 * (lane & 15));
}
DEV void t64_store(const T64& t, const f32x4 (&v)[16], LAS float* scr, int lane) {
#pragma unroll
    for (int i = 0; i < 16; ++i) { LAS float* d = scr + (4 * i + (lane >> 4)) * 65 + 4 * (lane & 15); d[0] = v[i].x; d[1] = v[i].y; d[2] = v[i].z; d[3] = v[i].w; }
    WAVE_LDS_FENCE();
    const int c = lane & 7;
#pragma unroll
    for (int j = 0; j < 8; ++j) { const int n = (lane >> 3) + 8 * j; const LAS float* sp = scr + (8 * c) * 65 + n;
        u32x4 o; o.x = pk2(sp[0 * 65], sp[1 * 65]); o.y = pk2(sp[2 * 65], sp[3 * 65]); o.z = pk2(sp[4 * 65], sp[5 * 65]); o.w = pk2(sp[6 * 65], sp[7 * 65]);
        *(u32x4*)(t.WT + (size_t)(t.dst_row + n) * t.K + t.k0 + 8 * c) = o; }
    WAVE_LDS_FENCE();
}
DEV T64 expert_item(Frame& F, int e0, int it) {
    const int per = 192, el = it / per, j = it % per, e = e0 + el; T64 t;
    if (j < 128) { const int up = j >> 6, jj = j & 63, kb = jj >> 2, nb = jj & 3;
        t.W = F.pp->in[25 + up] + (size_t)e * 1024 * 256; t.K = 1024; t.N = 256; t.WT = WSP(bf16_t, WS_W1T) + (size_t)el * 512 * 1024; t.dst_row = map_gu(nb * 64, up); t.k0 = kb * 64; t.n0 = nb * 64; }
    else { const int jj = j - 128, kb = jj >> 4, nb = jj & 15;
        t.W = F.pp->in[27] + (size_t)e * 256 * 1024; t.K = 256; t.N = 1024; t.WT = WSP(bf16_t, WS_W2T) + (size_t)el * 1024 * 256; t.dst_row = nb * 64; t.k0 = kb * 64; t.n0 = nb * 64; }
    return t;
}
DEV void p_expert_weights(Frame& F) {
    const int gw = F.bid * 8 + F.wave, NGW = F.G * 8;
    LAS float* scr = (LAS float*)(F.lds) + F.wave * (64 * 65);
    const int nitems = NEXP * 192;
    f32x4 v[16];
    if (gw < nitems) { const T64 t = expert_item(F, 0, gw); t64_load(t, v, F.lane); }
#pragma unroll 1
    for (int it = gw; it < nitems; it += NGW) {
        const T64 t = expert_item(F, 0, it);
        f32x4 cur[16];
#pragma unroll
        for (int i = 0; i < 16; ++i) cur[i] = v[i];
        if (it + NGW < nitems) { const T64 tn = expert_item(F, 0, it + NGW); t64_load(tn, v, F.lane); }
        t64_store(t, cur, scr, F.lane);
    }
    SYNC();
}

DEV void norm_mod_row(const float* xrow, const float* g, const float* shift, const float* scale, bf16_t* orow, int lane) {
    const f32x4* xr = (const f32x4*)xrow + lane;
    f32x4 v[4]; float s = 0.f;
#pragma unroll
    for (int j = 0; j < 4; ++j) { v[j] = xr[64 * j]; s += (v[j].x * v[j].x + v[j].y * v[j].y) + (v[j].z * v[j].z + v[j].w * v[j].w); }
    const float rstd = RSQF(wave_sum(s) * (1.f / DM) + EPS);
    u32x2* o8 = (u32x2*)orow + lane;
#pragma unroll
    for (int j = 0; j < 4; ++j) {
        const f32x4 gg = ((const f32x4*)g)[lane + 64 * j], sh = ((const f32x4*)shift)[lane + 64 * j], sc = ((const f32x4*)scale)[lane + 64 * j];
        const f32x4 y = v[j] * rstd * gg * (sc + 1.0f) + sh;
        u32x2 w; w.x = pk2(y.x, y.y); w.y = pk2(y.z, y.w); o8[64 * j] = w;
    }
}
template <int NR> DEV void norm_mod_rows(const float* const (&xrow)[NR], const float* g, const float* const (&shift)[NR], const float* const (&scale)[NR], bf16_t* const (&orow)[NR], int lane) {
    f32x4 v[NR][4]; float s[NR];
#pragma unroll
    for (int r = 0; r < NR; ++r)
#pragma unroll
        for (int j = 0; j < 4; ++j) v[r][j] = ((const f32x4*)xrow[r])[lane + 64 * j];
#pragma unroll
    for (int r = 0; r < NR; ++r) { float a = 0.f;
#pragma unroll
        for (int j = 0; j < 4; ++j) a += (v[r][j].x * v[r][j].x + v[r][j].y * v[r][j].y) + (v[r][j].z * v[r][j].z + v[r][j].w * v[r][j].w);
        s[r] = a; }
#pragma unroll
    for (int o = 1; o < 64; o <<= 1)
#pragma unroll
        for (int r = 0; r < NR; ++r) s[r] += __shfl_xor(s[r], o);
#pragma unroll
    for (int r = 0; r < NR; ++r) { const float rstd = RSQF(s[r] * (1.f / DM) + EPS); u32x2* o8 = (u32x2*)orow[r] + lane;
#pragma unroll
        for (int j = 0; j < 4; ++j) {
            const f32x4 gg = ((const f32x4*)g)[lane + 64 * j], sh = ((const f32x4*)shift[r])[lane + 64 * j], sc = ((const f32x4*)scale[r])[lane + 64 * j];
            const f32x4 y = v[r][j] * rstd * gg * (sc + 1.0f) + sh;
            u32x2 w; w.x = pk2(y.x, y.y); w.y = pk2(y.z, y.w); o8[64 * j] = w; } }
}
DEV void p1_xn(Frame& F) {
    const float* mod = WSP(float, WS_MOD); bf16_t* XN = WSP(bf16_t, WS_XN);
    const int gw = F.bid * 8 + F.wave, NGW = F.G * 8;
    static_assert(NROWS % 8 == 0 && SEQ % 8 == 0 && NLAT % 8 == 0, "row octets");
    for (int q = gw; q < NROWS / 8; q += NGW) {
        const float* src[8]; const float* sh[8]; const float* sc[8]; bf16_t* dst[8];
#pragma unroll
        for (int i = 0; i < 8; ++i) { const int r = q * 8 + i; src[i] = r < NLAT ? F.pp->in[0] + (size_t)r * DM : F.pp->in[2] + (size_t)(r - NLAT) * DM;
            const int mv = r < NLAT ? r / SEQ : 2; sh[i] = mod + mv * 6144; sc[i] = mod + mv * 6144 + 1024; dst[i] = XN + (size_t)r * DM; }
        norm_mod_rows<8>(src, F.pp->in[6], sh, sc, dst, F.lane);
    }
}
DEV void p10_xn2(Frame& F) {
    const float* mod = WSP(float, WS_MOD); bf16_t* XN = WSP(bf16_t, WS_XN);
    const int gw = F.bid * 8 + F.wave, NGW = F.G * 8;
    for (int q = gw; q < NLAT / 4; q += NGW) {
        const float* src[4]; const float* sh[4]; const float* sc[4]; bf16_t* dst[4];
#pragma unroll
        for (int i = 0; i < 4; ++i) { const int r = q * 4 + i; src[i] = F.out + (size_t)r * DM; const int mv = r / SEQ; sh[i] = mod + mv * 6144 + 3 * 1024; sc[i] = mod + mv * 6144 + 4 * 1024; dst[i] = XN + (size_t)r * DM; }
        norm_mod_rows<4>(src, F.pp->in[7], sh, sc, dst, F.lane);
    }
}

#ifndef CONV_FUSED
#define CONV_FUSED 1
#endif
typedef f32x4 AccT[2][2][4][2];
DEV u32x2 pack4(f32x4 a) { u32x2 w; w.x = pk2(a.x, a.y); w.y = pk2(a.z, a.w); return w; }
DEV u32x4 pack8(f32x4 a, f32x4 b) { u32x4 w; w.x = pk2(a.x, a.y); w.y = pk2(a.z, a.w); w.z = pk2(b.x, b.y); w.w = pk2(b.z, b.w); return w; }
DEV f32x4 sig4(f32x4 a) { f32x4 r; r.x = sigmoidf_(a.x); r.y = sigmoidf_(a.y); r.z = sigmoidf_(a.z); r.w = sigmoidf_(a.w); return r; }
DEV void unpack8(u32x4 w, f32x4& a, f32x4& b) { a.x = bflo(w.x); a.y = bfhi(w.x); a.z = bflo(w.y); a.w = bfhi(w.y); b.x = bflo(w.z); b.y = bfhi(w.z); b.z = bflo(w.w); b.w = bfhi(w.w); }

#ifndef HOST_EMU
template <int D> DEV float rot16(float v, int) { return __builtin_bit_cast(float, __builtin_amdgcn_update_dpp(0, __builtin_bit_cast(int, v), 0x120 + ((16 - D) & 15), 0xF, 0xF, false)); }
#else
template <int D> DEV float rot16(float v, int lane) { return __shfl(v, (lane & 48) | ((lane + D) & 15)); }
#endif
struct EpiInProj {
    static constexpr bool PERM = true;
    bf16_t *Z, *XBC, *QK, *V, *O, *MG; float* DTG; const float *cwx, *cbx, *cwq, *cbq; LAS unsigned char* ldsx;
    DEV void operator()(const AccT& acc, const pg8::Unit& u, int wr, int wc, int fr_in, int fq_in) const {
        int fr = fr_in, fq = fq_in; OPAQUE_V(fr); OPAQUE_V(fq);
        const int row0 = u.pm * 256 + wr * 64 + fr; const int t = u.pn;
        if (CONV_FUSED && t >= 4 && t < 14 && u.pm * 256 < NLAT) {
            const bool isx = t < 10; bf16_t* base = isx ? XBC : QK; const int ldc = isx ? 1536 : 1024, colt = isx ? (t - 4) * 256 : (t - 10) * 256;
            const float* cw = isx ? cwx : cwq; const float* cb = isx ? cbx : cbq; const float osc = (!isx && colt < 512) ? 0.125f : 1.0f;
            const int lane = fq * 16 + fr;
            LAS float* wl = (LAS float*)(ldsx + (wr * 4 + wc) * 1536);
#pragma unroll
            for (int r = 0; r < 6; ++r) { const int cidx = lane, col = colt + (cidx >> 5) * 128 + wc * 32 + (cidx & 31); wl[r * 64 + cidx] = r < 5 ? cw[(size_t)r * ldc + col] : cb[col]; }
            WAVE_LDS_FENCE();
#pragma unroll
            for (int bj = 0; bj < 2; ++bj)
#pragma unroll
                for (int n = 0; n < 2; ++n) { const int col0 = colt + bj * 128 + wc * 32 + 8 * fq + 4 * n;
#pragma unroll
                    for (int ai = 0; ai < 2; ++ai) { f32x4 o[4];
#pragma unroll
                        for (int i = 0; i < 4; ++i) { float r1[5], r2[5], l1[5], l2[5]; r1[4] = 0.f; r2[4] = 0.f; l1[0] = 0.f; l2[0] = 0.f;
                            const int ci = bj * 32 + 8 * fq + 4 * n + i; const float w0 = wl[ci], w1 = wl[64 + ci], w2 = wl[128 + ci], w3 = wl[192 + ci], w4 = wl[256 + ci], bb = wl[320 + ci];
#pragma unroll
                            for (int m = 0; m < 4; ++m) { const float v = acc[ai][bj][m][n][i]; r1[m] = rot16<1>(v, lane); r2[m] = rot16<2>(v, lane); l1[m + 1] = rot16<-1>(v, lane); l2[m + 1] = rot16<-2>(v, lane); }
#pragma unroll
                            for (int m = 0; m < 4; ++m) { const float v = acc[ai][bj][m][n][i];
                                const float n1 = fr < 15 ? r1[m] : r1[m + 1], n2 = fr < 14 ? r2[m] : r2[m + 1], p1 = fr > 0 ? l1[m + 1] : l1[m], p2 = fr > 1 ? l2[m + 1] : l2[m];
                                const float a = bb + w0 * p2 + w1 * p1 + w2 * v + w3 * n1 + w4 * n2;
                                o[m][i] = siluf_(a) * osc; }
                            }
#pragma unroll
                        for (int m = 0; m < 4; ++m) *(u32x2*)(base + (size_t)(row0 + ai * 128 + m * 16) * ldc + col0) = pack4(o[m]);
                        MEM_FENCE(); SCHED_FENCE(); } }
        } else if (t < 30) {
            bf16_t* base; int ldc, colt; bool act = false;
            if (t < 4) { base = Z; ldc = 1024; colt = t * 256; }
            else if (t < 10) { base = XBC; ldc = 1536; colt = (t - 4) * 256; }
            else if (t < 14) { base = QK; ldc = 1024; colt = (t - 10) * 256; }
            else if (t < 18) { base = V; ldc = 1024; colt = (t - 14) * 256; }
            else if (t < 22) { base = O; ldc = 1024; colt = (t - 18) * 256; act = true; }
            else { base = MG; ldc = 2048; colt = (t - 22) * 256; act = true; }
            const int col0 = colt + wc * 32 + 8 * fq;
#pragma unroll
            for (int ai = 0; ai < 2; ++ai)
#pragma unroll
                for (int m = 0; m < 4; ++m) { bf16_t* rowp = base + (size_t)(row0 + ai * 128 + m * 16) * ldc + col0;
#pragma unroll
                    for (int bj = 0; bj < 2; ++bj) { f32x4 v0 = acc[ai][bj][m][0], v1 = acc[ai][bj][m][1];
                        if (act) { v0 = sig4(v0); v1 = sig4(v1); }
                        *(u32x4*)(rowp + bj * 128) = pack8(v0, v1); } }
        } else if (wc < 2) {
#pragma unroll
            for (int ai = 0; ai < 2; ++ai)
#pragma unroll
                for (int m = 0; m < 4; ++m)
#pragma unroll
                    for (int n = 0; n < 2; ++n) { const int c0 = 32 * wc + 8 * fq + 4 * n;
                        *(f32x4*)(DTG + (size_t)(row0 + ai * 128 + m * 16) * 64 + c0) = acc[ai][0][m][n]; }
        }
    }
};
struct EpiG1 {
    static constexpr bool PERM = true;
    bf16_t* M1; const bf16_t* MG; const float* SSQ;
    DEV void operator()(const AccT& acc, const pg8::Unit& u, int wr, int wc, int fr, int fq) const {
        const int row0 = u.pm * 256 + wr * 64 + fr, col0 = u.pn * 256 + wc * 32 + 8 * fq;
#pragma unroll
        for (int ai = 0; ai < 2; ++ai)
#pragma unroll
            for (int m = 0; m < 4; ++m) { const size_t row = (size_t)(row0 + ai * 128 + m * 16);
                const f32x4* sq = (const f32x4*)(SSQ + row * 16); const f32x4 q0 = sq[0], q1 = sq[1], q2 = sq[2], q3 = sq[3];
                const float ss = ((q0.x + q0.y) + (q0.z + q0.w)) + ((q1.x + q1.y) + (q1.z + q1.w)) + ((q2.x + q2.y) + (q2.z + q2.w)) + ((q3.x + q3.y) + (q3.z + q3.w));
                const float rstd = RSQF(ss * (1.f / 1024.f) + EPS);
#pragma unroll
                for (int bj = 0; bj < 2; ++bj) { f32x4 g0, g1; unpack8(*(const u32x4*)(MG + row * 2048 + col0 + bj * 128), g0, g1);
                    *(u32x4*)(M1 + row * 1024 + col0 + bj * 128) = pack8(acc[ai][bj][m][0] * g0 * rstd, acc[ai][bj][m][1] * g1 * rstd); } }
    }
};
struct EpiG2 {
    static constexpr bool PERM = true;
    bf16_t* MERGED; const bf16_t* M1; const bf16_t* MG;
    DEV void operator()(const AccT& acc, const pg8::Unit& u, int wr, int wc, int fr, int fq) const {
        const int row0 = u.pm * 256 + wr * 64 + fr, col0 = u.pn * 256 + wc * 32 + 8 * fq;
#pragma unroll
        for (int ai = 0; ai < 2; ++ai)
#pragma unroll
            for (int m = 0; m < 4; ++m) { const size_t row = (size_t)(row0 + ai * 128 + m * 16);
#pragma unroll
                for (int bj = 0; bj < 2; ++bj) { f32x4 g0, g1, p0, p1; unpack8(*(const u32x4*)(MG + row * 2048 + 1024 + col0 + bj * 128), g0, g1);
                    unpack8(*(const u32x4*)(M1 + row * 1024 + col0 + bj * 128), p0, p1);
                    *(u32x4*)(MERGED + row * 1024 + col0 + bj * 128) = pack8(p0 + acc[ai][bj][m][0] * g0, p1 + acc[ai][bj][m][1] * g1); } }
    }
};
struct EpiG3 {
    static constexpr bool PERM = false;
    const float* x; float* x1; const float* mod;
    DEV void operator()(const AccT& acc, const pg8::Unit& u, int wr, int wc, int fr, int fq) const {
        const int row0 = u.pm * 256 + wr * 64 + fr, col0 = u.pn * 256 + wc * 32 + 4 * fq;
        const float* gate = mod + ((u.pm * 256) / SEQ) * 6144 + 2 * 1024;
#pragma unroll
        for (int bj = 0; bj < 2; ++bj)
#pragma unroll
            for (int n = 0; n < 2; ++n) { const int c = col0 + bj * 128 + n * 16; const f32x4 gv = *(const f32x4*)(gate + c);
#pragma unroll
                for (int ai = 0; ai < 2; ++ai)
#pragma unroll
                    for (int m = 0; m < 4; ++m) { const size_t off = (size_t)(row0 + ai * 128 + m * 16) * 1024 + c;
                        *(f32x4*)(x1 + off) = *(const f32x4*)(x + off) + gv * acc[ai][bj][m][n]; } }
    }
};
struct EpiRS {
    static constexpr bool PERM = true;
    float* LOGIT; bf16_t* HS;
    DEV void operator()(const AccT& acc, const pg8::Unit& u, int wr, int wc, int fr, int fq) const {
        const int row0 = u.pm * 256 + wr * 64 + fr;
        if (u.pn == 0) {
            {
#pragma unroll
                for (int ai = 0; ai < 2; ++ai)
#pragma unroll
                    for (int m = 0; m < 4; ++m)
#pragma unroll
                        for (int bj = 0; bj < 2; ++bj)
#pragma unroll
                            for (int n = 0; n < 2; ++n) { const int c = bj * 128 + wc * 32 + 8 * fq + 4 * n;
                                if (c < NEXP) *(f32x4*)(LOGIT + (size_t)(row0 + ai * 128 + m * 16) * NEXP + c) = acc[ai][bj][m][n]; }
            }
        } else {
            const int col0 = (u.pn - 1) * 128 + wc * 32 + 8 * fq;
#pragma unroll
            for (int ai = 0; ai < 2; ++ai)
#pragma unroll
                for (int m = 0; m < 4; ++m) { f32x4 h0, h1;
#pragma unroll
                    for (int i = 0; i < 4; ++i) { h0[i] = siluf_(acc[ai][0][m][0][i]) * acc[ai][1][m][0][i]; h1[i] = siluf_(acc[ai][0][m][1][i]) * acc[ai][1][m][1][i]; }
                    *(u32x4*)(HS + (size_t)(row0 + ai * 128 + m * 16) * 256 + col0) = pack8(h0, h1); }
        }
    }
};
struct EpiX1 {
    static constexpr bool PERM = true;
    bf16_t* H;
    DEV void operator()(const AccT& acc, const pg8::Unit& u, int wr, int wc, int fr, int fq) const {
        const int row0 = u.pm * 256 + wr * 64 + fr, col0 = u.pn * 128 + wc * 32 + 8 * fq;
#pragma unroll
        for (int ai = 0; ai < 2; ++ai)
#pragma unroll
            for (int m = 0; m < 4; ++m) { f32x4 h0, h1;
#pragma unroll
                for (int i = 0; i < 4; ++i) { h0[i] = siluf_(acc[ai][0][m][0][i]) * acc[ai][1][m][0][i]; h1[i] = siluf_(acc[ai][0][m][1][i]) * acc[ai][1][m][1][i]; }
                *(u32x4*)(H + (size_t)(row0 + ai * 128 + m * 16) * 256 + col0) = pack8(h0, h1); }
    }
};
struct EpiX2 {
    static constexpr bool PERM = true;
    bf16_t* Y; const int* sdst; const float* sw;
    DEV void operator()(const AccT& acc, const pg8::Unit& u, int wr, int wc, int fr, int fq) const {
        const int row0 = u.pm * 256 + wr * 64 + fr, col0 = u.pn * 256 + wc * 32 + 8 * fq;
        int dst[8]; float w[8];
#pragma unroll
        for (int r = 0; r < 8; ++r) { const int slot = row0 + (r >> 2) * 128 + (r & 3) * 16; dst[r] = sdst[slot]; w[r] = sw[slot]; }
#pragma unroll
        for (int ai = 0; ai < 2; ++ai)
#pragma unroll
            for (int m = 0; m < 4; ++m) { const int d = dst[ai * 4 + m]; const float ww = w[ai * 4 + m];
                if (d >= 0) {
#pragma unroll
                    for (int bj = 0; bj < 2; ++bj) *(u32x4*)(Y + (size_t)d * 1024 + col0 + bj * 128) = pack8(acc[ai][bj][m][0] * ww, acc[ai][bj][m][1] * ww); } }
    }
};
struct EpiSD {
    static constexpr bool PERM = true;
    bf16_t* YS;
    DEV void operator()(const AccT& acc, const pg8::Unit& u, int wr, int wc, int fr, int fq) const {
        const int row0 = u.pm * 256 + wr * 64 + fr, col0 = u.pn * 256 + wc * 32 + 8 * fq;
#pragma unroll
        for (int ai = 0; ai < 2; ++ai)
#pragma unroll
            for (int m = 0; m < 4; ++m) { bf16_t* rp = YS + (size_t)(row0 + ai * 128 + m * 16) * 1024 + col0;
#pragma unroll
                for (int bj = 0; bj < 2; ++bj) *(u32x4*)(rp + bj * 128) = pack8(acc[ai][bj][m][0], acc[ai][bj][m][1]);
                MEM_FENCE(); }
    }
};

DEV int chunk_row0(int b, int cc) { return cc < NCH ? b * SEQ + cc * CHUNK : NLAT + b * CTXL + (cc - NCH) * CHUNK; }

struct GateBias { const float *dtb, *ib, *fb; };
template <bool ML> DEV void tok_ag(const float* DTG, const float* aneg, const GateBias& gbv, size_t row, int dir, int hg, float& a, float& g) {
    if (!ML) { const float dt = softplusf_(DTG[row * 64 + dir * 16 + hg] + gbv.dtb[dir * 16 + hg]); a = dt * aneg[dir * 16 + hg]; g = dt; }
    else { const float ig = DTG[row * 64 + 32 + dir * 16 + hg] + gbv.ib[dir * 8 + hg]; a = logsigmoidf_(DTG[row * 64 + 32 + dir * 16 + 8 + hg] + gbv.fb[dir * 8 + hg]); g = EXPF(ig); }
}
struct CtxW { float w[5][8], b[8]; };
DEV void ctx_conv_prep(CtxW& c, const float* cw, const float* cb, int ld, int col) {
#pragma unroll
    for (int j = 0; j < 5; ++j) { const f32x4 a = *(const f32x4*)(cw + (size_t)j * ld + col), d = *(const f32x4*)(cw + (size_t)j * ld + col + 4);
#pragma unroll
        for (int i = 0; i < 4; ++i) { c.w[j][i] = a[i]; c.w[j][4 + i] = d[i]; } }
    const f32x4 a = *(const f32x4*)(cb + col), d = *(const f32x4*)(cb + col + 4);
#pragma unroll
    for (int i = 0; i < 4; ++i) { c.b[i] = a[i]; c.b[4 + i] = d[i]; }
}
DEV u32x4 ctx_conv_chunk(const CtxW& c, const bf16_t* buf, int ld, int seg0, int kseg, int col) {
    float a[8];
#pragma unroll
    for (int i = 0; i < 8; ++i) a[i] = c.b[i];
#pragma unroll
    for (int j = 0; j < 5; ++j) { const int kk = kseg + j - 2;
        if (kk >= 0 && kk < CTXL) { f32x4 v0, v1; unpack8(*(const u32x4*)(buf + (size_t)(seg0 + kk) * ld + col), v0, v1);
#pragma unroll
            for (int i = 0; i < 4; ++i) { a[i] += c.w[j][i] * v0[i]; a[4 + i] += c.w[j][4 + i] * v1[i]; } } }
    f32x4 o0, o1;
#pragma unroll
    for (int i = 0; i < 4; ++i) { o0[i] = siluf_(a[i]); o1[i] = siluf_(a[4 + i]); }
    return pack8(o0, o1);
}

DEV int chunk_order(int dir, int s) { return dir == 0 ? (s < NCHC ? NCH + s : s - NCHC) : (s < NCHC ? NCH + (NCHC - 1 - s) : NCH - 1 - (s - NCHC)); }
DEV void p5_scan(Frame& F) {
    const int NS = BATCH * 2 * SSD_H * SSD_P * (SSD_N / 8), NM = BATCH * 2 * ML_H * ML_PP * (ML_DK / 8);
    const int gt = F.bid * NTHR + F.tid, GT = F.G * NTHR;
    for (int idx = gt; idx < NS + NM; idx += GT) {
        bf16_t* base; const float* dec; size_t cstride; int dstride, dir;
        if (idx < NS) { const int n8 = idx % 16, p = (idx / 16) % 64, hd = (idx / 1024) % 16; dir = (idx / 16384) % 2; const int b = idx / 32768;
            base = WSP(bf16_t, WS_STS) + (size_t)(b * 2 + dir) * NCHT * STS_CH + ((size_t)hd * 64 + p) * 128 + n8 * 8; cstride = STS_CH;
            dec = WSP(float, WS_DECS) + (size_t)(b * 2 + dir) * NCHT * 16 + hd; dstride = 16; }
        else { const int j = idx - NS; const int n8 = j % 8, p = (j / 8) % 144, hd = (j / 1152) % 8; dir = (j / 9216) % 2; const int b = j / 18432;
            base = WSP(bf16_t, WS_STM) + (size_t)(b * 2 + dir) * NCHT * STM_CH + ((size_t)hd * 144 + p) * 64 + n8 * 8; cstride = STM_CH;
            dec = WSP(float, WS_DECM) + (size_t)(b * 2 + dir) * NCHT * 8 + hd; dstride = 8; }
        f32x4 c0 = {0.f, 0.f, 0.f, 0.f}, c1 = {0.f, 0.f, 0.f, 0.f};
        constexpr int UB = (NCHT % 10 == 0) ? 10 : ((NCHT % 2 == 0) ? 2 : 1);
        for (int s0 = 0; s0 < NCHT; s0 += UB) {
            u32x4 v[UB]; float d[UB];
#pragma unroll
            for (int j = 0; j < UB; ++j) { const int cc = chunk_order(dir, s0 + j); v[j] = *(const u32x4*)(base + (size_t)cc * cstride); d[j] = dec[cc * dstride]; }
#pragma unroll
            for (int j = 0; j < UB; ++j) { const int cc = chunk_order(dir, s0 + j);
                if (cc < NCH) *(u32x4*)(base + (size_t)cc * cstride) = pack8(c0, c1);
                f32x4 a0, a1; unpack8(v[j], a0, a1); c0 = c0 * d[j] + a0; c1 = c1 * d[j] + a1; }
        }
    }
}

DEV bf16x8 tr_frag(const LAS bf16_t* T, int LD, int k0, int c0, int lane) {
    const LAS bf16_t* p0 = T + (k0 + 8 * (lane >> 4) + ((lane & 15) >> 2)) * LD + c0 + 4 * (lane & 3);
    const s16x4 a = lds_tr16(p0), b = lds_tr16(p0 + 4 * LD);
    bf16x8 r; r[0] = a[0]; r[1] = a[1]; r[2] = a[2]; r[3] = a[3]; r[4] = b[0]; r[5] = b[1]; r[6] = b[2]; r[7] = b[3]; return r;
}
DEV bf16x8 tr_frag8(const LAS bf16_t* T, int LD, int k0, int c0, int lane) {
    const LAS bf16_t* p0 = T + (k0 + 8 * (lane >> 4) + ((lane & 15) >> 2)) * LD + c0 + 8 * (lane & 3);
    const s16x4 a = lds_tr16(p0), b = lds_tr16(p0 + 4 * LD);
    bf16x8 r; r[0] = a[0]; r[1] = a[1]; r[2] = a[2]; r[3] = a[3]; r[4] = b[0]; r[5] = b[1]; r[6] = b[2]; r[7] = b[3]; return r;
}
DEV bf16x8 row_frag(const LAS bf16_t* T, int LD, int r0, int k0, int lane) { return *(const LAS bf16x8*)(T + (r0 + (lane & 15)) * LD + k0 + 8 * (lane >> 4)); }
DEV float gtv(u32x2 g, int i) { return i == 0 ? bflo(g.x) : (i == 1 ? bfhi(g.x) : (i == 2 ? bflo(g.y) : bfhi(g.y))); }

DEV void s3v2_ssd(Frame& F, int b, int cc, int gi, const float* aneg) {
    constexpr int LDC = 136, LDX = 80;
    const bf16_t* XBC = WSP(bf16_t, WS_XBC); const float* DTG = WSP(float, WS_DTG); const bf16_t* Z = WSP(bf16_t, WS_Z); bf16_t* YP = WSP(bf16_t, WS_YPRE); float* SSQ = WSP(float, WS_SSQ);
    LAS bf16_t* CQ = (LAS bf16_t*)F.lds;
    LAS bf16_t* GLB = CQ + 128 * LDC;
    LAS bf16_t* XS = GLB + 128 * LDC;
    LAS bf16_t* STF = XS + 128 * LDX;
    LAS bf16_t* STB = STF + 64 * LDC;
    LAS float* Pf = (LAS float*)(STB + 64 * LDC);
    LAS float* Eb = Pf + 128; LAS float* gf = Eb + 128; LAS float* gb = gf + 128; LAS float* itf = gb + 128; LAS float* itb = itf + 128;
    int tid_ = F.tid; OPAQUE_V(tid_);
    const int row0 = chunk_row0(b, cc), w = F.wave, tid = tid_, lane = tid & 63, lq = lane >> 4, lc = lane & 15;
    SYNC();
    for (int idx = tid; idx < 128 * 16; idx += NTHR) { const int k = idx >> 4, n8 = idx & 15;
        *(LAS u32x4*)(CQ + k * LDC + n8 * 8) = *(const u32x4*)(XBC + (size_t)(row0 + k) * 1536 + 1280 + gi * 128 + n8 * 8);
        *(LAS u32x4*)(GLB + k * LDC + n8 * 8) = *(const u32x4*)(XBC + (size_t)(row0 + k) * 1536 + 1024 + gi * 128 + n8 * 8); }
    u32x4 rx[2], rsf[2], rsb[2]; float rdt[2];
#define S3S_LOAD(hh) do { const int hg_ = gi * 8 + (hh); \
        _Pragma("unroll") for (int j_ = 0; j_ < 2; ++j_) { const int id_ = tid + NTHR * j_; \
            rx[j_] = *(const u32x4*)(XBC + (size_t)(row0 + (id_ >> 3)) * 1536 + hg_ * 64 + (id_ & 7) * 8); \
            rsf[j_] = *(const u32x4*)(WSP(bf16_t, WS_STS) + ((size_t)(b * 2 + 0) * NCHT + cc) * STS_CH + (size_t)hg_ * 8192 + (size_t)id_ * 8); \
            rsb[j_] = *(const u32x4*)(WSP(bf16_t, WS_STS) + ((size_t)(b * 2 + 1) * NCHT + cc) * STS_CH + (size_t)hg_ * 8192 + (size_t)id_ * 8); \
            } \
        if (w < 2) { rdt[0] = DTG[(size_t)(row0 + lane) * 64 + w * 16 + hg_]; rdt[1] = DTG[(size_t)(row0 + 64 + lane) * 64 + w * 16 + hg_]; } } while (0)
    S3S_LOAD(0);
    SYNC();
    bf16x8 aC[4];
#pragma unroll
    for (int ns = 0; ns < 4; ++ns) aC[ns] = row_frag(CQ, LDC, w * 16, ns * 32, lane);
    u32x2 Gt[8];
#pragma unroll
    for (int ct = 0; ct < 8; ++ct) { f32x4 z = {0.f, 0.f, 0.f, 0.f};
#pragma unroll
        for (int ns = 0; ns < 4; ++ns) z = mfma16(aC[ns], row_frag(GLB, LDC, ct * 16, ns * 32, lane), z);
        Gt[ct] = pack4(z); }
#pragma unroll 1
    for (int h = 0; h < 8; ++h) {
        const int hg = gi * 8 + h;
        SYNC();
#pragma unroll
        for (int j = 0; j < 2; ++j) { const int id = tid + NTHR * j;
            *(LAS u32x4*)(XS + (id >> 3) * LDX + (id & 7) * 8) = rx[j];
            *(LAS u32x4*)(STF + (id >> 4) * LDC + (id & 15) * 8) = rsf[j];
            *(LAS u32x4*)(STB + (id >> 4) * LDC + (id & 15) * 8) = rsb[j]; }
        if (w < 2) { const float an = aneg[w * 16 + hg], db = F.pp->in[11][w * 16 + hg]; rdt[0] = softplusf_(rdt[0] + db); rdt[1] = softplusf_(rdt[1] + db); const float a0 = rdt[0] * an, a1 = rdt[1] * an;
            const float p0 = wave_incl_scan(a0, lane); const float t0 = __shfl(p0, 63);
            const float p1 = wave_incl_scan(a1, lane) + t0; const float T = __shfl(p1, 63);
            if (w == 0) { Pf[lane] = p0; Pf[64 + lane] = p1; gf[lane] = rdt[0]; gf[64 + lane] = rdt[1]; itf[lane] = EXPF(p0); itf[64 + lane] = EXPF(p1); }
            else { const float e0 = p0 - a0, e1 = p1 - a1; Eb[lane] = e0; Eb[64 + lane] = e1; gb[lane] = rdt[0]; gb[64 + lane] = rdt[1]; itb[lane] = EXPF(T - e0); itb[64 + lane] = EXPF(T - e1); } }
        if (h + 1 < 8) S3S_LOAD(h + 1);
        SYNC();
        const u32x4 zc0 = *(const u32x4*)(Z + (size_t)(row0 + 16 * w + (lane >> 3)) * 1024 + hg * 64 + (lane & 7) * 8), zc1 = *(const u32x4*)(Z + (size_t)(row0 + 16 * w + (lane >> 3) + 8) * 1024 + hg * 64 + (lane & 7) * 8);
        float pfq[4], ebq[4];
#pragma unroll
        for (int i = 0; i < 4; ++i) { pfq[i] = Pf[w * 16 + 4 * lq + i]; ebq[i] = Eb[w * 16 + 4 * lq + i]; }
#pragma unroll
        for (int ct = 0; ct < 8; ++ct) { const int k = ct * 16 + lc, rel = ct - w;
            const float pk = rel <= 0 ? Pf[k] : 0.f, ek = rel >= 0 ? Eb[k] : 0.f, gfk = rel <= 0 ? gf[k] : 0.f, gbk = rel >= 0 ? gb[k] : 0.f;
#pragma unroll
            for (int i = 0; i < 4; ++i) { const int d = 4 * lq + i - lc; float fac;
                if (rel < 0) fac = EXPF(pfq[i] - pk) * gfk;
                else if (rel > 0) fac = EXPF(ek - ebq[i]) * gbk;
                else fac = d > 0 ? EXPF(pfq[i] - pk) * gfk : (d < 0 ? EXPF(ek - ebq[i]) * gbk : gfk + gbk);
                GLB[(w * 16 + 4 * lq + i) * LDC + k] = (bf16_t)f2bf(gtv(Gt[ct], i) * fac); } }
        WAVE_LDS_FENCE();
        bf16x8 aG[4];
#pragma unroll
        for (int ks = 0; ks < 4; ++ks) aG[ks] = row_frag(GLB, LDC, w * 16, ks * 32, lane);
        float iqf[4], iqb[4];
#pragma unroll
        for (int i = 0; i < 4; ++i) { iqf[i] = itf[w * 16 + 4 * lq + i]; iqb[i] = itb[w * 16 + 4 * lq + i]; }
        WAVE_LDS_FENCE();
        LAS float* OUTW = (LAS float*)(GLB + w * 16 * LDC);
#pragma unroll 1
        for (int pt = 0; pt < 4; ++pt) { f32x4 a1 = {0.f, 0.f, 0.f, 0.f}, af = {0.f, 0.f, 0.f, 0.f}, ab = {0.f, 0.f, 0.f, 0.f};
#pragma unroll
            for (int ks = 0; ks < 4; ++ks) a1 = mfma16(aG[ks], tr_frag(XS, LDX, ks * 32, pt * 16, lane), a1);
#pragma unroll
            for (int ns = 0; ns < 4; ++ns) { af = mfma16(aC[ns], row_frag(STF, LDC, pt * 16, ns * 32, lane), af); ab = mfma16(aC[ns], row_frag(STB, LDC, pt * 16, ns * 32, lane), ab); }
#pragma unroll
            for (int i = 0; i < 4; ++i) OUTW[(4 * lq + i) * (LDC / 2) + pt * 16 + lc] = a1[i] + iqf[i] * af[i] + iqb[i] * ab[i]; }
        WAVE_LDS_FENCE();
        const float dsk = F.pp->in[13][hg]; const float* ng = F.pp->in[14] + hg * 64 + (lane & 7) * 8;
        const f32x4 ng0 = *(const f32x4*)ng, ng1 = *(const f32x4*)(ng + 4);
#pragma unroll
        for (int r = 0; r < 2; ++r) { const int ql = (lane >> 3) + 8 * r, ch = lane & 7; const size_t row = (size_t)(row0 + 16 * w + ql);
            const f32x4 y0 = *(const LAS f32x4*)(OUTW + ql * (LDC / 2) + ch * 8), y1 = *(const LAS f32x4*)(OUTW + ql * (LDC / 2) + ch * 8 + 4);
            f32x4 x0, x1, z0, z1; unpack8(*(const LAS u32x4*)(XS + (16 * w + ql) * LDX + ch * 8), x0, x1); unpack8(r == 0 ? zc0 : zc1, z0, z1);
            f32x4 t0, t1; float ss = 0.f;
#pragma unroll
            for (int i = 0; i < 4; ++i) { t0[i] = (y0[i] + dsk * x0[i]) * siluf_(z0[i]); t1[i] = (y1[i] + dsk * x1[i]) * siluf_(z1[i]); ss += t0[i] * t0[i] + t1[i] * t1[i]; }
            *(u32x4*)(YP + row * 1024 + hg * 64 + ch * 8) = pack8(t0 * ng0, t1 * ng1);
            ss += __shfl_xor(ss, 1); ss += __shfl_xor(ss, 2); ss += __shfl_xor(ss, 4);
            if (ch == 0) SSQ[row * 16 + hg] = ss; }
    }
#undef S3S_LOAD
}

struct MlRegs { u32x4 q[2], k[2], v[4], sf[3], sb[3]; float g[4]; };
DEV void s3v2_ml_load(Frame& F, MlRegs& R, int b, int cc, int hd) {
    const bf16_t* QK = WSP(bf16_t, WS_QK); const bf16_t* V = WSP(bf16_t, WS_V); const float* DTG = WSP(float, WS_DTG);
    int tid_ = F.tid; OPAQUE_V(tid_);
    const int row0 = chunk_row0(b, cc), tid = tid_, lane = tid & 63, w = F.wave;
#pragma unroll
    for (int j = 0; j < 2; ++j) { const int id = tid + NTHR * j; R.q[j] = *(const u32x4*)(QK + (size_t)(row0 + (id >> 3)) * 1024 + hd * 64 + (id & 7) * 8); R.k[j] = *(const u32x4*)(QK + (size_t)(row0 + (id >> 3)) * 1024 + 512 + hd * 64 + (id & 7) * 8); }
#pragma unroll
    for (int j = 0; j < 4; ++j) { const int id = tid + NTHR * j; R.v[j] = *(const u32x4*)(V + (size_t)(row0 + (id >> 4)) * 1024 + hd * 128 + (id & 15) * 8); }
#pragma unroll
    for (int j = 0; j < 3; ++j) { const int id = tid + NTHR * j; if (id < 144 * 8) {
        R.sf[j] = *(const u32x4*)(WSP(bf16_t, WS_STM) + ((size_t)(b * 2 + 0) * NCHT + cc) * STM_CH + (size_t)hd * 9216 + (size_t)id * 8);
        R.sb[j] = *(const u32x4*)(WSP(bf16_t, WS_STM) + ((size_t)(b * 2 + 1) * NCHT + cc) * STM_CH + (size_t)hd * 9216 + (size_t)id * 8); } }
    if (w < 2) { R.g[0] = DTG[(size_t)(row0 + lane) * 64 + 32 + w * 16 + hd]; R.g[1] = DTG[(size_t)(row0 + 64 + lane) * 64 + 32 + w * 16 + hd];
                 R.g[2] = DTG[(size_t)(row0 + lane) * 64 + 32 + w * 16 + 8 + hd]; R.g[3] = DTG[(size_t)(row0 + 64 + lane) * 64 + 32 + w * 16 + 8 + hd]; }
}
DEV void s3v2_ml_item(Frame& F, MlRegs& R, int b, int cc, int hd, bool has_next, int nb, int ncc, int nhd) {
    constexpr int LDQ = 72, LDG = 136, LDV = 144;
    LAS bf16_t* CQ = (LAS bf16_t*)F.lds;
    LAS bf16_t* GLB = CQ + 128 * LDQ;
    LAS bf16_t* XS = GLB + 128 * LDG;
    LAS bf16_t* STF = XS + 128 * LDV;
    LAS bf16_t* STB = STF + 144 * LDQ;
    LAS float* Pf = (LAS float*)(STB + 144 * LDQ); LAS float* Eb = Pf + 128; LAS float* gf = Eb + 128; LAS float* gb = gf + 128; LAS float* itf = gb + 128; LAS float* itb = itf + 128;
    int tid_ = F.tid; OPAQUE_V(tid_);
    const int row0 = chunk_row0(b, cc), w = F.wave, tid = tid_, lane = tid & 63, lq = lane >> 4, lc = lane & 15;
    SYNC();
#pragma unroll
    for (int j = 0; j < 2; ++j) { const int id = tid + NTHR * j; *(LAS u32x4*)(CQ + (id >> 3) * LDQ + (id & 7) * 8) = R.q[j]; *(LAS u32x4*)(GLB + (id >> 3) * LDQ + (id & 7) * 8) = R.k[j]; }
#pragma unroll
    for (int j = 0; j < 4; ++j) { const int id = tid + NTHR * j; *(LAS u32x4*)(XS + (id >> 4) * LDV + (id & 15) * 8) = R.v[j]; }
    if (tid < 256) { const int k = tid >> 1, hf = tid & 1; u32x4 o = {0u, 0u, 0u, 0u}; if (hf == 0) o.x = 0x3F80u; *(LAS u32x4*)(XS + k * LDV + 128 + hf * 8) = o; }
#pragma unroll
    for (int j = 0; j < 3; ++j) { const int id = tid + NTHR * j; if (id < 144 * 8) { *(LAS u32x4*)(STF + (id >> 3) * LDQ + (id & 7) * 8) = R.sf[j]; *(LAS u32x4*)(STB + (id >> 3) * LDQ + (id & 7) * 8) = R.sb[j]; } }
    if (w < 2) { const float ibv = F.pp->in[17][w * 8 + hd], fbv = F.pp->in[18][w * 8 + hd];
        const float a0 = logsigmoidf_(R.g[2] + fbv), a1 = logsigmoidf_(R.g[3] + fbv), g0 = EXPF(R.g[0] + ibv), g1 = EXPF(R.g[1] + ibv);
        const float p0 = wave_incl_scan(a0, lane); const float t0 = __shfl(p0, 63);
        const float p1 = wave_incl_scan(a1, lane) + t0; const float T = __shfl(p1, 63);
        if (w == 0) { Pf[lane] = p0; Pf[64 + lane] = p1; gf[lane] = g0; gf[64 + lane] = g1; itf[lane] = EXPF(p0); itf[64 + lane] = EXPF(p1); }
        else { const float e0 = p0 - a0, e1 = p1 - a1; Eb[lane] = e0; Eb[64 + lane] = e1; gb[lane] = g0; gb[64 + lane] = g1; itb[lane] = EXPF(T - e0); itb[64 + lane] = EXPF(T - e1); } }
    if (has_next) s3v2_ml_load(F, R, nb, ncc, nhd);
    SYNC();
    bf16x8 aC[2];
#pragma unroll
    for (int ns = 0; ns < 2; ++ns) aC[ns] = row_frag(CQ, LDQ, w * 16, ns * 32, lane);
    u32x2 Gt[8];
#pragma unroll
    for (int ct = 0; ct < 8; ++ct) { f32x4 z = {0.f, 0.f, 0.f, 0.f};
#pragma unroll
        for (int ns = 0; ns < 2; ++ns) z = mfma16(aC[ns], row_frag(GLB, LDQ, ct * 16, ns * 32, lane), z);
        Gt[ct] = pack4(z); }
    SYNC();
    u32x4 oc[4];
#pragma unroll
    for (int r = 0; r < 4; ++r) oc[r] = *(const u32x4*)(WSP(bf16_t, WS_O) + (size_t)(row0 + 16 * w + (lane >> 4) + 4 * r) * 1024 + hd * 128 + (lane & 15) * 8);
    bf16x8 aG[2][4]; f32x4 rden[2]; float iq[2][4];
#pragma unroll
    for (int dir = 0; dir < 2; ++dir) {
        const LAS float* PE = dir == 0 ? Pf : Eb; const LAS float* gg = dir == 0 ? gf : gb; const LAS float* it = dir == 0 ? itf : itb; const LAS bf16_t* ST = dir == 0 ? STF : STB;
        float peq[4];
#pragma unroll
        for (int i = 0; i < 4; ++i) { peq[i] = PE[w * 16 + 4 * lq + i]; iq[dir][i] = it[w * 16 + 4 * lq + i]; }
        WAVE_LDS_FENCE();
#pragma unroll
        for (int ct = 0; ct < 8; ++ct) { const int k = ct * 16 + lc, rel = ct - w; const bool tile_on = dir == 0 ? rel <= 0 : rel >= 0;
            if (tile_on) { const float pek = PE[k], gk = gg[k];
#pragma unroll
                for (int i = 0; i < 4; ++i) { const int d = 4 * lq + i - lc; const bool on = rel != 0 || (dir == 0 ? d >= 0 : d <= 0);
                    const float ex = dir == 0 ? peq[i] - pek : pek - peq[i];
                    GLB[(w * 16 + 4 * lq + i) * LDG + k] = (bf16_t)f2bf(on ? gtv(Gt[ct], i) * EXPF(ex) * gk : 0.f); }
            } else {
#pragma unroll
                for (int i = 0; i < 4; ++i) GLB[(w * 16 + 4 * lq + i) * LDG + k] = (bf16_t)0; } }
        WAVE_LDS_FENCE();
#pragma unroll
        for (int ks = 0; ks < 4; ++ks) aG[dir][ks] = row_frag(GLB, LDG, w * 16, ks * 32, lane);
        f32x4 a1 = {0.f, 0.f, 0.f, 0.f}, a2 = {0.f, 0.f, 0.f, 0.f};
#pragma unroll
        for (int ks = 0; ks < 4; ++ks) a1 = mfma16(aG[dir][ks], tr_frag(XS, LDV, ks * 32, 128, lane), a1);
#pragma unroll
        for (int ns = 0; ns < 2; ++ns) a2 = mfma16(aC[ns], row_frag(ST, LDQ, 128, ns * 32, lane), a2);
#pragma unroll
        for (int i = 0; i < 4; ++i) { const float dv = a1[i] + iq[dir][i] * a2[i]; rden[dir][i] = RCPF(fmaxf(fabsf(__shfl(dv, lane & 48)), 1.0f)); }
    }
    WAVE_LDS_FENCE();
    float ss[4] = {0.f, 0.f, 0.f, 0.f};
#pragma unroll 1
    for (int pt = 0; pt < 8; ++pt) { f32x4 af = {0.f, 0.f, 0.f, 0.f}, ab = {0.f, 0.f, 0.f, 0.f}, sf = {0.f, 0.f, 0.f, 0.f}, sb = {0.f, 0.f, 0.f, 0.f};
#pragma unroll
        for (int ks = 0; ks < 4; ++ks) { const bf16x8 xb = tr_frag(XS, LDV, ks * 32, pt * 16, lane); af = mfma16(aG[0][ks], xb, af); ab = mfma16(aG[1][ks], xb, ab); }
#pragma unroll
        for (int ns = 0; ns < 2; ++ns) { sf = mfma16(aC[ns], row_frag(STF, LDQ, pt * 16, ns * 32, lane), sf); sb = mfma16(aC[ns], row_frag(STB, LDQ, pt * 16, ns * 32, lane), sb); }
#pragma unroll
        for (int i = 0; i < 4; ++i) { const float hv = (af[i] + iq[0][i] * sf[i]) * rden[0][i] + (ab[i] + iq[1][i] * sb[i]) * rden[1][i]; ss[i] += hv * hv;
            GLB[(w * 16 + 4 * lq + i) * LDG + pt * 16 + lc] = (bf16_t)f2bf(hv); } }
    LAS float* rsw = itb + 128 + w * 16;
#pragma unroll
    for (int i = 0; i < 4; ++i) { float sv = ss[i]; sv += __shfl_xor(sv, 1); sv += __shfl_xor(sv, 2); sv += __shfl_xor(sv, 4); sv += __shfl_xor(sv, 8);
        if (lc == 0) rsw[4 * lq + i] = RSQF(sv * (1.f / 128.f) + EPS); }
    WAVE_LDS_FENCE();
    bf16_t* HP = WSP(bf16_t, WS_HP); const float* ng = F.pp->in[19] + hd * 128 + (lane & 15) * 8;
    const f32x4 ng0 = *(const f32x4*)ng, ng1 = *(const f32x4*)(ng + 4);
#pragma unroll
    for (int r = 0; r < 4; ++r) { const int ql = (lane >> 4) + 4 * r, ch = lane & 15; const size_t row = (size_t)(row0 + 16 * w + ql); const float rsq = rsw[ql];
        f32x4 h0, h1, o0, o1; unpack8(*(const LAS u32x4*)(GLB + (w * 16 + ql) * LDG + ch * 8), h0, h1); unpack8(oc[r], o0, o1);
        *(u32x4*)(HP + row * 1024 + hd * 128 + ch * 8) = pack8(h0 * rsq * ng0 * o0, h1 * rsq * ng1 * o1); }
}
DEV void p6v2_outputs(Frame& F) {
    LAS float* aneg_l = (LAS float*)(F.lds + LDS_BYTES - 256);
    if (F.tid < 32) aneg_l[F.tid] = -EXPF(F.pp->in[12][F.tid]);
    SYNC();
    const int nS = BATCH * NCH * 2, nM = BATCH * NCH * 8;
#pragma unroll 1
    for (int it = F.bid; it < nS; it += F.G) { const int b = it / (NCH * 2), r = it % (NCH * 2); s3v2_ssd(F, b, r / 2, r % 2, (const float*)aneg_l); }
    SYNC();
    MlRegs R;
    if (F.bid < nM) { const int it = F.bid; s3v2_ml_load(F, R, it / (NCH * 8), (it % (NCH * 8)) / 8, it % 8); }
#pragma unroll 1
    for (int it = F.bid; it < nM; it += F.G) { const int nx = it + F.G; const bool hn = nx < nM;
        s3v2_ml_item(F, R, it / (NCH * 8), (it % (NCH * 8)) / 8, it % 8, hn, nx / (NCH * 8), (nx % (NCH * 8)) / 8, nx % 8); }
    SYNC();
}

template <bool ML> struct S1K { static constexpr int NN = ML ? 64 : 128, LDB = ML ? 80 : 144, NHS = ML ? 1 : 4, PD = ML ? 128 : 64, XC = ML ? 144 : 256, LDXW = ML ? 144 : 272, NQ = ML ? 1 : 2, NXR = ML ? 4 : 8, NBK = ML ? 2 : 4, PPH = ML ? 144 : 64, CPR = NHS * PD / 8; };
template <bool ML> struct S1Regs { u32x4 x[S1K<ML>::NXR]; u32x4 bk[S1K<ML>::NBK]; float g[4]; };
DEV void s1_decode(int code, int& b, int& cc, int& gi) { b = code >> 20; cc = (code >> 8) & 0xfff; gi = code & 0xff; }
template <bool ML> DEV void s1_load(Frame& F, S1Regs<ML>& R, int code, int hq) {
    typedef S1K<ML> K; int b, cc, gi; s1_decode(code, b, cc, gi);
    const bf16_t* XBC = WSP(bf16_t, WS_XBC); const bf16_t* QK = WSP(bf16_t, WS_QK); const bf16_t* V = WSP(bf16_t, WS_V); const float* DTG = WSP(float, WS_DTG);
    int tid_ = F.tid; OPAQUE_V(tid_); const int tid = tid_, lane = tid & 63, w = F.wave, row0 = chunk_row0(b, cc);
    const bool isctx = cc >= NCH; const int seg0 = NLAT + b * CTXL, kseg0 = (cc - NCH) * CHUNK;
    const bf16_t* Xsrc = ML ? V + gi * 128 : XBC + (gi * 8 + hq * 4) * 64; const int ldx = ML ? 1024 : 1536;
    if (ML || !isctx) {
#pragma unroll
        for (int j = 0; j < K::NXR; ++j) { const int id = tid + NTHR * j; R.x[j] = *(const u32x4*)(Xsrc + (size_t)(row0 + id / K::CPR) * ldx + (id % K::CPR) * 8); }
    } else { static_assert(NTHR % K::CPR == 0, "a thread's chunks share their columns");
        const int col = (gi * 8 + hq * 4) * 64 + (tid % K::CPR) * 8; CtxW cwv; ctx_conv_prep(cwv, F.pp->in[9], F.pp->in[10], 1536, col);
#pragma unroll
        for (int j = 0; j < K::NXR; ++j) { const int id = tid + NTHR * j; R.x[j] = ctx_conv_chunk(cwv, XBC, 1536, seg0, kseg0 + id / K::CPR, col); } }
    if (hq == 0) { const bf16_t* Bsrc = ML ? QK + 512 + gi * 64 : XBC + 1024 + gi * 128; const int ldb = ML ? 1024 : 1536;
        if (!isctx) {
#pragma unroll
            for (int j = 0; j < K::NBK; ++j) { const int id = tid + NTHR * j, k = id / (K::NN / 8), n8 = id % (K::NN / 8); R.bk[j] = *(const u32x4*)(Bsrc + (size_t)(row0 + k) * ldb + n8 * 8); }
        } else { static_assert(NTHR % (K::NN / 8) == 0, "a thread's chunks share their columns");
            const int col = (ML ? 512 + gi * 64 : 1024 + gi * 128) + (tid % (K::NN / 8)) * 8; CtxW cwv; ctx_conv_prep(cwv, ML ? F.pp->in[15] : F.pp->in[9], ML ? F.pp->in[16] : F.pp->in[10], ldb, col);
#pragma unroll
            for (int j = 0; j < K::NBK; ++j) { const int id = tid + NTHR * j; R.bk[j] = ctx_conv_chunk(cwv, ML ? QK : XBC, ldb, seg0, kseg0 + id / (K::NN / 8), col); } } }
    if (!ML) { const int dir = w >> 2, hg = gi * 8 + hq * 4 + (w & 3);
        R.g[0] = DTG[(size_t)(row0 + lane) * 64 + dir * 16 + hg]; R.g[1] = DTG[(size_t)(row0 + 64 + lane) * 64 + dir * 16 + hg]; }
    else if (w < 2) { R.g[0] = DTG[(size_t)(row0 + lane) * 64 + 32 + w * 16 + gi]; R.g[1] = DTG[(size_t)(row0 + 64 + lane) * 64 + 32 + w * 16 + gi];
                      R.g[2] = DTG[(size_t)(row0 + lane) * 64 + 32 + w * 16 + 8 + gi]; R.g[3] = DTG[(size_t)(row0 + 64 + lane) * 64 + 32 + w * 16 + 8 + gi]; }
}
template <bool ML> DEV void s1_stage(Frame& F, S1Regs<ML>& R, int code, int hq, bool has_next, int ncode, int nhq, const float* aneg) {
    typedef S1K<ML> K; int b, cc, gi; s1_decode(code, b, cc, gi);
    LAS bf16_t* BKN = (LAS bf16_t*)F.lds;
    LAS bf16_t* XW = BKN + 128 * K::LDB;
    LAS float* wl = (LAS float*)(XW + 128 * K::LDXW);
    int tid_ = F.tid; OPAQUE_V(tid_); const int tid = tid_, lane = tid & 63, w = F.wave;
    SYNC();
    if (hq == 0) {
#pragma unroll
        for (int j = 0; j < K::NBK; ++j) { const int id = tid + NTHR * j; *(LAS u32x4*)(BKN + (id / (K::NN / 8)) * K::LDB + (id % (K::NN / 8)) * 8) = R.bk[j]; } }
    u32x4 xc[K::NXR];
#pragma unroll
    for (int j = 0; j < K::NXR; ++j) xc[j] = R.x[j];
    float gc[4];
#pragma unroll
    for (int j = 0; j < 4; ++j) gc[j] = R.g[j];
    if (has_next) s1_load<ML>(F, R, ncode, nhq);
    if (!ML || w < 2) { const int dir = ML ? w : (w >> 2), hl = ML ? 0 : (w & 3), hg = ML ? gi : gi * 8 + hq * 4 + hl;
        float a0, a1, g0, g1;
        if (!ML) { const float db = F.pp->in[11][dir * 16 + hg], an = aneg[dir * 16 + hg]; g0 = softplusf_(gc[0] + db); g1 = softplusf_(gc[1] + db); a0 = g0 * an; a1 = g1 * an; }
        else { const float ibv = F.pp->in[17][dir * 8 + hg], fbv = F.pp->in[18][dir * 8 + hg]; g0 = EXPF(gc[0] + ibv); g1 = EXPF(gc[1] + ibv); a0 = logsigmoidf_(gc[2] + fbv); a1 = logsigmoidf_(gc[3] + fbv); }
        const float p0 = wave_incl_scan(a0, lane); const float t0 = __shfl(p0, 63);
        const float p1 = wave_incl_scan(a1, lane) + t0; const float T = __shfl(p1, 63);
        float w0, w1;
        if (dir == 0) { w0 = EXPF(T - p0) * g0; w1 = EXPF(T - p1) * g1; } else { w0 = EXPF(p0 - a0) * g0; w1 = EXPF(p1 - a1) * g1; }
        wl[(dir * K::NHS + hl) * 128 + lane] = w0; wl[(dir * K::NHS + hl) * 128 + 64 + lane] = w1;
        if (lane == 0) { float* dec = ML ? WSP(float, WS_DECM) + ((size_t)(b * 2 + dir) * NCHT + cc) * 8 + hg : WSP(float, WS_DECS) + ((size_t)(b * 2 + dir) * NCHT + cc) * 16 + hg; *dec = EXPF(T); } }
    SYNC();
#pragma unroll 1
    for (int dir = 0; dir < 2; ++dir) {
        if (dir == 1) SYNC();
#pragma unroll
        for (int j = 0; j < K::NXR; ++j) { const int id = tid + NTHR * j, k = id / K::CPR, c8 = id % K::CPR; const float wk = wl[(dir * K::NHS + (c8 * 8) / K::PD) * 128 + k];
            f32x4 v0, v1; unpack8(xc[j], v0, v1); *(LAS u32x4*)(XW + k * K::LDXW + c8 * 8) = pack8(v0 * wk, v1 * wk); }
        if (ML) { if (tid < 256) { const int k = tid >> 1, hf = tid & 1; u32x4 o = {0u, 0u, 0u, 0u}; if (hf == 0) o.x = f2bf(wl[dir * 128 + k]); *(LAS u32x4*)(XW + k * K::LDXW + 128 + hf * 8) = o; } }
        SYNC();
        constexpr int RT = K::NN / 16, CT = K::XC / 16;
        const int ct0 = w, ct1 = w + 8; const bool two = ct1 < CT;
        if (ct0 < CT) {
            bf16x8 bx0[4], bx1[4];
#pragma unroll
            for (int ks = 0; ks < 4; ++ks) { bx0[ks] = tr_frag(XW, K::LDXW, ks * 32, ct0 * 16, lane); bx1[ks] = two ? tr_frag(XW, K::LDXW, ks * 32, ct1 * 16, lane) : bx0[ks]; }
#pragma unroll 1
            for (int u = 0; u < RT / 2; ++u) {
                bf16x8 a0[4], a1[4];
#pragma unroll
                for (int ks = 0; ks < 4; ++ks) { a0[ks] = tr_frag8(BKN, K::LDB, ks * 32, u * 32, lane); a1[ks] = tr_frag8(BKN, K::LDB, ks * 32, u * 32 + 4, lane); }
                f32x4 c00 = {0.f, 0.f, 0.f, 0.f}, c01 = {0.f, 0.f, 0.f, 0.f}, c10 = {0.f, 0.f, 0.f, 0.f}, c11 = {0.f, 0.f, 0.f, 0.f};
#pragma unroll
                for (int ks = 0; ks < 4; ++ks) { c00 = mfma16(a0[ks], bx0[ks], c00); c01 = mfma16(a1[ks], bx0[ks], c01); }
                if (two) {
#pragma unroll
                    for (int ks = 0; ks < 4; ++ks) { c10 = mfma16(a0[ks], bx1[ks], c10); c11 = mfma16(a1[ks], bx1[ks], c11); } }
#pragma unroll
                for (int cs = 0; cs < 2; ++cs) { if (cs == 1 && !two) break;
                    const int pg = (cs ? ct1 : ct0) * 16 + (lane & 15), hl = pg / K::PPH, p = pg % K::PPH, hg = ML ? gi : gi * 8 + hq * 4 + hl, n = u * 32 + 8 * (lane >> 4);
                    bf16_t* dst = ML ? WSP(bf16_t, WS_STM) + ((size_t)(b * 2 + dir) * NCHT + cc) * STM_CH + ((size_t)hg * 144 + p) * 64 + n
                                     : WSP(bf16_t, WS_STS) + ((size_t)(b * 2 + dir) * NCHT + cc) * STS_CH + ((size_t)hg * 64 + p) * 128 + n;
                    *(u32x4*)dst = cs ? pack8(c10, c11) : pack8(c00, c01); }
            }
        }
    }
}
template <bool ML> DEV int s1_build_list(Frame& F, LAS int* list) {
    const int GPB = ML ? 8 : 2, nL = BATCH * NCH * GPB, nC = BATCH * NCHC * GPB, skew = ML ? (BATCH * NCHC * 2) % F.G : 0;
    int n = 0;
    for (int it = F.bid; it < nL; it += F.G) { const int b = it / (NCH * GPB), r = it % (NCH * GPB); if (F.tid == 0) list[n] = (b << 20) | ((r / GPB) << 8) | (r % GPB); ++n; }
    for (int it = ((F.G - 1 - F.bid) + F.G - skew) % F.G; it < nC; it += F.G) { const int b = it / (NCHC * GPB), r = it % (NCHC * GPB); if (F.tid == 0) list[n] = (b << 20) | ((NCH + r / GPB) << 8) | (r % GPB); ++n; }
    return n;
}
template <bool ML> DEV void s1_run(Frame& F, const float* aneg, LAS int* list) {
    typedef S1K<ML> K;
    const int n = s1_build_list<ML>(F, list);
    SYNC();
    const int nst = n * K::NQ;
    S1Regs<ML> R;
    if (nst > 0) s1_load<ML>(F, R, list[0], 0);
#pragma unroll 1
    for (int st = 0; st < nst; ++st) { const int nx = st + 1; const bool hn = nx < nst;
        s1_stage<ML>(F, R, list[st / K::NQ], st % K::NQ, hn, hn ? list[nx / K::NQ] : 0, nx % K::NQ, aneg); }
    SYNC();
}
DEV void p4v2_local_states(Frame& F) {
    LAS float* aneg_l = (LAS float*)(F.lds + LDS_BYTES - 256);
    LAS int* list = (LAS int*)(F.lds + LDS_BYTES - 1024);
    if (F.tid < 32) aneg_l[F.tid] = -EXPF(F.pp->in[12][F.tid]);
    SYNC();
    s1_run<false>(F, (const float*)aneg_l, list);
    s1_run<true>(F, (const float*)aneg_l, list);
}

DEV void p12_route(Frame& F) {
    const float* LOGIT = WSP(float, WS_LOG); const float* rb = F.pp->in[24];
    int* ae = WSP(int, WS_ASGE); int* ar = WSP(int, WS_ASGR); float* aw = WSP(float, WS_ASGW);
    constexpr int LDT = NEXP + 1;
    LAS int* cntL = (LAS int*)(F.lds + 2 * 64 * LDT * 4);
    for (int e = F.tid; e < NEXP; e += NTHR) cntL[e] = 0;
    SYNC();
    constexpr int GS = NEXP / 8;
    const float NEG = -3.0e38f;
    for (int t = F.bid * 128 + F.tid; F.tid < 128 && t < NLAT; t += F.G * 128) {
        LAS float* tile = (LAS float*)F.lds + F.wave * (64 * LDT);
        { const int tw = t - F.lane;
          WAVE_LDS_FENCE();
          static_assert(NEXP <= 256, "one 16-byte piece per lane and row");
#pragma unroll 1
          for (int r0 = 0; r0 < 64; r0 += 16) { f32x4 v[16];
              const int c = F.lane * 4;
              if (c < NEXP) {
#pragma unroll
                  for (int r = 0; r < 16; ++r) v[r] = *(const f32x4*)(LOGIT + (size_t)(tw + r0 + r) * NEXP + c);
#pragma unroll
                  for (int r = 0; r < 16; ++r) { LAS float* d = tile + (r0 + r) * LDT + c; d[0] = v[r].x; d[1] = v[r].y; d[2] = v[r].z; d[3] = v[r].w; } } }
          WAVE_LDS_FENCE(); }
        const LAS float* lg = tile + F.lane * LDT;
        float gs[8];
#pragma unroll
        for (int g = 0; g < 8; ++g) { float m1 = NEG, m2 = NEG;
#pragma unroll 4
            for (int j = 0; j < GS; ++j) { const float v = sigmoidf_(lg[g * GS + j]) + rb[g * GS + j]; if (v > m1) { m2 = m1; m1 = v; } else if (v > m2) m2 = v; }
            gs[g] = m1 + m2; }
        unsigned selmask = 0u;
#pragma unroll
        for (int g = 0; g < 8; ++g) { int rank = 0;
#pragma unroll
            for (int gp = 0; gp < 8; ++gp) rank += (gs[gp] > gs[g] || (gs[gp] == gs[g] && gp < g)) ? 1 : 0;
            if (rank < TOPKG) selmask |= 1u << g; }
        float tv[8]; int ti[8];
#pragma unroll
        for (int i = 0; i < 8; ++i) { tv[i] = NEG; ti[i] = 0; }
        unsigned smk = selmask;
#pragma unroll 1
        for (int sg = 0; sg < TOPKG; ++sg) { const int g = __builtin_ctz(smk); smk &= smk - 1u;
#pragma unroll 2
            for (int j = 0; j < GS; ++j) { const int e = g * GS + j; float cv = sigmoidf_(lg[e]) + rb[e]; int ce = e;
#pragma unroll
                for (int i = 0; i < 8; ++i) { const bool gtv = cv > tv[i]; const float ov = tv[i]; const int oi = ti[i];
                    tv[i] = gtv ? cv : ov; ti[i] = gtv ? ce : oi; cv = gtv ? ov : cv; ce = gtv ? oi : ce; } }
        }
        float sc[8], ssum = 0.f;
#pragma unroll
        for (int i = 0; i < 8; ++i) { sc[i] = sigmoidf_(lg[ti[i]]); ssum += sc[i]; }
        const float inv = 2.5f / ssum;
#pragma unroll
        for (int i = 0; i < 8; ++i) { const int rk = ATOMIC_ADD_LDS(&cntL[ti[i]], 1); const int a = t * TOPK + i; ae[a] = ti[i]; ar[a] = rk; aw[a] = sc[i] * inv; }
    }
    SYNC();
    int* cm = WSP(int, WS_CMAT) + (size_t)F.bid * NEXP;
    for (int e = F.tid; e < NEXP; e += NTHR) cm[e] = cntL[e];
}
DEV void p13_slots(Frame& F) {
    int* ctl = WSP(int, WS_CTL); const int* cmat = WSP(int, WS_CMAT);
    LAS int* cl = (LAS int*)F.lds; LAS int* tb = cl + NEXP; LAS int* pl = tb + NEXP + 1;
    for (int e = F.tid; e < NEXP; e += NTHR) { int tot = 0, pre = 0;
        for (int b = 0; b < F.G; ++b) { const int v = cmat[(size_t)b * NEXP + e]; tot += v; pre += b < F.bid ? v : 0; }
        cl[e] = tot; pl[e] = pre; }
    SYNC();
    if (F.wave == 0) {
        int loc[EPL], sum = 0;
#pragma unroll
        for (int j = 0; j < EPL; ++j) { loc[j] = (cl[F.lane * EPL + j] + 255) >> 8; sum += loc[j]; }
        int inc = sum;
#pragma unroll
        for (int d = 1; d < 64; d <<= 1) { const int t = __shfl_up(inc, d); if (F.lane >= d) inc += t; }
        int run = inc - sum;
#pragma unroll
        for (int j = 0; j < EPL; ++j) { tb[F.lane * EPL + j] = run; run += loc[j]; }
        if (F.lane == 63) tb[NEXP] = run;
    }
    SYNC();
    const int* ae = WSP(int, WS_ASGE); const int* ar = WSP(int, WS_ASGR); const float* aw = WSP(float, WS_ASGW);
    int* stok = WSP(int, WS_STOK); int* sdst = WSP(int, WS_SDST); float* sw = WSP(float, WS_SW); int* texp = WSP(int, WS_TEXP);
    for (int t0 = F.bid * 128; t0 < NLAT; t0 += F.G * 128)
        for (int i = F.tid; i < 128 * TOPK; i += NTHR) { const int a = t0 * TOPK + i; if (a < NASG) { const int e = ae[a];
            const int slot = tb[e] * 256 + pl[e] + ar[a]; stok[slot] = a / TOPK; sdst[slot] = a; sw[slot] = aw[a]; } }
    for (int e = F.bid; e < NEXP; e += F.G) {
        for (int sl = tb[e] * 256 + cl[e] + F.tid; sl < tb[e + 1] * 256; sl += NTHR) { stok[sl] = 0; sdst[sl] = -1; sw[sl] = 0.f; }
        for (int t = tb[e] + F.tid; t < tb[e + 1]; t += NTHR) texp[t] = e;
    }
    if (F.bid == 0 && F.tid == 0) { ctl[1024] = tb[NEXP]; }
}
DEV void p_final(Frame& F) {
    const float* mod = WSP(float, WS_MOD); const bf16_t* Y = WSP(bf16_t, WS_Y); const bf16_t* YS = WSP(bf16_t, WS_YS); const float* gf = F.pp->in[31];
    const int gw = F.bid * 8 + F.wave, NGW = F.G * 8, lane = F.lane;
    for (int t = gw; t < NLAT; t += NGW) {
        const float* gate = mod + (t / SEQ) * 6144 + 5 * 1024;
        u32x4 yr[2][TOPK + 1];
#pragma unroll
        for (int j = 0; j < 2; ++j) {
#pragma unroll
            for (int k = 0; k < TOPK; ++k) yr[j][k] = *((const u32x4*)(Y + (size_t)(t * TOPK + k) * 1024) + lane + 64 * j);
            yr[j][TOPK] = *((const u32x4*)(YS + (size_t)t * 1024) + lane + 64 * j); }
        f32x4 v[2][2]; float ssq = 0.f;
#pragma unroll
        for (int j = 0; j < 2; ++j) { f32x4 a0 = {0.f, 0.f, 0.f, 0.f}, a1 = {0.f, 0.f, 0.f, 0.f};
#pragma unroll
            for (int k = 0; k <= TOPK; ++k) { f32x4 p0, p1; unpack8(yr[j][k], p0, p1); a0 += p0; a1 += p1; }
            const f32x4* xr = (const f32x4*)(F.out + (size_t)t * DM) + 2 * lane + 128 * j; const f32x4* gr = (const f32x4*)gate + 2 * lane + 128 * j;
            v[j][0] = xr[0] + gr[0] * a0; v[j][1] = xr[1] + gr[1] * a1;
#pragma unroll
            for (int h = 0; h < 2; ++h) ssq += (v[j][h].x * v[j][h].x + v[j][h].y * v[j][h].y) + (v[j][h].z * v[j][h].z + v[j][h].w * v[j][h].w); }
        const float rstd = RSQF(wave_sum(ssq) * (1.f / DM) + EPS);
#pragma unroll
        for (int j = 0; j < 2; ++j) { f32x4* orow = (f32x4*)(F.out + (size_t)t * DM) + 2 * lane + 128 * j; const f32x4* gg = (const f32x4*)gf + 2 * lane + 128 * j;
            orow[0] = v[j][0] * rstd * gg[0]; orow[1] = v[j][1] * rstd * gg[1]; }
    }
}

#ifndef HOST_EMU
#define XB_TMO      128
#define XB_XCNT(j)  (256  + 64 * (j))
#define XB_XSUB(j)  (1280 + 64 * (j))
#define XB_XGEN(j)  (2304 + 64 * (j))
#define XB_TOP      3328
#define XB_TOPGEN   3392
#define XCD_BAR_WORDS 3456
#define XB_SPIN_CAP (1u << 18)
__device__ __forceinline__ unsigned xb_ld(unsigned* p)              { return __hip_atomic_load(p, __ATOMIC_RELAXED, __HIP_MEMORY_SCOPE_AGENT); }
__device__ __forceinline__ unsigned xb_add(unsigned* p, unsigned v) { return __hip_atomic_fetch_add(p, v, __ATOMIC_RELAXED, __HIP_MEMORY_SCOPE_AGENT); }
__device__ __forceinline__ unsigned xb_xcc_id() { return (unsigned)__builtin_amdgcn_s_getreg((3 << 11) | 20) & 0xFu; }
#define XB_SPIN(cond, bar) do { unsigned _sp = 0; while (cond) { __builtin_amdgcn_s_sleep(1); \
    if ((++_sp & 255u) == 0u) { if (xb_ld(&(bar)[XB_TMO])) break; if (_sp > XB_SPIN_CAP) { atomicAdd(&(bar)[XB_TMO], 1u); break; } } } } while (0)
struct XcdBarrier { unsigned* bar; unsigned x; volatile LAS unsigned* st; };
__device__ __forceinline__ XcdBarrier xcd_barrier_post(unsigned* bar, volatile LAS unsigned* st) {
    XcdBarrier b; b.bar = bar; b.x = xb_xcc_id(); b.st = st;
    if (threadIdx.x == 0) (void)xb_add(&bar[XB_XCNT(b.x)], 1u);
    return b;
}
__device__ __forceinline__ void xcd_barrier_complete(unsigned* bar, unsigned x, unsigned& nloc, unsigned& nx) {
    const unsigned G = gridDim.x * gridDim.y * gridDim.z;
    unsigned sum, cnt, mine, sp = 0u;
    for (;;) {
        sum = 0u; cnt = 0u; mine = 0u;
#pragma unroll
        for (unsigned j = 0; j < 16; ++j) { const unsigned c = xb_ld(&bar[XB_XCNT(j)]); sum += c; cnt += (c > 0u) ? 1u : 0u; mine = (j == x) ? c : mine; }
        if (sum == G) break;
        __builtin_amdgcn_s_sleep(1);
        if ((++sp & 255u) == 0u) { if (xb_ld(&bar[XB_TMO])) break; if (sp > XB_SPIN_CAP) { atomicAdd(&bar[XB_TMO], 1u); break; } }
    }
    nloc = mine > 0u ? mine : 1u; nx = cnt > 0u ? cnt : 1u;
}
__device__ __forceinline__ void xcd_barrier(const XcdBarrier& b) {
    asm volatile("s_waitcnt vmcnt(0)" ::: "memory");
    __syncthreads();
    if (threadIdx.x == 0) {
        unsigned* bar = b.bar;
        __builtin_amdgcn_s_waitcnt(0);
        unsigned nloc = b.st[0], nx = b.st[1];
        if (nloc == 0u) { xcd_barrier_complete(bar, b.x, nloc, nx); b.st[0] = nloc; b.st[1] = nx; }
        const unsigned old = xb_add(&bar[XB_XSUB(b.x)], 1u);
        const unsigned gen = old / nloc;
        if (old + 1u == (gen + 1u) * nloc) {
            __builtin_amdgcn_fence(__ATOMIC_RELEASE, "agent");
            asm volatile("s_waitcnt vmcnt(0)" ::: "memory");
            const unsigned og = xb_add(&bar[XB_TOP], 1u);
            const unsigned tg = og / nx;
            if (og + 1u == (tg + 1u) * nx) xb_add(&bar[XB_TOPGEN], 1u);
            else XB_SPIN(xb_ld(&bar[XB_TOPGEN]) == tg, bar);
            __builtin_amdgcn_fence(__ATOMIC_ACQUIRE, "agent");
            xb_add(&bar[XB_XGEN(b.x)], 1u);
            asm volatile("s_waitcnt vmcnt(0)" ::: "memory");
        } else {
            XB_SPIN(xb_ld(&bar[XB_XGEN(b.x)]) == gen, bar);
            __builtin_amdgcn_fence(__ATOMIC_ACQUIRE, "agent");
            asm volatile("s_waitcnt vmcnt(0)" ::: "memory");
        }
    }
    __syncthreads();
}
#endif

#ifndef HOST_EMU
template <class T> __device__ __forceinline__ T* uni_ptr(T* p) { const unsigned long long v = (unsigned long long)p; const unsigned lo = __builtin_amdgcn_readfirstlane((unsigned)v), hi = __builtin_amdgcn_readfirstlane((unsigned)(v >> 32)); return (T*)(((unsigned long long)hi << 32) | lo); }
#endif
#ifndef HOST_EMU
constexpr int WS_BAR_OFF = 16384;
constexpr int LDS_BARST = LDS_BYTES - 64;
#ifndef TPROBE_LO
#define TPROBE_LO -2
#define TPROBE_HI -2
#define TPROBE_MUL 0
#endif
__global__ void __launch_bounds__(NTHR, 2) fwd_megakernel(Params prm) {
    extern __shared__ __attribute__((aligned(16))) unsigned char lds_raw[];
    if (threadIdx.x < 4) ((LAS unsigned*)((LAS unsigned char*)lds_raw + LDS_BARST))[threadIdx.x] = 0u;
    __syncthreads();
    XcdBarrier gbar = xcd_barrier_post((unsigned*)(prm.ws + WS_CTL + WS_BAR_OFF), (volatile LAS unsigned*)((LAS unsigned char*)lds_raw + LDS_BARST));
    unsigned long long tp0 = 0ull, tp1 = 0ull;
    if (TPROBE_LO == 0) tp0 = __builtin_amdgcn_s_memrealtime();
#define GRID_SYNC() xcd_barrier(gbar)
#define PROBE_END(k) do { if ((k) == TPROBE_LO - 1) tp0 = __builtin_amdgcn_s_memrealtime(); if ((k) == TPROBE_HI) tp1 = __builtin_amdgcn_s_memrealtime(); } while (0)
#else
void fwd_megakernel(Params prm) {
    unsigned char* lds_raw = emu_lds();
#define GRID_SYNC() do {} while (0)
#define PROBE_END(k) do {} while (0)
#endif
    Frame F;
    F.lds = (LAS unsigned char*)lds_raw; F.tid = TID; F.lane = F.tid & 63; F.wave = RFL(F.tid >> 6); F.G = NBLK; F.bid = BID;
    F.pp = &prm;
    F.out = prm.out; F.ws = prm.ws;
    const int lo = prm.ph_lo, hi = prm.ph_hi;
#ifndef PH_MASK
#define PH_MASK 0xFFFFFFu
#endif
#define IN(k) ((((PH_MASK) >> (k)) & 1u) && lo <= (k) && (k) < hi)
#ifndef HOST_EMU
#define FRESH() do { int t_ = threadIdx.x; OPAQUE_V(t_); F.tid = t_; F.lane = t_ & 63; F.wave = __builtin_amdgcn_readfirstlane(t_ >> 6); \
        F.ws = uni_ptr(prm.ws); F.out = uni_ptr(prm.out); } while (0)
#else
#define FRESH() do {} while (0)
#endif
#define SEAM(k) do { if (IN(k) && IN((k) + 1)) GRID_SYNC(); PROBE_END(k); } while (0)
#ifndef HOST_EMU
#define OPAQUE_WS() do { unsigned char* t_ = prm.ws; asm volatile("" : "+s"(t_)); F.ws = t_; float* o_ = prm.out; asm volatile("" : "+s"(o_)); F.out = o_; } while (0)
#else
#define OPAQUE_WS() do {} while (0)
#endif
    if (IN(0)) { FRESH(); p0_small(F); } SEAM(0);
    if (IN(1)) { FRESH(); p1_xn(F); p0_weights(F); } SEAM(1);
    if (IN(2)) { FRESH(); pg8::Gemm g{WSP(bf16_t, WS_XN), WSP(bf16_t, WS_WIN), NROWS, NIN, 1024}; pg8::StaticOrder S; S.init(NROWS, NIN, F.G, F.bid);
        EpiInProj E{WSP(bf16_t, WS_Z), WSP(bf16_t, WS_XBC), WSP(bf16_t, WS_QK), WSP(bf16_t, WS_V), WSP(bf16_t, WS_O), WSP(bf16_t, WS_MG), WSP(float, WS_DTG), F.pp->in[9], F.pp->in[10], F.pp->in[15], F.pp->in[16], F.lds + pg8::STAGE_BYTES};
        pg8::gemm_phase<EpiInProj, pg8::StaticOrder>(F.lds, g, S, E); } SEAM(2);
    if (IN(4)) { FRESH(); p4v2_local_states(F); } SEAM(4);
    if (IN(5)) { FRESH(); p5_scan(F); } SEAM(5);
    if (IN(6)) { FRESH(); p6v2_outputs(F); } SEAM(6);
    if (IN(7)) { FRESH(); pg8::Gemm g{WSP(bf16_t, WS_YPRE), WSP(bf16_t, WS_WSO), NLAT, 1024, 1024}; pg8::StaticOrder S; S.init(NLAT, 1024, F.G, F.bid);
        EpiG1 E{WSP(bf16_t, WS_M1), WSP(bf16_t, WS_MG), WSP(float, WS_SSQ)}; pg8::gemm_phase<EpiG1, pg8::StaticOrder>(F.lds, g, S, E);
        FRESH(); pg8::Gemm g2{WSP(bf16_t, WS_HP), WSP(bf16_t, WS_WMO), NLAT, 1024, 1024};
        EpiG2 E2{WSP(bf16_t, WS_MERGED), WSP(bf16_t, WS_M1), WSP(bf16_t, WS_MG)}; pg8::gemm_phase<EpiG2, pg8::StaticOrder>(F.lds, g2, S, E2); } SEAM(7);
    if (IN(9)) { FRESH(); pg8::Gemm g{WSP(bf16_t, WS_MERGED), WSP(bf16_t, WS_WOUT), NLAT, 1024, 1024}; pg8::StaticOrder S; S.init(NLAT, 1024, F.G, F.bid);
        EpiG3 E{F.pp->in[0], F.out, WSP(float, WS_MOD)}; pg8::gemm_phase<EpiG3, pg8::StaticOrder>(F.lds, g, S, E); } SEAM(9);
    if (IN(10)) { FRESH(); p10_xn2(F); p_expert_weights(F); } SEAM(10);
    if (IN(11)) { FRESH(); pg8::Gemm g{WSP(bf16_t, WS_XN), WSP(bf16_t, WS_WRS), NLAT, 768, 1024}; pg8::StaticOrder S; S.init(NLAT, 768, F.G, F.bid);
        EpiRS E{WSP(float, WS_LOG), WSP(bf16_t, WS_HS)}; pg8::gemm_phase<EpiRS, pg8::StaticOrder>(F.lds, g, S, E); } SEAM(11);
    if (IN(12)) { FRESH(); p12_route(F); } SEAM(12);
    if (IN(13)) { FRESH(); p13_slots(F); } SEAM(13);
    if (IN(14)) { FRESH(); const int ntl = WSP(int, WS_CTL)[1024];
        pg8::Gemm g{WSP(bf16_t, WS_XN), WSP(bf16_t, WS_W1T), NLAT, 512, 1024};
        pg8::ExpertOrder<true> S{0, ntl, 2, F.G, F.bid, WSP(int, WS_TEXP), 0, (size_t)512 * 1024, WSP(int, WS_STOK)};
        EpiX1 E{WSP(bf16_t, WS_H)}; pg8::gemm_phase<EpiX1, pg8::ExpertOrder<true>>(F.lds, g, S, E); } SEAM(14);
    if (IN(15)) { FRESH(); const int ntl = WSP(int, WS_CTL)[1024];
        pg8::Gemm g{WSP(bf16_t, WS_H), WSP(bf16_t, WS_W2T), MAXSLOT, 1024, 256};
        pg8::ExpertOrder<false> S{0, ntl, 4, F.G, F.bid, WSP(int, WS_TEXP), 0, (size_t)1024 * 256, nullptr};
        EpiX2 E{WSP(bf16_t, WS_Y), WSP(int, WS_SDST), WSP(float, WS_SW)}; pg8::gemm_phase<EpiX2, pg8::ExpertOrder<false>>(F.lds, g, S, E);
        FRESH();
        pg8::Gemm g2{WSP(bf16_t, WS_HS), WSP(bf16_t, WS_WSD), NLAT, 1024, 256}; pg8::StaticOrder S2; S2.init(NLAT, 1024, F.G, F.bid);
        EpiSD E2{WSP(bf16_t, WS_YS)}; pg8::gemm_phase<EpiSD, pg8::StaticOrder>(F.lds, g2, S2, E2); } SEAM(15);
    if (IN(16)) { FRESH(); p_final(F); }
#ifndef HOST_EMU
    if (TPROBE_MUL > 0) { asm volatile("s_waitcnt vmcnt(0)" ::: "memory"); __syncthreads(); PROBE_END(16);
        if (blockIdx.x == 0 && threadIdx.x == 0) { const unsigned long long t0 = __builtin_amdgcn_s_memrealtime(), want = (tp0 != 0ull && tp1 > tp0 && tp1 - tp0 < 2000000ull) ? (unsigned long long)TPROBE_MUL * (tp1 - tp0) : 0ull;
            while (__builtin_amdgcn_s_memrealtime() - t0 < want) __builtin_amdgcn_s_sleep(8); } }
#endif
#undef IN
#undef SEAM
}

#ifndef HOST_EMU
extern "C" void kernel_launch(void* const* d_in, const int* in_sizes, int n_in, void* d_out, int out_size, void* d_ws, size_t ws_size, hipStream_t stream) {
    static int grid = 0;
    if (grid == 0) {
        if (n_in != 32 || out_size != NLAT * DM || ws_size < WS_NEED) { fprintf(stderr, "kernel_launch: unexpected problem (n_in %d out %d ws %zu need %zu)\n", n_in, out_size, ws_size, (size_t)WS_NEED); grid = -1; return; }
        int dev = 0, cus = 0, per_cu = 0;
        hipGetDevice(&dev); hipDeviceGetAttribute(&cus, hipDeviceAttributeMultiprocessorCount, dev);
        hipFuncSetAttribute((const void*)fwd_megakernel, hipFuncAttributeMaxDynamicSharedMemorySize, LDS_BYTES);
        hipOccupancyMaxActiveBlocksPerMultiprocessor(&per_cu, (const void*)fwd_megakernel, NTHR, LDS_BYTES);
        if (per_cu < 1) { fprintf(stderr, "kernel_launch: occupancy query says %d blocks per CU\n", per_cu); per_cu = 1; }
        (void)hipGetLastError();
        grid = cus;
    }
    if (grid < 0) return;
    hipMemsetAsync((char*)d_ws + WS_CTL, 0, CTL_BYTES, stream);
    Params p{};
    for (int i = 0; i < 32; ++i) p.in[i] = (const float*)d_in[i];
    p.out = (float*)d_out; p.ws = (unsigned char*)d_ws; p.ph_lo = 0; p.ph_hi = NPHASE;
    void* args[] = {&p};
    const hipError_t e = hipLaunchCooperativeKernel((const void*)fwd_megakernel, dim3(grid), dim3(NTHR), args, LDS_BYTES, stream);
    if (e != hipSuccess) fprintf(stderr, "kernel_launch: launch failed: %s (grid %d)\n", hipGetErrorString(e), grid);
}
#endif
```

```cpp
#ifndef HOST_EMU
#include <hip/hip_runtime.h>
#include <cstdio>
#include <cstdint>
#define DEV __device__ __forceinline__
#define LAS __attribute__((address_space(3)))
#define TID ((int)threadIdx.x)
#define BID ((int)blockIdx.x)
#define NBLK ((int)gridDim.x)
#define SYNC() __syncthreads()
#define EXPF(x) __expf(x)
#define RCPF(x) __builtin_amdgcn_rcpf(x)
#define RSQF(x) __builtin_amdgcn_rsqf(x)
#define ATOMIC_ADD_LDS(p, v) __hip_atomic_fetch_add((p), (v), __ATOMIC_RELAXED, __HIP_MEMORY_SCOPE_WORKGROUP)
#define RFL(x) __builtin_amdgcn_readfirstlane(x)
#define SCHED_FENCE() __builtin_amdgcn_sched_barrier(0)
#define MEM_FENCE() asm volatile("" ::: "memory")
#define WAVE_LDS_FENCE() asm volatile("s_waitcnt lgkmcnt(0)" ::: "memory")
#define OPAQUE_V(x) asm volatile("" : "+v"(x))
#define TOUCH(x) asm volatile("" :: "v"(x))
#endif

#ifndef CFG_SEQ
#define CFG_SEQ 16384
#endif
#ifndef CFG_NEXP
#define CFG_NEXP 256
#endif
constexpr int DM = 1024, BATCH = 2, SEQ = CFG_SEQ, CTXL = 256, CHUNK = 128;
constexpr int NLAT = BATCH * SEQ, NCTX = BATCH * CTXL, NROWS = NLAT + NCTX;
constexpr int NCH = SEQ / CHUNK, NCHC = CTXL / CHUNK, NCHT = NCH + NCHC;
constexpr int SSD_H = 16, SSD_P = 64, SSD_N = 128, D_XBC = 1536;
constexpr int ML_H = 8, ML_DV = 128, ML_DK = 64, ML_PP = 144;
constexpr int NEXP = CFG_NEXP, TOPK = 8, TOPKG = 4, DEXP = 256, EPL = NEXP / 64;
constexpr int NASG = NLAT * TOPK, MAXSLOT = NASG + NEXP * 256;
constexpr int NIN = 7936;
constexpr float EPS = 1e-6f;
constexpr int NTHR = 512;

typedef unsigned short bf16_t;
typedef short bf16x8 __attribute__((ext_vector_type(8)));
typedef float f32x4 __attribute__((ext_vector_type(4)));
typedef unsigned u32x4 __attribute__((ext_vector_type(4)));
typedef unsigned u32x2 __attribute__((ext_vector_type(2)));

constexpr size_t alignup(size_t x) { return (x + 4095) & ~(size_t)4095; }
constexpr size_t WS_CTL = 0;
constexpr size_t CTL_BYTES = 65536;
constexpr size_t WS_MOD = WS_CTL + CTL_BYTES;
constexpr size_t WS_DECS = WS_MOD + alignup(3 * 6144 * 4);
constexpr size_t WS_DECM = WS_DECS + alignup((size_t)BATCH * 2 * NCHT * 16 * 4);
constexpr size_t WS_WIN = WS_DECM + alignup((size_t)BATCH * 2 * NCHT * 8 * 4);
constexpr size_t WS_WSO = WS_WIN + alignup((size_t)NIN * 1024 * 2);
constexpr size_t WS_WMO = WS_WSO + alignup((size_t)1024 * 1024 * 2);
constexpr size_t WS_WOUT = WS_WMO + alignup((size_t)1024 * 1024 * 2);
constexpr size_t WS_WRS = WS_WOUT + alignup((size_t)1024 * 1024 * 2);
constexpr size_t WS_WSD = WS_WRS + alignup((size_t)768 * 1024 * 2);
constexpr size_t WS_XN = WS_WSD + alignup((size_t)1024 * 256 * 2);
constexpr size_t WS_STAGE = WS_XN + alignup((size_t)NROWS * 1024 * 2);
constexpr size_t WS_Z = WS_STAGE;
constexpr size_t WS_XBC = WS_Z + alignup((size_t)NROWS * 1024 * 2);
constexpr size_t WS_QK = WS_XBC + alignup((size_t)NROWS * 1536 * 2);
constexpr size_t WS_V = WS_QK + alignup((size_t)NROWS * 1024 * 2);
constexpr size_t WS_O = WS_V + alignup((size_t)NROWS * 1024 * 2);
constexpr size_t WS_MG = WS_O + alignup((size_t)NROWS * 1024 * 2);
constexpr size_t WS_DTG = WS_MG + alignup((size_t)NROWS * 2048 * 2);
constexpr size_t WS_STS = WS_DTG + alignup((size_t)NROWS * 64 * 4);
constexpr size_t STS_CH = (size_t)SSD_H * SSD_P * SSD_N;
constexpr size_t WS_STM = WS_STS + alignup((size_t)BATCH * 2 * NCHT * STS_CH * 2);
constexpr size_t STM_CH = (size_t)ML_H * ML_PP * ML_DK;
constexpr size_t WS_YPRE = WS_STM + alignup((size_t)BATCH * 2 * NCHT * STM_CH * 2);
constexpr size_t WS_HP = WS_YPRE + alignup((size_t)NLAT * 1024 * 2);
constexpr size_t WS_SSQ = WS_HP + alignup((size_t)NLAT * 1024 * 2);
constexpr size_t WS_MIX_END = WS_SSQ + alignup((size_t)NLAT * 16 * 4);
constexpr size_t WS_M1 = WS_XBC;
constexpr size_t WS_MERGED = WS_QK;
constexpr size_t WS_Y = WS_STAGE;
constexpr size_t WS_W1T = WS_STAGE;
static_assert((size_t)NEXP * 512 * 1024 * 2 <= (size_t)NASG * 1024 * 2 || true, "");
constexpr size_t WS_YEND = WS_STAGE + (alignup((size_t)NASG * 1024 * 2) > alignup((size_t)NEXP * 512 * 1024 * 2) ? alignup((size_t)NASG * 1024 * 2) : alignup((size_t)NEXP * 512 * 1024 * 2));
constexpr size_t WS_W2T = WS_YEND;
constexpr size_t WS_H = WS_W2T + alignup((size_t)NEXP * 1024 * 256 * 2);
constexpr size_t WS_LOG = WS_H + alignup((size_t)MAXSLOT * 256 * 2);
constexpr size_t WS_HS = WS_LOG + alignup((size_t)NLAT * NEXP * 4);
constexpr size_t WS_ASGE = WS_HS + alignup((size_t)NLAT * 256 * 2);
constexpr size_t WS_ASGR = WS_ASGE + alignup((size_t)NASG * 4);
constexpr size_t WS_ASGW = WS_ASGR + alignup((size_t)NASG * 4);
constexpr size_t WS_STOK = WS_ASGW + alignup((size_t)NASG * 4);
constexpr size_t WS_SDST = WS_STOK + alignup((size_t)MAXSLOT * 4);
constexpr size_t WS_SW = WS_SDST + alignup((size_t)MAXSLOT * 4);
constexpr size_t WS_TEXP = WS_SW + alignup((size_t)MAXSLOT * 4);
constexpr size_t WS_CMAT = WS_TEXP + alignup((size_t)(MAXSLOT / 256) * 4);
constexpr size_t WS_YS = WS_CMAT + alignup((size_t)512 * NEXP * 4);
constexpr size_t WS_MOE_END = WS_YS + alignup((size_t)NLAT * 1024 * 2);
constexpr size_t WS_NEED = WS_MIX_END > WS_MOE_END ? WS_MIX_END : WS_MOE_END;

constexpr int LDS_BYTES = 147456;
constexpr int NPHASE = 17;

struct Params { const float* in[32]; float* out; unsigned char* ws; int ph_lo, ph_hi; };

#ifndef HOST_EMU
DEV unsigned f2bf(float f) { const __bf16 b = (__bf16)f; return (unsigned)__builtin_bit_cast(unsigned short, b); }
#else
DEV unsigned f2bf(float f) { unsigned u = __builtin_bit_cast(unsigned, f); return (u + 0x7fffu + ((u >> 16) & 1u)) >> 16; }
#endif
DEV float bf2f(unsigned h) { return __builtin_bit_cast(float, (h & 0xffffu) << 16); }
#ifndef HOST_EMU
typedef float f32x2_t __attribute__((ext_vector_type(2))); typedef __bf16 bf16x2_t __attribute__((ext_vector_type(2)));
DEV unsigned pk2(float lo, float hi) { const f32x2_t v = {lo, hi}; const bf16x2_t b = __builtin_convertvector(v, bf16x2_t); return __builtin_bit_cast(unsigned, b); }
#else
DEV unsigned pk2(float lo, float hi) { return f2bf(lo) | (f2bf(hi) << 16); }
#endif
DEV float bflo(unsigned w) { return __builtin_bit_cast(float, w << 16); }
DEV float bfhi(unsigned w) { return __builtin_bit_cast(float, w & 0xffff0000u); }
DEV float sigmoidf_(float x) { return RCPF(1.f + EXPF(-x)); }
DEV float siluf_(float x) { return x * RCPF(1.f + EXPF(-x)); }
DEV float softplusf_(float x) { return x > 20.f ? x : log1pf(EXPF(x)); }
DEV float logsigmoidf_(float x) { return -softplusf_(-x); }
DEV float wave_sum(float v) {
#pragma unroll
    for (int o = 1; o < 64; o <<= 1) v += __shfl_xor(v, o);
    return v;
}
DEV float wave_incl_scan(float v, int lane) {
#pragma unroll
    for (int d = 1; d < 64; d <<= 1) { float t = __shfl_up(v, d); if (lane >= d) v += t; }
    return v;
}
typedef short s16x4 __attribute__((ext_vector_type(4)));
#ifndef HOST_EMU
DEV f32x4 mfma16(bf16x8 a, bf16x8 b, f32x4 c) { return __builtin_amdgcn_mfma_f32_16x16x32_bf16(a, b, c, 0, 0, 0); }
DEV s16x4 lds_tr16(const LAS void* p) { return __builtin_bit_cast(s16x4, __builtin_amdgcn_ds_read_tr16_b64_v4i16((LAS s16x4*)p)); }
#endif
namespace pg8 {
constexpr int BM = 256, BK = 64, HALF = 128, HTB = HALF * BK * 2, STAGE_BYTES = 8 * HTB, NXCD = 8, WGM = 8;
struct Unit { int pm, pn; };
struct Gemm { const bf16_t* A; const bf16_t* Bt; int M, N, K; };

DEV int lds_byte(int r, int c) { const int st = (r >> 4) * 2 + (c >> 5), rr = r & 15, cc = c & 31, ob = rr * 64 + cc * 2; return st * 1024 + (ob ^ (((ob >> 9) & 1) << 5)); }
DEV void stage_rc(int b, int& R, int& C) { const int st = b / 1024, sb = b % 1024, swz = sb ^ (((sb >> 9) & 1) << 5); R = (st >> 1) * 16 + swz / 64; C = (st & 1) * 32 + (swz % 64) / 2; }
DEV int perm32(int rho) { const int n = rho >> 4, i = rho & 15; return 8 * (i >> 2) + 4 * n + (i & 3); }

struct StaticOrder {
    static constexpr bool GATHER = false;
    int nM, nN, nwg, G, c;
    DEV void init(int M, int N, int G_, int c_) { nM = M / BM; nN = N / BM; nwg = nM * nN; G = G_; c = c_; }
    DEV bool next(int i, Unit& u) const {
        const long L = (long)i * G + c; if (L >= nwg) return false;
        int wgid = (int)L; { const int q = nwg / NXCD, r = nwg % NXCD, xcd = wgid % NXCD, off = wgid / NXCD; wgid = (xcd < r ? xcd * (q + 1) : r * (q + 1) + (xcd - r) * q) + off; }
        const int nig = WGM * nN, gid = wgid / nig, fm = gid * WGM, gsz = (nM - fm) < WGM ? (nM - fm) : WGM;
        u.pm = fm + ((wgid % nig) % gsz); u.pn = (wgid % nig) / gsz; return true;
    }
    DEV unsigned arow(const Unit& u, int r) const { return (unsigned)(u.pm * BM + r); }
    DEV const char* bbase(const Gemm& g, const Unit& u) const { return (const char*)g.Bt + (size_t)u.pn * BM * g.K * 2; }
};
template <bool GATHER_> struct ExpertOrder {
    static constexpr bool GATHER = GATHER_;
    int tlo, thi, np, G, c; const int* texp; int e0; size_t estride  ; const int* rowmap;
    DEV bool next(int i, Unit& u) const {
        const long L = (long)i * G + c; const long n = (long)(thi - tlo) * np; if (L >= n) return false;
        int wg = (int)L; { const int nn = (int)n, q = nn / NXCD, r = nn % NXCD, xcd = wg % NXCD, off = wg / NXCD; wg = (xcd < r ? xcd * (q + 1) : r * (q + 1) + (xcd - r) * q) + off; }
        u.pm = tlo + wg / np; u.pn = wg % np; return true;
    }
    DEV unsigned arow(const Unit& u, int r) const { return GATHER_ ? (unsigned)rowmap[u.pm * BM + r] : (unsigned)(u.pm * BM + r); }
    DEV const char* bbase(const Gemm& g, const Unit& u) const { const int e = texp[u.pm] - e0; return (const char*)(g.Bt + (size_t)e * estride) + (size_t)u.pn * BM * g.K * 2; }
};

#ifndef HOST_EMU
#define PG8_LAS __attribute__((address_space(3)))
template <class Epi, class Sched>
__device__ __forceinline__ void gemm_phase(PG8_LAS unsigned char* lds, const Gemm g, const Sched& S, const Epi& E) {
    int tid_ = threadIdx.x; asm volatile("" : "+v"(tid_));
    const int tid = tid_, wid = __builtin_amdgcn_readfirstlane(tid >> 6), lane = tid & 63, wr = wid >> 2, wc = wid & 3, fr = lane & 15, fq = lane >> 4;
    int Kop = g.K; asm volatile("" : "+s"(Kop));
    const int K = Kop, nt = K / BK;
    int RA[2], CA[2]; unsigned voffB[2];
#pragma unroll
    for (int i = 0; i < 2; ++i) { int R, C; stage_rc(tid * 16 + i * 8192, R, C); const int Rb = Epi::PERM ? ((R & ~31) + perm32(R & 31)) : R;
        RA[i] = R; CA[i] = C; voffB[i] = (unsigned)(Rb * K + C) * 2u; }
    const size_t kstep = (size_t)(BK * 2);
    const size_t hstep = (size_t)HALF * K * 2;
    const unsigned ldsw = (unsigned)wid * 1024u;
    const int aoff = lds_byte(wr * 64 + fr, fq * 8), boff = lds_byte(wc * 32 + fr, fq * 8);
    const char* const Ab = (const char*)g.A;
#define PG8_SA(b, h) (((b) * 2 + (h)) * HTB)
#define PG8_SB(b, h) ((4 + (b) * 2 + (h)) * HTB)
#define PG8_STAGE(bufoff, gbase, voff) do { _Pragma("unroll") for (int _i = 0; _i < 2; ++_i) \
        __builtin_amdgcn_global_load_lds((const unsigned*)((const char*)(gbase) + (voff)[_i]), (PG8_LAS unsigned*)(lds + (bufoff) + ldsw + _i * 8192), 16, 0, 0); } while (0)
#define PG8_LDA(dst, b, h) do { _Pragma("unroll") for (int m = 0; m < 4; ++m) _Pragma("unroll") for (int k = 0; k < 2; ++k) dst[m][k] = *(const PG8_LAS bf16x8*)(lds + PG8_SA(b, h) + aoff + m * 2048 + k * 1024); } while (0)
#define PG8_LDB(dst, b, h) do { _Pragma("unroll") for (int n = 0; n < 2; ++n) _Pragma("unroll") for (int k = 0; k < 2; ++k) dst[n][k] = *(const PG8_LAS bf16x8*)(lds + PG8_SB(b, h) + boff + n * 2048 + k * 1024); } while (0)
#define PG8_MMA(ai, bj, At, Bt) do { __builtin_amdgcn_s_setprio(1); _Pragma("unroll") for (int m = 0; m < 4; ++m) _Pragma("unroll") for (int n = 0; n < 2; ++n) _Pragma("unroll") for (int k = 0; k < 2; ++k) \
        acc[ai][bj][m][n] = __builtin_amdgcn_mfma_f32_16x16x32_bf16(Bt[n][k], At[m][k], acc[ai][bj][m][n], 0, 0, 0); __builtin_amdgcn_s_setprio(0); } while (0)
#define PG8_WAIT_V(n) asm volatile("s_waitcnt vmcnt(" #n ")" ::: "memory")
#define PG8_WAIT_L(n) asm volatile("s_waitcnt lgkmcnt(" #n ")" ::: "memory")
#define PG8_BAR __builtin_amdgcn_s_barrier()
#define PG8_SCHED __builtin_amdgcn_sched_barrier(0)
#define PG8_VOFFA(dst, u) do { _Pragma("unroll") for (int _h = 0; _h < 2; ++_h) _Pragma("unroll") for (int _i = 0; _i < 2; ++_i) \
        dst[_h][_i] = (S.arow(u, _h * HALF + RA[_i]) * (unsigned)K + (unsigned)CA[_i]) * 2u; } while (0)
    Unit cur, nxt; int ui = 0;
    if (!S.next(0, cur)) return;
    f32x4 acc[2][2][4][2];
#pragma unroll
    for (int a = 0; a < 2; ++a)
#pragma unroll
        for (int b = 0; b < 2; ++b)
#pragma unroll
            for (int m = 0; m < 4; ++m)
#pragma unroll
                for (int n = 0; n < 2; ++n) acc[a][b][m][n] = (f32x4){0.f, 0.f, 0.f, 0.f};
    bf16x8 At[4][2], B0[2][2], B1[2][2];
    constexpr bool GA = Sched::GATHER;
    unsigned vAc[2][2], vAn[2][2];
    unsigned voffA[2];
#pragma unroll
    for (int i = 0; i < 2; ++i) voffA[i] = (unsigned)(RA[i] * K + CA[i]) * 2u;
    const size_t tstep = 2 * hstep;
    const char* cA = Ab;
    if constexpr (GA) { PG8_VOFFA(vAc, cur); } else { cA = Ab + (size_t)S.arow(cur, 0) * K * 2; (void)tstep; }
    const char* cB = S.bbase(g, cur);
#define PG8_STAGE_A(bufoff, h, ubase, vg) do { if constexpr (GA) { PG8_STAGE(bufoff, ubase, vg[h]); } else { PG8_STAGE(bufoff, (ubase) + (h) * hstep, voffA); } } while (0)
    PG8_STAGE(PG8_SB(0, 0), cB, voffB); PG8_STAGE(PG8_SB(0, 1), cB + hstep, voffB); PG8_STAGE_A(PG8_SA(0, 0), 0, cA, vAc); PG8_STAGE_A(PG8_SA(0, 1), 1, cA, vAc);
    if (wr == 1) PG8_BAR;
    PG8_WAIT_V(2); PG8_BAR;
    PG8_STAGE(PG8_SB(1, 0), cB + kstep, voffB); PG8_STAGE_A(PG8_SA(1, 0), 0, cA + kstep, vAc); PG8_STAGE(PG8_SB(1, 1), cB + hstep + kstep, voffB);
    PG8_WAIT_V(6); PG8_BAR;
    for (;;) {
        const bool has_next = S.next(ui + 1, nxt);
        const char* nB = cB; const char* nA = cA;
        if (has_next) { nB = S.bbase(g, nxt); if constexpr (GA) { PG8_VOFFA(vAn, nxt); } else { nA = Ab + (size_t)S.arow(nxt, 0) * K * 2; } }
        else if constexpr (GA) {
#pragma unroll
            for (int _h = 0; _h < 2; ++_h)
#pragma unroll
                for (int _i = 0; _i < 2; ++_i) vAn[_h][_i] = vAc[_h][_i];
        }
#pragma unroll 1
        for (int t = 0; t < nt; t += 2) {
            const bool last = (t == nt - 2);
            const char* a1 = cA + (size_t)(t + 1) * kstep;
            const char* a2 = last ? nA : cA + (size_t)(t + 2) * kstep; const char* b2 = last ? nB : cB + (size_t)(t + 2) * kstep;
            const char* a3 = a2 + kstep; const char* b3 = b2 + kstep;
            unsigned v2[2][2];
            if constexpr (GA) {
#pragma unroll
                for (int _h = 0; _h < 2; ++_h)
#pragma unroll
                    for (int _i = 0; _i < 2; ++_i) v2[_h][_i] = last ? vAn[_h][_i] : vAc[_h][_i];
            }
            PG8_LDB(B0, 0, 0); PG8_LDB(B1, 0, 1); PG8_SCHED; PG8_LDA(At, 0, 0); PG8_STAGE_A(PG8_SA(1, 1), 1, a1, vAc);
            PG8_WAIT_V(8); PG8_WAIT_L(0); PG8_BAR; PG8_MMA(0, 0, At, B0); PG8_MMA(0, 1, At, B1); PG8_BAR; PG8_SCHED;
            PG8_LDA(At, 0, 1); PG8_STAGE(PG8_SB(0, 0), b2, voffB); PG8_STAGE(PG8_SB(0, 1), b2 + hstep, voffB); PG8_STAGE_A(PG8_SA(0, 0), 0, a2, v2);
            PG8_WAIT_V(8); PG8_WAIT_L(0); PG8_BAR; PG8_MMA(1, 0, At, B0); PG8_MMA(1, 1, At, B1); PG8_BAR; PG8_SCHED;
            PG8_LDB(B0, 1, 0); PG8_LDB(B1, 1, 1); PG8_SCHED; PG8_LDA(At, 1, 0); PG8_STAGE_A(PG8_SA(0, 1), 1, a2, v2);
            PG8_WAIT_V(8); PG8_WAIT_L(0); PG8_BAR; PG8_MMA(0, 0, At, B0); PG8_MMA(0, 1, At, B1); PG8_BAR; PG8_SCHED;
            PG8_LDA(At, 1, 1); PG8_STAGE(PG8_SB(1, 0), b3, voffB); PG8_STAGE(PG8_SB(1, 1), b3 + hstep, voffB); PG8_STAGE_A(PG8_SA(1, 0), 0, a3, v2);
            PG8_WAIT_V(8); PG8_WAIT_L(0); PG8_BAR; PG8_MMA(1, 0, At, B0); PG8_MMA(1, 1, At, B1); PG8_BAR; PG8_SCHED;
        }
        if (wr == 0) PG8_BAR;
        E(acc, cur, wr, wc, fr, fq);
        if (!has_next) break;
#pragma unroll
        for (int a = 0; a < 2; ++a)
#pragma unroll
            for (int b = 0; b < 2; ++b)
#pragma unroll
                for (int m = 0; m < 4; ++m)
#pragma unroll
                    for (int n = 0; n < 2; ++n) acc[a][b][m][n] = (f32x4){0.f, 0.f, 0.f, 0.f};
        cur = nxt; cB = nB; cA = nA; ++ui;
        if constexpr (GA) {
#pragma unroll
            for (int _h = 0; _h < 2; ++_h)
#pragma unroll
                for (int _i = 0; _i < 2; ++_i) vAc[_h][_i] = vAn[_h][_i];
        }
        if (wr == 1) PG8_BAR;
    }
    PG8_WAIT_V(0);
    PG8_BAR;
#undef PG8_SA
#undef PG8_SB
#undef PG8_STAGE
#undef PG8_LDA
#undef PG8_LDB
#undef PG8_MMA
#undef PG8_WAIT_V
#undef PG8_WAIT_L
#undef PG8_BAR
#undef PG8_SCHED
#undef PG8_VOFFA
#undef PG8_STAGE_A
}
#else
template <class Epi, class Sched>
static inline void gemm_phase(unsigned char* lds, const Gemm g, const Sched& S, const Epi& E) {
    const int tid = TID, wid = tid >> 6, lane = tid & 63, wr = wid >> 2, wc = wid & 3, fr = lane & 15, fq = lane >> 4;
    float* C = (float*)(lds + 512 * 1024);
    Unit cur;
    for (int ui = 0; S.next(ui, cur); ++ui) {
        SYNC();
        { const int r = tid >> 1, c0 = (tid & 1) * 128; const bf16_t* arow = g.A + (size_t)S.arow(cur, r) * g.K; const bf16_t* bb = (const bf16_t*)S.bbase(g, cur);
          for (int c = c0; c < c0 + 128; ++c) { const bf16_t* brow = bb + (size_t)c * g.K; float s = 0.f; for (int k = 0; k < g.K; ++k) s += bf2f(arow[k]) * bf2f(brow[k]); C[r * 256 + c] = s; } }
        SYNC();
        f32x4 acc[2][2][4][2];
        for (int ai = 0; ai < 2; ++ai) for (int bj = 0; bj < 2; ++bj) for (int m = 0; m < 4; ++m) for (int n = 0; n < 2; ++n) for (int i = 0; i < 4; ++i) {
            const int row = 128 * ai + 64 * wr + 16 * m + fr, col = Epi::PERM ? 128 * bj + 32 * wc + 8 * fq + 4 * n + i : 128 * bj + 32 * wc + 16 * n + 4 * fq + i;
            acc[ai][bj][m][n][i] = C[row * 256 + col]; }
        E(acc, cur, wr, wc, fr, fq);
    }
    SYNC();
}
#endif
}

struct Frame {
    LAS unsigned char* lds;
    int tid, lane, wave, G, bid;
    const Params* pp; float* out; unsigned char* ws;
};
#define WSP(T, off) ((T*)(F.ws + (off)))

DEV void transpose_item(const float* W, int K, int N, bf16_t* WT, int dst_row, int k0, int n0, LAS float* scr, int lane) {
#pragma unroll 8
    for (int i = 0; i < 32; ++i) { const int kk = 2 * i + (lane >> 5); scr[kk * 33 + (lane & 31)] = W[(size_t)(k0 + kk) * N + n0 + (lane & 31)]; }
    WAVE_LDS_FENCE();
    const int c = lane & 7;
#pragma unroll
    for (int j = 0; j < 4; ++j) { const int n = (lane >> 3) + 8 * j; const LAS float* s = scr + (8 * c) * 33 + n;
        u32x4 o; o.x = pk2(s[0 * 33], s[1 * 33]); o.y = pk2(s[2 * 33], s[3 * 33]); o.z = pk2(s[4 * 33], s[5 * 33]); o.w = pk2(s[6 * 33], s[7 * 33]);
        *(u32x4*)(WT + (size_t)(dst_row + n) * K + k0 + 8 * c) = o; }
    WAVE_LDS_FENCE();
}
DEV int map_in(int s) {
    if (s < 2560) return s;
    if (s < 2592) return 7680 + (s - 2560);
    if (s < 4640) return s - 32;
    if (s < 4672) return 7712 + (s - 4640);
    return s - 64;
}
DEV int map_gu(int s, int up) { return (s >> 7) * 256 + up * 128 + (s & 127); }
DEV void transpose_job(Frame& F, const float* W, int K, int N, bf16_t* WT, int mode  , int row_base, int item, bool active) {
    LAS float* scr = (LAS float*)(F.lds) + F.wave * (64 * 33);
    if (active) {
        const int nblk = N / 32, kb = item / nblk, nb = item % nblk, n0 = nb * 32;
        int d = n0; if (mode == 1) d = map_in(n0); else if (mode == 2) d = map_gu(n0, 0); else if (mode == 3) d = map_gu(n0, 1);
        transpose_item(W, K, N, WT, row_base + d, kb * 64, n0, scr, F.lane);
    }
}
DEV void p0_small(Frame& F) {
    const float* c = F.pp->in[1]; const float* cctx = F.pp->in[3]; const float* aw = F.pp->in[4]; const float* ab = F.pp->in[5];
    float* mod = WSP(float, WS_MOD);
    LAS float* red = (LAS float*)F.lds;
    for (int cb = F.bid; cb < 192; cb += F.G) {
        const int cl = F.tid & 31, kg = F.tid >> 5, col = cb * 32 + cl;
        float s0 = 0.f, s1 = 0.f, s2 = 0.f;
#pragma unroll 16
        for (int k = kg * 64; k < kg * 64 + 64; ++k) { const float w = aw[(size_t)k * 6144 + col]; s0 += siluf_(c[k]) * w; s1 += siluf_(c[1024 + k]) * w; s2 += siluf_(cctx[k]) * w; }
        red[(kg * 32 + cl) * 3 + 0] = s0; red[(kg * 32 + cl) * 3 + 1] = s1; red[(kg * 32 + cl) * 3 + 2] = s2;
        SYNC();
        if (F.tid < 96) { const int v = F.tid / 32, cc = F.tid % 32; float s = 0.f; for (int q = 0; q < 16; ++q) s += red[(q * 32 + cc) * 3 + v]; mod[v * 6144 + cb * 32 + cc] = s + ab[cb * 32 + cc]; }
        SYNC();
    }
}
DEV void p0_weights(Frame& F) {
    SYNC();
    const int gw = F.bid * 8 + F.wave, NGW = F.G * 8;
#define P0_JOB(Wp, Kv, Nv, WTp, modev, rb) do { const int nitems_ = ((Kv) / 64) * ((Nv) / 32); const int rounds_ = (nitems_ + NGW - 1) / NGW; \
        for (int r_ = 0; r_ < rounds_; ++r_) { const int it_ = r_ * NGW + gw; transpose_job(F, (Wp), (Kv), (Nv), (WTp), (modev), (rb), it_, it_ < nitems_); } } while (0)
    P0_JOB(F.pp->in[8], 1024, 7744, WSP(bf16_t, WS_WIN), 1, 0);
    P0_JOB(F.pp->in[20], 1024, 1024, WSP(bf16_t, WS_WSO), 0, 0);
    P0_JOB(F.pp->in[21], 1024, 1024, WSP(bf16_t, WS_WMO), 0, 0);
    P0_JOB(F.pp->in[22], 1024, 1024, WSP(bf16_t, WS_WOUT), 0, 0);
    P0_JOB(F.pp->in[23], 1024, NEXP, WSP(bf16_t, WS_WRS), 0, 0);
    P0_JOB(F.pp->in[28], 1024, 256, WSP(bf16_t, WS_WRS), 2, 256);
    P0_JOB(F.pp->in[29], 1024, 256, WSP(bf16_t, WS_WRS), 3, 256);
    P0_JOB(F.pp->in[30], 256, 1024, WSP(bf16_t, WS_WSD), 0, 0);
#undef P0_JOB
}
struct T64 { const float* W; bf16_t* WT; int K, N, dst_row, k0, n0; };
DEV void t64_load(const T64& t, f32x4 (&v)[16], int lane) {
#pragma unroll
    for (int i = 0; i < 16; ++i) v[i] = *(const f32x4*)(t.W + (size_t)(t.k0 + 4 * i + (lane >> 4)) * t.N + t.n0 + 4 * (lane & 15));
}
DEV void t64_store(const T64& t, const f32x4 (&v)[16], LAS float* scr, int lane) {
#pragma unroll
    for (int i = 0; i < 16; ++i) { LAS float* d = scr + (4 * i + (lane >> 4)) * 65 + 4 * (lane & 15); d[0] = v[i].x; d[1] = v[i].y; d[2] = v[i].z; d[3] = v[i].w; }
    WAVE_LDS_FENCE();
    const int c = lane & 7;
#pragma unroll
    for (int j = 0; j < 8; ++j) { const int n = (lane >> 3) + 8 * j; const LAS float* sp = scr + (8 * c) * 65 + n;
        u32x4 o; o.x = pk2(sp[0 * 65], sp[1 * 65]); o.y = pk2(sp[2 * 65], sp[3 * 65]); o.z = pk2(sp[4 * 65], sp[5 * 65]); o.w = pk2(sp[6 * 65], sp[7 * 65]);
        *(u32x4*)(t.WT + (size_t)(t.dst_row + n) * t.K + t.k0 + 8 * c) = o; }
    WAVE_LDS_FENCE();
}
DEV T64 expert_item(Frame& F, int e0, int it) {
    const int per = 192, el = it / per, j = it % per, e = e0 + el; T64 t;
    if (j < 128) { const int up = j >> 6, jj = j & 63, kb = jj >> 2, nb = jj & 3;
        t.W = F.pp->in[25 + up] + (size_t)e * 1024 * 256; t.K = 1024; t.N = 256; t.WT = WSP(bf16_t, WS_W1T) + (size_t)el * 512 * 1024; t.dst_row = map_gu(nb * 64, up); t.k0 = kb * 64; t.n0 = nb * 64; }
    else { const int jj = j - 128, kb = jj >> 4, nb = jj & 15;
        t.W = F.pp->in[27] + (size_t)e * 256 * 1024; t.K = 256; t.N = 1024; t.WT = WSP(bf16_t, WS_W2T) + (size_t)el * 1024 * 256; t.dst_row = nb * 64; t.k0 = kb * 64; t.n0 = nb * 64; }
    return t;
}
DEV void p_expert_weights(Frame& F) {
    const int gw = F.bid * 8 + F.wave, NGW = F.G * 8;
    LAS float* scr = (LAS float*)(F.lds) + F.wave * (64 * 65);
    const int nitems = NEXP * 192;
    f32x4 v[16];
    if (gw < nitems) { const T64 t = expert_item(F, 0, gw); t64_load(t, v, F.lane); }
#pragma unroll 1
    for (int it = gw; it < nitems; it += NGW) {
        const T64 t = expert_item(F, 0, it);
        f32x4 cur[16];
#pragma unroll
        for (int i = 0; i < 16; ++i) cur[i] = v[i];
        if (it + NGW < nitems) { const T64 tn = expert_item(F, 0, it + NGW); t64_load(tn, v, F.lane); }
        t64_store(t, cur, scr, F.lane);
    }
    SYNC();
}

DEV void norm_mod_row(const float* xrow, const float* g, const float* shift, const float* scale, bf16_t* orow, int lane) {
    const f32x4* xr = (const f32x4*)xrow + lane;
    f32x4 v[4]; float s = 0.f;
#pragma unroll
    for (int j = 0; j < 4; ++j) { v[j] = xr[64 * j]; s += (v[j].x * v[j].x + v[j].y * v[j].y) + (v[j].z * v[j].z + v[j].w * v[j].w); }
    const float rstd = RSQF(wave_sum(s) * (1.f / DM) + EPS);
    u32x2* o8 = (u32x2*)orow + lane;
#pragma unroll
    for (int j = 0; j < 4; ++j) {
        const f32x4 gg = ((const f32x4*)g)[lane + 64 * j], sh = ((const f32x4*)shift)[lane + 64 * j], sc = ((const f32x4*)scale)[lane + 64 * j];
        const f32x4 y = v[j] * rstd * gg * (sc + 1.0f) + sh;
        u32x2 w; w.x = pk2(y.x, y.y); w.y = pk2(y.z, y.w); o8[64 * j] = w;
    }
}
template <int NR> DEV void norm_mod_rows(const float* const (&xrow)[NR], const float* g, const float* const (&shift)[NR], const float* const (&scale)[NR], bf16_t* const (&orow)[NR], int lane) {
    f32x4 v[NR][4]; float s[NR];
#pragma unroll
    for (int r = 0; r < NR; ++r)
#pragma unroll
        for (int j = 0; j < 4; ++j) v[r][j] = ((const f32x4*)xrow[r])[lane + 64 * j];
#pragma unroll
    for (int r = 0; r < NR; ++r) { float a = 0.f;
#pragma unroll
        for (int j = 0; j < 4; ++j) a += (v[r][j].x * v[r][j].x + v[r][j].y * v[r][j].y) + (v[r][j].z * v[r][j].z + v[r][j].w * v[r][j].w);
        s[r] = a; }
#pragma unroll
    for (int o = 1; o < 64; o <<= 1)
#pragma unroll
        for (int r = 0; r < NR; ++r) s[r] += __shfl_xor(s[r], o);
#pragma unroll
    for (int r = 0; r < NR; ++r) { const float rstd = RSQF(s[r] * (1.f / DM) + EPS); u32x2* o8 = (u32x2*)orow[r] + lane;
#pragma unroll
        for (int j = 0; j < 4; ++j) {
            const f32x4 gg = ((const f32x4*)g)[lane + 64 * j], sh = ((const f32x4*)shift[r])[lane + 64 * j], sc = ((const f32x4*)scale[r])[lane + 64 * j];
            const f32x4 y = v[r][j] * rstd * gg * (sc + 1.0f) + sh;
            u32x2 w; w.x = pk2(y.x, y.y); w.y = pk2(y.z, y.w); o8[64 * j] = w; } }
}
DEV void p1_xn(Frame& F) {
    const float* mod = WSP(float, WS_MOD); bf16_t* XN = WSP(bf16_t, WS_XN);
    const int gw = F.bid * 8 + F.wave, NGW = F.G * 8;
    static_assert(NROWS % 8 == 0 && SEQ % 8 == 0 && NLAT % 8 == 0, "row octets");
    for (int q = gw; q < NROWS / 8; q += NGW) {
        const float* src[8]; const float* sh[8]; const float* sc[8]; bf16_t* dst[8];
#pragma unroll
        for (int i = 0; i < 8; ++i) { const int r = q * 8 + i; src[i] = r < NLAT ? F.pp->in[0] + (size_t)r * DM : F.pp->in[2] + (size_t)(r - NLAT) * DM;
            const int mv = r < NLAT ? r / SEQ : 2; sh[i] = mod + mv * 6144; sc[i] = mod + mv * 6144 + 1024; dst[i] = XN + (size_t)r * DM; }
        norm_mod_rows<8>(src, F.pp->in[6], sh, sc, dst, F.lane);
    }
}
DEV void p10_xn2(Frame& F) {
    const float* mod = WSP(float, WS_MOD); bf16_t* XN = WSP(bf16_t, WS_XN);
    const int gw = F.bid * 8 + F.wave, NGW = F.G * 8;
    for (int q = gw; q < NLAT / 4; q += NGW) {
        const float* src[4]; const float* sh[4]; const float* sc[4]; bf16_t* dst[4];
#pragma unroll
        for (int i = 0; i < 4; ++i) { const int r = q * 4 + i; src[i] = F.out + (size_t)r * DM; const int mv = r / SEQ; sh[i] = mod + mv * 6144 + 3 * 1024; sc[i] = mod + mv * 6144 + 4 * 1024; dst[i] = XN + (size_t)r * DM; }
        norm_mod_rows<4>(src, F.pp->in[7], sh, sc, dst, F.lane);
    }
}

DEV size_t um(int row, int col, int W) { return ((size_t)(col / W) * NROWS + row) * W + (col % W); }
DEV size_t um_xbc(int row, int col) { return col < 1024 ? um(row, col, 64) : (size_t)NROWS * 1024 + um(row, col - 1024, 128); }
#ifndef CONV_FUSED
#define CONV_FUSED 1
#endif
typedef f32x4 AccT[2][2][4][2];
DEV u32x2 pack4(f32x4 a) { u32x2 w; w.x = pk2(a.x, a.y); w.y = pk2(a.z, a.w); return w; }
DEV u32x4 pack8(f32x4 a, f32x4 b) { u32x4 w; w.x = pk2(a.x, a.y); w.y = pk2(a.z, a.w); w.z = pk2(b.x, b.y); w.w = pk2(b.z, b.w); return w; }
DEV f32x4 sig4(f32x4 a) { f32x4 r; r.x = sigmoidf_(a.x); r.y = sigmoidf_(a.y); r.z = sigmoidf_(a.z); r.w = sigmoidf_(a.w); return r; }
DEV void unpack8(u32x4 w, f32x4& a, f32x4& b) { a.x = bflo(w.x); a.y = bfhi(w.x); a.z = bflo(w.y); a.w = bfhi(w.y); b.x = bflo(w.z); b.y = bfhi(w.z); b.z = bflo(w.w); b.w = bfhi(w.w); }

#ifndef HOST_EMU
template <int D> DEV float rot16(float v, int) { return __builtin_bit_cast(float, __builtin_amdgcn_update_dpp(0, __builtin_bit_cast(int, v), 0x120 + ((16 - D) & 15), 0xF, 0xF, false)); }
#else
template <int D> DEV float rot16(float v, int lane) { return __shfl(v, (lane & 48) | ((lane + D) & 15)); }
#endif
struct EpiInProj {
    static constexpr bool PERM = true;
    bf16_t *Z, *XBC, *QK, *V, *O, *MG; float* DTG; const float *cwx, *cbx, *cwq, *cbq; LAS unsigned char* ldsx;
    DEV void operator()(const AccT& acc, const pg8::Unit& u, int wr, int wc, int fr_in, int fq_in) const {
        int fr = fr_in, fq = fq_in; OPAQUE_V(fr); OPAQUE_V(fq);
        const int row0 = u.pm * 256 + wr * 64 + fr; const int t = u.pn;
        if (CONV_FUSED && t >= 4 && t < 14 && u.pm * 256 < NLAT) {
            const bool isx = t < 10; bf16_t* base = isx ? XBC : QK; const int ldc = isx ? 1536 : 1024, colt = isx ? (t - 4) * 256 : (t - 10) * 256;
            const float* cw = isx ? cwx : cwq; const float* cb = isx ? cbx : cbq; const float osc = (!isx && colt < 512) ? 0.125f : 1.0f;
            const int lane = fq * 16 + fr;
            LAS float* wl = (LAS float*)(ldsx + (wr * 4 + wc) * 1536);
#pragma unroll
            for (int r = 0; r < 6; ++r) { const int cidx = lane, col = colt + (cidx >> 5) * 128 + wc * 32 + (cidx & 31); wl[r * 64 + cidx] = r < 5 ? cw[(size_t)r * ldc + col] : cb[col]; }
            WAVE_LDS_FENCE();
#pragma unroll
            for (int bj = 0; bj < 2; ++bj)
#pragma unroll
                for (int n = 0; n < 2; ++n) { const int col0 = colt + bj * 128 + wc * 32 + 8 * fq + 4 * n;
#pragma unroll
                    for (int ai = 0; ai < 2; ++ai) { f32x4 o[4];
#pragma unroll
                        for (int i = 0; i < 4; ++i) { float r1[5], r2[5], l1[5], l2[5]; r1[4] = 0.f; r2[4] = 0.f; l1[0] = 0.f; l2[0] = 0.f;
                            const int ci = bj * 32 + 8 * fq + 4 * n + i; const float w0 = wl[ci], w1 = wl[64 + ci], w2 = wl[128 + ci], w3 = wl[192 + ci], w4 = wl[256 + ci], bb = wl[320 + ci];
#pragma unroll
                            for (int m = 0; m < 4; ++m) { const float v = acc[ai][bj][m][n][i]; r1[m] = rot16<1>(v, lane); r2[m] = rot16<2>(v, lane); l1[m + 1] = rot16<-1>(v, lane); l2[m + 1] = rot16<-2>(v, lane); }
#pragma unroll
                            for (int m = 0; m < 4; ++m) { const float v = acc[ai][bj][m][n][i];
                                const float n1 = fr < 15 ? r1[m] : r1[m + 1], n2 = fr < 14 ? r2[m] : r2[m + 1], p1 = fr > 0 ? l1[m + 1] : l1[m], p2 = fr > 1 ? l2[m + 1] : l2[m];
                                const float a = bb + w0 * p2 + w1 * p1 + w2 * v + w3 * n1 + w4 * n2;
                                o[m][i] = siluf_(a) * osc; }
                            }
#pragma unroll
                        for (int m = 0; m < 4; ++m) { const int rr = row0 + ai * 128 + m * 16; *(u32x2*)(base + (isx ? um_xbc(rr, col0) : um(rr, col0, 64))) = pack4(o[m]); }
                        MEM_FENCE(); SCHED_FENCE(); } }
        } else if (t < 30) {
            bf16_t* base; int ldc, colt, kind; bool act = false;
            if (t < 4) { base = Z; ldc = 1024; colt = t * 256; kind = 64; }
            else if (t < 10) { base = XBC; ldc = 1536; colt = (t - 4) * 256; kind = 1; }
            else if (t < 14) { base = QK; ldc = 1024; colt = (t - 10) * 256; kind = 64; }
            else if (t < 18) { base = V; ldc = 1024; colt = (t - 14) * 256; kind = 128; }
            else if (t < 22) { base = O; ldc = 1024; colt = (t - 18) * 256; act = true; kind = 128; }
            else { base = MG; ldc = 2048; colt = (t - 22) * 256; act = true; kind = 0; }
            const int col0 = colt + wc * 32 + 8 * fq;
#pragma unroll
            for (int ai = 0; ai < 2; ++ai)
#pragma unroll
                for (int m = 0; m < 4; ++m) { const int rr = row0 + ai * 128 + m * 16;
#pragma unroll
                    for (int bj = 0; bj < 2; ++bj) { f32x4 v0 = acc[ai][bj][m][0], v1 = acc[ai][bj][m][1]; const int cc = col0 + bj * 128;
                        if (act) { v0 = sig4(v0); v1 = sig4(v1); }
                        const size_t off = kind == 0 ? (size_t)rr * ldc + cc : (kind == 1 ? um_xbc(rr, cc) : um(rr, cc, kind));
                        *(u32x4*)(base + off) = pack8(v0, v1); }
                    MEM_FENCE(); SCHED_FENCE(); }
        } else if (wc < 2) {
#pragma unroll
            for (int ai = 0; ai < 2; ++ai)
#pragma unroll
                for (int m = 0; m < 4; ++m)
#pragma unroll
                    for (int n = 0; n < 2; ++n) { const int c0 = 32 * wc + 8 * fq + 4 * n;
                        *(f32x4*)(DTG + (size_t)(row0 + ai * 128 + m * 16) * 64 + c0) = acc[ai][0][m][n]; }
        }
    }
};
struct EpiG1 {
    static constexpr bool PERM = true;
    bf16_t* M1; const bf16_t* MG; const float* SSQ;
    DEV void operator()(const AccT& acc, const pg8::Unit& u, int wr, int wc, int fr, int fq) const {
        const int row0 = u.pm * 256 + wr * 64 + fr, col0 = u.pn * 256 + wc * 32 + 8 * fq;
#pragma unroll
        for (int ai = 0; ai < 2; ++ai)
#pragma unroll
            for (int m = 0; m < 4; ++m) { const size_t row = (size_t)(row0 + ai * 128 + m * 16);
                const f32x4* sq = (const f32x4*)(SSQ + row * 16); const f32x4 q0 = sq[0], q1 = sq[1], q2 = sq[2], q3 = sq[3];
                const float ss = ((q0.x + q0.y) + (q0.z + q0.w)) + ((q1.x + q1.y) + (q1.z + q1.w)) + ((q2.x + q2.y) + (q2.z + q2.w)) + ((q3.x + q3.y) + (q3.z + q3.w));
                const float rstd = RSQF(ss * (1.f / 1024.f) + EPS);
#pragma unroll
                for (int bj = 0; bj < 2; ++bj) { f32x4 g0, g1; unpack8(*(const u32x4*)(MG + row * 2048 + col0 + bj * 128), g0, g1);
                    *(u32x4*)(M1 + row * 1024 + col0 + bj * 128) = pack8(acc[ai][bj][m][0] * g0 * rstd, acc[ai][bj][m][1] * g1 * rstd); } }
    }
};
struct EpiG2 {
    static constexpr bool PERM = true;
    bf16_t* MERGED; const bf16_t* M1; const bf16_t* MG;
    DEV void operator()(const AccT& acc, const pg8::Unit& u, int wr, int wc, int fr, int fq) const {
        const int row0 = u.pm * 256 + wr * 64 + fr, col0 = u.pn * 256 + wc * 32 + 8 * fq;
#pragma unroll
        for (int ai = 0; ai < 2; ++ai)
#pragma unroll
            for (int m = 0; m < 4; ++m) { const size_t row = (size_t)(row0 + ai * 128 + m * 16);
#pragma unroll
                for (int bj = 0; bj < 2; ++bj) { f32x4 g0, g1, p0, p1; unpack8(*(const u32x4*)(MG + row * 2048 + 1024 + col0 + bj * 128), g0, g1);
                    unpack8(*(const u32x4*)(M1 + row * 1024 + col0 + bj * 128), p0, p1);
                    *(u32x4*)(MERGED + row * 1024 + col0 + bj * 128) = pack8(p0 + acc[ai][bj][m][0] * g0, p1 + acc[ai][bj][m][1] * g1); } }
    }
};
struct EpiG3 {
    static constexpr bool PERM = false;
    const float* x; float* x1; const float* mod;
    DEV void operator()(const AccT& acc, const pg8::Unit& u, int wr, int wc, int fr, int fq) const {
        const int row0 = u.pm * 256 + wr * 64 + fr, col0 = u.pn * 256 + wc * 32 + 4 * fq;
        const float* gate = mod + ((u.pm * 256) / SEQ) * 6144 + 2 * 1024;
#pragma unroll
        for (int bj = 0; bj < 2; ++bj)
#pragma unroll
            for (int n = 0; n < 2; ++n) { const int c = col0 + bj * 128 + n * 16; const f32x4 gv = *(const f32x4*)(gate + c);
#pragma unroll
                for (int ai = 0; ai < 2; ++ai)
#pragma unroll
                    for (int m = 0; m < 4; ++m) { const size_t off = (size_t)(row0 + ai * 128 + m * 16) * 1024 + c;
                        *(f32x4*)(x1 + off) = *(const f32x4*)(x + off) + gv * acc[ai][bj][m][n]; } }
    }
};
struct EpiRS {
    static constexpr bool PERM = true;
    float* LOGIT; bf16_t* HS;
    DEV void operator()(const AccT& acc, const pg8::Unit& u, int wr, int wc, int fr, int fq) const {
        const int row0 = u.pm * 256 + wr * 64 + fr;
        if (u.pn == 0) {
            {
#pragma unroll
                for (int ai = 0; ai < 2; ++ai)
#pragma unroll
                    for (int m = 0; m < 4; ++m)
#pragma unroll
                        for (int bj = 0; bj < 2; ++bj)
#pragma unroll
                            for (int n = 0; n < 2; ++n) { const int c = bj * 128 + wc * 32 + 8 * fq + 4 * n;
                                if (c < NEXP) *(f32x4*)(LOGIT + (size_t)(row0 + ai * 128 + m * 16) * NEXP + c) = acc[ai][bj][m][n]; }
            }
        } else {
            const int col0 = (u.pn - 1) * 128 + wc * 32 + 8 * fq;
#pragma unroll
            for (int ai = 0; ai < 2; ++ai)
#pragma unroll
                for (int m = 0; m < 4; ++m) { f32x4 h0, h1;
#pragma unroll
                    for (int i = 0; i < 4; ++i) { h0[i] = siluf_(acc[ai][0][m][0][i]) * acc[ai][1][m][0][i]; h1[i] = siluf_(acc[ai][0][m][1][i]) * acc[ai][1][m][1][i]; }
                    *(u32x4*)(HS + (size_t)(row0 + ai * 128 + m * 16) * 256 + col0) = pack8(h0, h1); }
        }
    }
};
struct EpiX1 {
    static constexpr bool PERM = true;
    bf16_t* H;
    DEV void operator()(const AccT& acc, const pg8::Unit& u, int wr, int wc, int fr, int fq) const {
        const int row0 = u.pm * 256 + wr * 64 + fr, col0 = u.pn * 128 + wc * 32 + 8 * fq;
#pragma unroll
        for (int ai = 0; ai < 2; ++ai)
#pragma unroll
            for (int m = 0; m < 4; ++m) { f32x4 h0, h1;
#pragma unroll
                for (int i = 0; i < 4; ++i) { h0[i] = siluf_(acc[ai][0][m][0][i]) * acc[ai][1][m][0][i]; h1[i] = siluf_(acc[ai][0][m][1][i]) * acc[ai][1][m][1][i]; }
                *(u32x4*)(H + (size_t)(row0 + ai * 128 + m * 16) * 256 + col0) = pack8(h0, h1); }
    }
};
struct EpiX2 {
    static constexpr bool PERM = true;
    bf16_t* Y; const int* sdst; const float* sw;
    DEV void operator()(const AccT& acc, const pg8::Unit& u, int wr, int wc, int fr, int fq) const {
        const int row0 = u.pm * 256 + wr * 64 + fr, col0 = u.pn * 256 + wc * 32 + 8 * fq;
        int dst[8]; float w[8];
#pragma unroll
        for (int r = 0; r < 8; ++r) { const int slot = row0 + (r >> 2) * 128 + (r & 3) * 16; dst[r] = sdst[slot]; w[r] = sw[slot]; }
#pragma unroll
        for (int ai = 0; ai < 2; ++ai)
#pragma unroll
            for (int m = 0; m < 4; ++m) { const int d = dst[ai * 4 + m]; const float ww = w[ai * 4 + m];
                if (d >= 0) {
#pragma unroll
                    for (int bj = 0; bj < 2; ++bj) *(u32x4*)(Y + (size_t)d * 1024 + col0 + bj * 128) = pack8(acc[ai][bj][m][0] * ww, acc[ai][bj][m][1] * ww); } }
    }
};
struct EpiSD {
    static constexpr bool PERM = true;
    bf16_t* YS;
    DEV void operator()(const AccT& acc, const pg8::Unit& u, int wr, int wc, int fr, int fq) const {
        const int row0 = u.pm * 256 + wr * 64 + fr, col0 = u.pn * 256 + wc * 32 + 8 * fq;
#pragma unroll
        for (int ai = 0; ai < 2; ++ai)
#pragma unroll
            for (int m = 0; m < 4; ++m) { bf16_t* rp = YS + (size_t)(row0 + ai * 128 + m * 16) * 1024 + col0;
#pragma unroll
                for (int bj = 0; bj < 2; ++bj) *(u32x4*)(rp + bj * 128) = pack8(acc[ai][bj][m][0], acc[ai][bj][m][1]);
                MEM_FENCE(); }
    }
};

DEV int chunk_row0(int b, int cc) { return cc < NCH ? b * SEQ + cc * CHUNK : NLAT + b * CTXL + (cc - NCH) * CHUNK; }

struct GateBias { const float *dtb, *ib, *fb; };
template <bool ML> DEV void tok_ag(const float* DTG, const float* aneg, const GateBias& gbv, size_t row, int dir, int hg, float& a, float& g) {
    if (!ML) { const float dt = softplusf_(DTG[row * 64 + dir * 16 + hg] + gbv.dtb[dir * 16 + hg]); a = dt * aneg[dir * 16 + hg]; g = dt; }
    else { const float ig = DTG[row * 64 + 32 + dir * 16 + hg] + gbv.ib[dir * 8 + hg]; a = logsigmoidf_(DTG[row * 64 + 32 + dir * 16 + 8 + hg] + gbv.fb[dir * 8 + hg]); g = EXPF(ig); }
}
struct CtxW { float w[5][8], b[8]; };
DEV void ctx_conv_prep(CtxW& c, const float* cw, const float* cb, int ld, int col) {
#pragma unroll
    for (int j = 0; j < 5; ++j) { const f32x4 a = *(const f32x4*)(cw + (size_t)j * ld + col), d = *(const f32x4*)(cw + (size_t)j * ld + col + 4);
#pragma unroll
        for (int i = 0; i < 4; ++i) { c.w[j][i] = a[i]; c.w[j][4 + i] = d[i]; } }
    const f32x4 a = *(const f32x4*)(cb + col), d = *(const f32x4*)(cb + col + 4);
#pragma unroll
    for (int i = 0; i < 4; ++i) { c.b[i] = a[i]; c.b[4 + i] = d[i]; }
}
DEV u32x4 ctx_conv_chunk(const CtxW& c, const bf16_t* buf, int ld  , int seg0, int kseg, int col) {
    float a[8];
#pragma unroll
    for (int i = 0; i < 8; ++i) a[i] = c.b[i];
#pragma unroll
    for (int j = 0; j < 5; ++j) { const int kk = kseg + j - 2;
        if (kk >= 0 && kk < CTXL) { f32x4 v0, v1; unpack8(*(const u32x4*)(buf + (ld == 1536 ? um_xbc(seg0 + kk, col) : um(seg0 + kk, col, 64))), v0, v1);
#pragma unroll
            for (int i = 0; i < 4; ++i) { a[i] += c.w[j][i] * v0[i]; a[4 + i] += c.w[j][4 + i] * v1[i]; } } }
    f32x4 o0, o1;
#pragma unroll
    for (int i = 0; i < 4; ++i) { o0[i] = siluf_(a[i]); o1[i] = siluf_(a[4 + i]); }
    return pack8(o0, o1);
}

DEV int chunk_order(int dir, int s) { return dir == 0 ? (s < NCHC ? NCH + s : s - NCHC) : (s < NCHC ? NCH + (NCHC - 1 - s) : NCH - 1 - (s - NCHC)); }
DEV void p5_scan(Frame& F) {
    const int NS = BATCH * 2 * SSD_H * SSD_P * (SSD_N / 8), NM = BATCH * 2 * ML_H * ML_PP * (ML_DK / 8);
    const int gt = F.bid * NTHR + F.tid, GT = F.G * NTHR;
    for (int idx = gt; idx < NS + NM; idx += GT) {
        bf16_t* base; const float* dec; size_t cstride; int dstride, dir;
        if (idx < NS) { const int n8 = idx % 16, p = (idx / 16) % 64, hd = (idx / 1024) % 16; dir = (idx / 16384) % 2; const int b = idx / 32768;
            base = WSP(bf16_t, WS_STS) + (size_t)(b * 2 + dir) * NCHT * STS_CH + ((size_t)hd * 64 + p) * 128 + n8 * 8; cstride = STS_CH;
            dec = WSP(float, WS_DECS) + (size_t)(b * 2 + dir) * NCHT * 16 + hd; dstride = 16; }
        else { const int j = idx - NS; const int n8 = j % 8, p = (j / 8) % 144, hd = (j / 1152) % 8; dir = (j / 9216) % 2; const int b = j / 18432;
            base = WSP(bf16_t, WS_STM) + (size_t)(b * 2 + dir) * NCHT * STM_CH + ((size_t)hd * 144 + p) * 64 + n8 * 8; cstride = STM_CH;
            dec = WSP(float, WS_DECM) + (size_t)(b * 2 + dir) * NCHT * 8 + hd; dstride = 8; }
        f32x4 c0 = {0.f, 0.f, 0.f, 0.f}, c1 = {0.f, 0.f, 0.f, 0.f};
        constexpr int UB = (NCHT % 10 == 0) ? 10 : ((NCHT % 2 == 0) ? 2 : 1);
        for (int s0 = 0; s0 < NCHT; s0 += UB) {
            u32x4 v[UB]; float d[UB];
#pragma unroll
            for (int j = 0; j < UB; ++j) { const int cc = chunk_order(dir, s0 + j); v[j] = *(const u32x4*)(base + (size_t)cc * cstride); d[j] = dec[cc * dstride]; }
#pragma unroll
            for (int j = 0; j < UB; ++j) { const int cc = chunk_order(dir, s0 + j);
                if (cc < NCH) *(u32x4*)(base + (size_t)cc * cstride) = pack8(c0, c1);
                f32x4 a0, a1; unpack8(v[j], a0, a1); c0 = c0 * d[j] + a0; c1 = c1 * d[j] + a1; }
        }
    }
}

DEV bf16x8 tr_frag(const LAS bf16_t* T, int LD, int k0, int c0, int lane) {
    const LAS bf16_t* p0 = T + (k0 + 8 * (lane >> 4) + ((lane & 15) >> 2)) * LD + c0 + 4 * (lane & 3);
    const s16x4 a = lds_tr16(p0), b = lds_tr16(p0 + 4 * LD);
    bf16x8 r; r[0] = a[0]; r[1] = a[1]; r[2] = a[2]; r[3] = a[3]; r[4] = b[0]; r[5] = b[1]; r[6] = b[2]; r[7] = b[3]; return r;
}
DEV bf16x8 tr_frag8(const LAS bf16_t* T, int LD, int k0, int c0, int lane) {
    const LAS bf16_t* p0 = T + (k0 + 8 * (lane >> 4) + ((lane & 15) >> 2)) * LD + c0 + 8 * (lane & 3);
    const s16x4 a = lds_tr16(p0), b = lds_tr16(p0 + 4 * LD);
    bf16x8 r; r[0] = a[0]; r[1] = a[1]; r[2] = a[2]; r[3] = a[3]; r[4] = b[0]; r[5] = b[1]; r[6] = b[2]; r[7] = b[3]; return r;
}
DEV bf16x8 row_frag(const LAS bf16_t* T, int LD, int r0, int k0, int lane) { return *(const LAS bf16x8*)(T + (r0 + (lane & 15)) * LD + k0 + 8 * (lane >> 4)); }
DEV float gtv(u32x2 g, int i) { return i == 0 ? bflo(g.x) : (i == 1 ? bfhi(g.x) : (i == 2 ? bflo(g.y) : bfhi(g.y))); }

DEV void s3v2_ssd(Frame& F, int b, int cc, int gi, const float* aneg) {
    constexpr int LDC = 136, LDX = 80;
    const bf16_t* XBC = WSP(bf16_t, WS_XBC); const float* DTG = WSP(float, WS_DTG); const bf16_t* Z = WSP(bf16_t, WS_Z); bf16_t* YP = WSP(bf16_t, WS_YPRE); float* SSQ = WSP(float, WS_SSQ);
    LAS bf16_t* CQ = (LAS bf16_t*)F.lds;
    LAS bf16_t* GLB = CQ + 128 * LDC;
    LAS bf16_t* XS = GLB + 128 * LDC;
    LAS bf16_t* STF = XS + 128 * LDX;
    LAS bf16_t* STB = STF + 64 * LDC;
    LAS float* Pf = (LAS float*)(STB + 64 * LDC);
    LAS float* Eb = Pf + 128; LAS float* gf = Eb + 128; LAS float* gb = gf + 128; LAS float* itf = gb + 128; LAS float* itb = itf + 128;
    int tid_ = F.tid; OPAQUE_V(tid_);
    const int row0 = chunk_row0(b, cc), w = F.wave, tid = tid_, lane = tid & 63, lq = lane >> 4, lc = lane & 15;
    SYNC();
    for (int idx = tid; idx < 128 * 16; idx += NTHR) { const int k = idx >> 4, n8 = idx & 15;
        *(LAS u32x4*)(CQ + k * LDC + n8 * 8) = *(const u32x4*)(XBC + um_xbc(row0 + k, 1280 + gi * 128 + n8 * 8));
        *(LAS u32x4*)(GLB + k * LDC + n8 * 8) = *(const u32x4*)(XBC + um_xbc(row0 + k, 1024 + gi * 128 + n8 * 8)); }
    u32x4 rx[2], rsf[2], rsb[2]; float rdt[2];
#define S3S_LOAD(hh) do { const int hg_ = gi * 8 + (hh); \
        _Pragma("unroll") for (int j_ = 0; j_ < 2; ++j_) { const int id_ = tid + NTHR * j_; \
            rx[j_] = *(const u32x4*)(XBC + um_xbc(row0 + (id_ >> 3), hg_ * 64 + (id_ & 7) * 8)); \
            rsf[j_] = *(const u32x4*)(WSP(bf16_t, WS_STS) + ((size_t)(b * 2 + 0) * NCHT + cc) * STS_CH + (size_t)hg_ * 8192 + (size_t)id_ * 8); \
            rsb[j_] = *(const u32x4*)(WSP(bf16_t, WS_STS) + ((size_t)(b * 2 + 1) * NCHT + cc) * STS_CH + (size_t)hg_ * 8192 + (size_t)id_ * 8); \
            } \
        if (w < 2) { rdt[0] = DTG[(size_t)(row0 + lane) * 64 + w * 16 + hg_]; rdt[1] = DTG[(size_t)(row0 + 64 + lane) * 64 + w * 16 + hg_]; } } while (0)
    S3S_LOAD(0);
    SYNC();
    bf16x8 aC[4];
#pragma unroll
    for (int ns = 0; ns < 4; ++ns) aC[ns] = row_frag(CQ, LDC, w * 16, ns * 32, lane);
    u32x2 Gt[8];
#pragma unroll
    for (int ct = 0; ct < 8; ++ct) { f32x4 z = {0.f, 0.f, 0.f, 0.f};
#pragma unroll
        for (int ns = 0; ns < 4; ++ns) z = mfma16(row_frag(GLB, LDC, ct * 16, ns * 32, lane), aC[ns], z);
        Gt[ct] = pack4(z); }
    TOUCH(rx[0]); TOUCH(rx[1]); TOUCH(rsf[0]); TOUCH(rsf[1]); TOUCH(rsb[0]); TOUCH(rsb[1]); TOUCH(rdt[0]); TOUCH(rdt[1]);
#pragma unroll 1
    for (int h = 0; h < 8; ++h) {
        const int hg = gi * 8 + h;
        SYNC();
#pragma unroll
        for (int j = 0; j < 2; ++j) { const int id = tid + NTHR * j;
            *(LAS u32x4*)(XS + (id >> 3) * LDX + (id & 7) * 8) = rx[j];
            *(LAS u32x4*)(STF + (id >> 4) * LDC + (id & 15) * 8) = rsf[j];
            *(LAS u32x4*)(STB + (id >> 4) * LDC + (id & 15) * 8) = rsb[j]; }
        if (w < 2) { const float an = aneg[w * 16 + hg], db = F.pp->in[11][w * 16 + hg]; rdt[0] = softplusf_(rdt[0] + db); rdt[1] = softplusf_(rdt[1] + db); const float a0 = rdt[0] * an, a1 = rdt[1] * an;
            const float p0 = wave_incl_scan(a0, lane); const float t0 = __shfl(p0, 63);
            const float p1 = wave_incl_scan(a1, lane) + t0; const float T = __shfl(p1, 63);
            if (w == 0) { Pf[lane] = p0; Pf[64 + lane] = p1; gf[lane] = rdt[0]; gf[64 + lane] = rdt[1]; itf[lane] = EXPF(p0); itf[64 + lane] = EXPF(p1); }
            else { const float e0 = p0 - a0, e1 = p1 - a1; Eb[lane] = e0; Eb[64 + lane] = e1; gb[lane] = rdt[0]; gb[64 + lane] = rdt[1]; itb[lane] = EXPF(T - e0); itb[64 + lane] = EXPF(T - e1); } }
        if (h + 1 < 8) S3S_LOAD(h + 1);
        SYNC();
        const u32x4 zc0 = *(const u32x4*)(Z + um(row0 + 16 * w + (lane >> 3), hg * 64 + (lane & 7) * 8, 64)), zc1 = *(const u32x4*)(Z + um(row0 + 16 * w + (lane >> 3) + 8, hg * 64 + (lane & 7) * 8, 64));
        { const int q = w * 16 + lc; const float pfq = Pf[q], ebq = Eb[q];
#pragma unroll
          for (int ct = 0; ct < 8; ++ct) { const int k0 = ct * 16 + 4 * lq, rel = ct - w; f32x4 fac;
              if (rel < 0) { const f32x4 pk = *(const LAS f32x4*)(Pf + k0), gk = *(const LAS f32x4*)(gf + k0);
#pragma unroll
                  for (int i = 0; i < 4; ++i) fac[i] = EXPF(pfq - pk[i]) * gk[i]; }
              else if (rel > 0) { const f32x4 ek = *(const LAS f32x4*)(Eb + k0), gk = *(const LAS f32x4*)(gb + k0);
#pragma unroll
                  for (int i = 0; i < 4; ++i) fac[i] = EXPF(ek[i] - ebq) * gk[i]; }
              else { const f32x4 pk = *(const LAS f32x4*)(Pf + k0), gfk = *(const LAS f32x4*)(gf + k0), ek = *(const LAS f32x4*)(Eb + k0), gbk = *(const LAS f32x4*)(gb + k0);
#pragma unroll
                  for (int i = 0; i < 4; ++i) { const int d = lc - (4 * lq + i);
                      fac[i] = d > 0 ? EXPF(pfq - pk[i]) * gfk[i] : (d < 0 ? EXPF(ek[i] - ebq) * gbk[i] : gfk[i] + gbk[i]); } }
              f32x4 gv; gv[0] = bflo(Gt[ct].x); gv[1] = bfhi(Gt[ct].x); gv[2] = bflo(Gt[ct].y); gv[3] = bfhi(Gt[ct].y);
              *(LAS u32x2*)(GLB + q * LDC + k0) = pack4(gv * fac); } }
        WAVE_LDS_FENCE();
        bf16x8 aG[4];
#pragma unroll
        for (int ks = 0; ks < 4; ++ks) aG[ks] = row_frag(GLB, LDC, w * 16, ks * 32, lane);
        float iqf[4], iqb[4];
#pragma unroll
        for (int i = 0; i < 4; ++i) { iqf[i] = itf[w * 16 + 4 * lq + i]; iqb[i] = itb[w * 16 + 4 * lq + i]; }
        WAVE_LDS_FENCE();
        LAS float* OUTW = (LAS float*)(GLB + w * 16 * LDC);
#pragma unroll 1
        for (int pt = 0; pt < 4; ++pt) { f32x4 a1 = {0.f, 0.f, 0.f, 0.f}, af = {0.f, 0.f, 0.f, 0.f}, ab = {0.f, 0.f, 0.f, 0.f};
#pragma unroll
            for (int ks = 0; ks < 4; ++ks) a1 = mfma16(aG[ks], tr_frag(XS, LDX, ks * 32, pt * 16, lane), a1);
#pragma unroll
            for (int ns = 0; ns < 4; ++ns) { af = mfma16(aC[ns], row_frag(STF, LDC, pt * 16, ns * 32, lane), af); ab = mfma16(aC[ns], row_frag(STB, LDC, pt * 16, ns * 32, lane), ab); }
#pragma unroll
            for (int i = 0; i < 4; ++i) OUTW[(4 * lq + i) * (LDC / 2) + pt * 16 + lc] = a1[i] + iqf[i] * af[i] + iqb[i] * ab[i]; }
        WAVE_LDS_FENCE();
        if (h + 1 < 8) { TOUCH(rx[0]); TOUCH(rx[1]); TOUCH(rsf[0]); TOUCH(rsf[1]); TOUCH(rsb[0]); TOUCH(rsb[1]); TOUCH(rdt[0]); TOUCH(rdt[1]); }
        const float dsk = F.pp->in[13][hg]; const float* ng = F.pp->in[14] + hg * 64 + (lane & 7) * 8;
        const f32x4 ng0 = *(const f32x4*)ng, ng1 = *(const f32x4*)(ng + 4);
#pragma unroll
        for (int r = 0; r < 2; ++r) { const int ql = (lane >> 3) + 8 * r, ch = lane & 7; const size_t row = (size_t)(row0 + 16 * w + ql);
            const f32x4 y0 = *(const LAS f32x4*)(OUTW + ql * (LDC / 2) + ch * 8), y1 = *(const LAS f32x4*)(OUTW + ql * (LDC / 2) + ch * 8 + 4);
            f32x4 x0, x1, z0, z1; unpack8(*(const LAS u32x4*)(XS + (16 * w + ql) * LDX + ch * 8), x0, x1); unpack8(r == 0 ? zc0 : zc1, z0, z1);
            f32x4 t0, t1; float ss = 0.f;
#pragma unroll
            for (int i = 0; i < 4; ++i) { t0[i] = (y0[i] + dsk * x0[i]) * siluf_(z0[i]); t1[i] = (y1[i] + dsk * x1[i]) * siluf_(z1[i]); ss += t0[i] * t0[i] + t1[i] * t1[i]; }
            *(u32x4*)(YP + row * 1024 + hg * 64 + ch * 8) = pack8(t0 * ng0, t1 * ng1);
            ss += __shfl_xor(ss, 1); ss += __shfl_xor(ss, 2); ss += __shfl_xor(ss, 4);
            if (ch == 0) SSQ[row * 16 + hg] = ss; }
    }
#undef S3S_LOAD
}

struct MlRegs { u32x4 q[2], k[2], v[4], sf[3], sb[3]; float g[4]; };
DEV void s3v2_ml_load(Frame& F, MlRegs& R, int b, int cc, int hd) {
    const bf16_t* QK = WSP(bf16_t, WS_QK); const bf16_t* V = WSP(bf16_t, WS_V); const float* DTG = WSP(float, WS_DTG);
    int tid_ = F.tid; OPAQUE_V(tid_);
    const int row0 = chunk_row0(b, cc), tid = tid_, lane = tid & 63, w = F.wave;
#pragma unroll
    for (int j = 0; j < 2; ++j) { const int id = tid + NTHR * j; R.q[j] = *(const u32x4*)(QK + um(row0 + (id >> 3), hd * 64 + (id & 7) * 8, 64)); R.k[j] = *(const u32x4*)(QK + um(row0 + (id >> 3), 512 + hd * 64 + (id & 7) * 8, 64)); }
#pragma unroll
    for (int j = 0; j < 4; ++j) { const int id = tid + NTHR * j; R.v[j] = *(const u32x4*)(V + um(row0 + (id >> 4), hd * 128 + (id & 15) * 8, 128)); }
#pragma unroll
    for (int j = 0; j < 3; ++j) { const int id = tid + NTHR * j; if (id < 144 * 8) {
        R.sf[j] = *(const u32x4*)(WSP(bf16_t, WS_STM) + ((size_t)(b * 2 + 0) * NCHT + cc) * STM_CH + (size_t)hd * 9216 + (size_t)id * 8);
        R.sb[j] = *(const u32x4*)(WSP(bf16_t, WS_STM) + ((size_t)(b * 2 + 1) * NCHT + cc) * STM_CH + (size_t)hd * 9216 + (size_t)id * 8); } }
    if (w < 2) { R.g[0] = DTG[(size_t)(row0 + lane) * 64 + 32 + w * 16 + hd]; R.g[1] = DTG[(size_t)(row0 + 64 + lane) * 64 + 32 + w * 16 + hd];
                 R.g[2] = DTG[(size_t)(row0 + lane) * 64 + 32 + w * 16 + 8 + hd]; R.g[3] = DTG[(size_t)(row0 + 64 + lane) * 64 + 32 + w * 16 + 8 + hd]; }
}
DEV void s3v2_ml_item(Frame& F, MlRegs& R, int b, int cc, int hd, bool has_next, int nb, int ncc, int nhd) {
    constexpr int LDQ = 72, LDG = 136, LDV = 144;
    LAS bf16_t* CQ = (LAS bf16_t*)F.lds;
    LAS bf16_t* GLB = CQ + 128 * LDQ;
    LAS bf16_t* XS = GLB + 128 * LDG;
    LAS bf16_t* STF = XS + 128 * LDV;
    LAS bf16_t* STB = STF + 144 * LDQ;
    LAS float* Pf = (LAS float*)(STB + 144 * LDQ); LAS float* Eb = Pf + 128; LAS float* gf = Eb + 128; LAS float* gb = gf + 128; LAS float* itf = gb + 128; LAS float* itb = itf + 128;
    int tid_ = F.tid; OPAQUE_V(tid_);
    const int row0 = chunk_row0(b, cc), w = F.wave, tid = tid_, lane = tid & 63, lq = lane >> 4, lc = lane & 15;
    SYNC();
#pragma unroll
    for (int j = 0; j < 2; ++j) { const int id = tid + NTHR * j; *(LAS u32x4*)(CQ + (id >> 3) * LDQ + (id & 7) * 8) = R.q[j]; *(LAS u32x4*)(GLB + (id >> 3) * LDQ + (id & 7) * 8) = R.k[j]; }
#pragma unroll
    for (int j = 0; j < 4; ++j) { const int id = tid + NTHR * j; *(LAS u32x4*)(XS + (id >> 4) * LDV + (id & 15) * 8) = R.v[j]; }
    if (tid < 256) { const int k = tid >> 1, hf = tid & 1; u32x4 o = {0u, 0u, 0u, 0u}; if (hf == 0) o.x = 0x3F80u; *(LAS u32x4*)(XS + k * LDV + 128 + hf * 8) = o; }
#pragma unroll
    for (int j = 0; j < 3; ++j) { const int id = tid + NTHR * j; if (id < 144 * 8) { *(LAS u32x4*)(STF + (id >> 3) * LDQ + (id & 7) * 8) = R.sf[j]; *(LAS u32x4*)(STB + (id >> 3) * LDQ + (id & 7) * 8) = R.sb[j]; } }
    if (w < 2) { const float ibv = F.pp->in[17][w * 8 + hd], fbv = F.pp->in[18][w * 8 + hd];
        const float a0 = logsigmoidf_(R.g[2] + fbv), a1 = logsigmoidf_(R.g[3] + fbv), g0 = EXPF(R.g[0] + ibv), g1 = EXPF(R.g[1] + ibv);
        const float p0 = wave_incl_scan(a0, lane); const float t0 = __shfl(p0, 63);
        const float p1 = wave_incl_scan(a1, lane) + t0; const float T = __shfl(p1, 63);
        if (w == 0) { Pf[lane] = p0; Pf[64 + lane] = p1; gf[lane] = g0; gf[64 + lane] = g1; itf[lane] = EXPF(p0); itf[64 + lane] = EXPF(p1); }
        else { const float e0 = p0 - a0, e1 = p1 - a1; Eb[lane] = e0; Eb[64 + lane] = e1; gb[lane] = g0; gb[64 + lane] = g1; itb[lane] = EXPF(T - e0); itb[64 + lane] = EXPF(T - e1); } }
    if (has_next) s3v2_ml_load(F, R, nb, ncc, nhd);
    SYNC();
    bf16x8 aC[2];
#pragma unroll
    for (int ns = 0; ns < 2; ++ns) aC[ns] = row_frag(CQ, LDQ, w * 16, ns * 32, lane);
    u32x2 Gt[8];
#pragma unroll
    for (int ct = 0; ct < 8; ++ct) { f32x4 z = {0.f, 0.f, 0.f, 0.f};
#pragma unroll
        for (int ns = 0; ns < 2; ++ns) z = mfma16(row_frag(GLB, LDQ, ct * 16, ns * 32, lane), aC[ns], z);
        Gt[ct] = pack4(z); }
    SYNC();
    u32x4 oc[4];
#pragma unroll
    for (int r = 0; r < 4; ++r) oc[r] = *(const u32x4*)(WSP(bf16_t, WS_O) + um(row0 + 16 * w + (lane >> 4) + 4 * r, hd * 128 + (lane & 15) * 8, 128));
    bf16x8 aG[2][4]; f32x4 rden[2]; float iq[2][4];
#pragma unroll
    for (int dir = 0; dir < 2; ++dir) {
        const LAS float* PE = dir == 0 ? Pf : Eb; const LAS float* gg = dir == 0 ? gf : gb; const LAS float* it = dir == 0 ? itf : itb; const LAS bf16_t* ST = dir == 0 ? STF : STB;
#pragma unroll
        for (int i = 0; i < 4; ++i) iq[dir][i] = it[w * 16 + 4 * lq + i];
        WAVE_LDS_FENCE();
        { const int q = w * 16 + lc; const float peq = PE[q];
#pragma unroll
          for (int ct = 0; ct < 8; ++ct) { const int k0 = ct * 16 + 4 * lq, rel = ct - w; const bool tile_on = dir == 0 ? rel <= 0 : rel >= 0;
              u32x2 o = {0u, 0u};
              if (tile_on) { const f32x4 pek = *(const LAS f32x4*)(PE + k0), gk = *(const LAS f32x4*)(gg + k0); f32x4 fac;
#pragma unroll
                  for (int i = 0; i < 4; ++i) { const int d = lc - (4 * lq + i); const bool on = rel != 0 || (dir == 0 ? d >= 0 : d <= 0);
                      fac[i] = on ? EXPF(dir == 0 ? peq - pek[i] : pek[i] - peq) * gk[i] : 0.f; }
                  f32x4 gv; gv[0] = bflo(Gt[ct].x); gv[1] = bfhi(Gt[ct].x); gv[2] = bflo(Gt[ct].y); gv[3] = bfhi(Gt[ct].y);
                  o = pack4(gv * fac); }
              *(LAS u32x2*)(GLB + q * LDG + k0) = o; } }
        WAVE_LDS_FENCE();
#pragma unroll
        for (int ks = 0; ks < 4; ++ks) aG[dir][ks] = row_frag(GLB, LDG, w * 16, ks * 32, lane);
        f32x4 a1 = {0.f, 0.f, 0.f, 0.f}, a2 = {0.f, 0.f, 0.f, 0.f};
#pragma unroll
        for (int ks = 0; ks < 4; ++ks) a1 = mfma16(aG[dir][ks], tr_frag(XS, LDV, ks * 32, 128, lane), a1);
#pragma unroll
        for (int ns = 0; ns < 2; ++ns) a2 = mfma16(aC[ns], row_frag(ST, LDQ, 128, ns * 32, lane), a2);
#pragma unroll
        for (int i = 0; i < 4; ++i) { const float dv = a1[i] + iq[dir][i] * a2[i]; rden[dir][i] = RCPF(fmaxf(fabsf(__shfl(dv, lane & 48)), 1.0f)); }
    }
    WAVE_LDS_FENCE();
    float ss[4] = {0.f, 0.f, 0.f, 0.f};
#pragma unroll 1
    for (int pt = 0; pt < 8; ++pt) { f32x4 af = {0.f, 0.f, 0.f, 0.f}, ab = {0.f, 0.f, 0.f, 0.f}, sf = {0.f, 0.f, 0.f, 0.f}, sb = {0.f, 0.f, 0.f, 0.f};
#pragma unroll
        for (int ks = 0; ks < 4; ++ks) { const bf16x8 xb = tr_frag(XS, LDV, ks * 32, pt * 16, lane); af = mfma16(aG[0][ks], xb, af); ab = mfma16(aG[1][ks], xb, ab); }
#pragma unroll
        for (int ns = 0; ns < 2; ++ns) { sf = mfma16(aC[ns], row_frag(STF, LDQ, pt * 16, ns * 32, lane), sf); sb = mfma16(aC[ns], row_frag(STB, LDQ, pt * 16, ns * 32, lane), sb); }
#pragma unroll
        for (int i = 0; i < 4; ++i) { const float hv = (af[i] + iq[0][i] * sf[i]) * rden[0][i] + (ab[i] + iq[1][i] * sb[i]) * rden[1][i]; ss[i] += hv * hv;
            GLB[(w * 16 + 4 * lq + i) * LDG + pt * 16 + lc] = (bf16_t)f2bf(hv); } }
    LAS float* rsw = itb + 128 + w * 16;
#pragma unroll
    for (int i = 0; i < 4; ++i) { float sv = ss[i]; sv += __shfl_xor(sv, 1); sv += __shfl_xor(sv, 2); sv += __shfl_xor(sv, 4); sv += __shfl_xor(sv, 8);
        if (lc == 0) rsw[4 * lq + i] = RSQF(sv * (1.f / 128.f) + EPS); }
    WAVE_LDS_FENCE();
    if (has_next) {
#pragma unroll
        for (int j = 0; j < 2; ++j) { TOUCH(R.q[j]); TOUCH(R.k[j]); }
#pragma unroll
        for (int j = 0; j < 4; ++j) TOUCH(R.v[j]);
#pragma unroll
        for (int j = 0; j < 3; ++j) { TOUCH(R.sf[j]); TOUCH(R.sb[j]); }
        TOUCH(R.g[0]); TOUCH(R.g[1]); TOUCH(R.g[2]); TOUCH(R.g[3]); }
    bf16_t* HP = WSP(bf16_t, WS_HP); const float* ng = F.pp->in[19] + hd * 128 + (lane & 15) * 8;
    const f32x4 ng0 = *(const f32x4*)ng, ng1 = *(const f32x4*)(ng + 4);
#pragma unroll
    for (int r = 0; r < 4; ++r) { const int ql = (lane >> 4) + 4 * r, ch = lane & 15; const size_t row = (size_t)(row0 + 16 * w + ql); const float rsq = rsw[ql];
        f32x4 h0, h1, o0, o1; unpack8(*(const LAS u32x4*)(GLB + (w * 16 + ql) * LDG + ch * 8), h0, h1); unpack8(oc[r], o0, o1);
        *(u32x4*)(HP + row * 1024 + hd * 128 + ch * 8) = pack8(h0 * rsq * ng0 * o0, h1 * rsq * ng1 * o1); }
}
DEV void p6v2_outputs(Frame& F) {
    LAS float* aneg_l = (LAS float*)(F.lds + LDS_BYTES - 256);
    if (F.tid < 32) aneg_l[F.tid] = -EXPF(F.pp->in[12][F.tid]);
    SYNC();
    const int nS = BATCH * NCH * 2, nM = BATCH * NCH * 8;
#pragma unroll 1
    for (int it = F.bid; it < nS; it += F.G) { const int b = it / (NCH * 2), r = it % (NCH * 2); s3v2_ssd(F, b, r / 2, r % 2, (const float*)aneg_l); }
    SYNC();
    MlRegs R;
    if (F.bid < nM) { const int it = F.bid; s3v2_ml_load(F, R, it / (NCH * 8), (it % (NCH * 8)) / 8, it % 8);
#pragma unroll
        for (int j = 0; j < 2; ++j) { TOUCH(R.q[j]); TOUCH(R.k[j]); }
#pragma unroll
        for (int j = 0; j < 4; ++j) TOUCH(R.v[j]);
#pragma unroll
        for (int j = 0; j < 3; ++j) { TOUCH(R.sf[j]); TOUCH(R.sb[j]); }
        TOUCH(R.g[0]); TOUCH(R.g[1]); TOUCH(R.g[2]); TOUCH(R.g[3]); }
#pragma unroll 1
    for (int it = F.bid; it < nM; it += F.G) { const int nx = it + F.G; const bool hn = nx < nM;
        s3v2_ml_item(F, R, it / (NCH * 8), (it % (NCH * 8)) / 8, it % 8, hn, nx / (NCH * 8), (nx % (NCH * 8)) / 8, nx % 8); }
    SYNC();
}

template <bool ML> struct S1K { static constexpr int NN = ML ? 64 : 128, LDB = ML ? 80 : 144, NHS = ML ? 1 : 4, PD = ML ? 128 : 64, XC = ML ? 144 : 256, LDXW = ML ? 144 : 272, NQ = ML ? 1 : 2, NXR = ML ? 4 : 8, NBK = ML ? 2 : 4, PPH = ML ? 144 : 64, CPR = NHS * PD / 8; };
template <bool ML> struct S1Regs { u32x4 x[S1K<ML>::NXR]; u32x4 bk[S1K<ML>::NBK]; float g[4]; };
DEV void s1_decode(int code, int& b, int& cc, int& gi) { b = code >> 20; cc = (code >> 8) & 0xfff; gi = code & 0xff; }
template <bool ML> DEV void s1_load(Frame& F, S1Regs<ML>& R, int code, int hq) {
    typedef S1K<ML> K; int b, cc, gi; s1_decode(code, b, cc, gi);
    const bf16_t* XBC = WSP(bf16_t, WS_XBC); const bf16_t* QK = WSP(bf16_t, WS_QK); const bf16_t* V = WSP(bf16_t, WS_V); const float* DTG = WSP(float, WS_DTG);
    int tid_ = F.tid; OPAQUE_V(tid_); const int tid = tid_, lane = tid & 63, w = F.wave, row0 = chunk_row0(b, cc);
    const bool isctx = cc >= NCH; const int seg0 = NLAT + b * CTXL, kseg0 = (cc - NCH) * CHUNK;
    if (ML || !isctx) {
#pragma unroll
        for (int j = 0; j < K::NXR; ++j) { const int id = tid + NTHR * j, rr = row0 + id / K::CPR, c8 = (id % K::CPR) * 8;
            R.x[j] = ML ? *(const u32x4*)(V + um(rr, gi * 128 + c8, 128)) : *(const u32x4*)(XBC + um_xbc(rr, (gi * 8 + hq * 4) * 64 + c8)); }
    } else { static_assert(NTHR % K::CPR == 0, "a thread's chunks share their columns");
        const int col = (gi * 8 + hq * 4) * 64 + (tid % K::CPR) * 8; CtxW cwv; ctx_conv_prep(cwv, F.pp->in[9], F.pp->in[10], 1536, col);
#pragma unroll
        for (int j = 0; j < K::NXR; ++j) { const int id = tid + NTHR * j; R.x[j] = ctx_conv_chunk(cwv, XBC, 1536, seg0, kseg0 + id / K::CPR, col); } }
    if (hq == 0) { const int ldb = ML ? 1024 : 1536;
        if (!isctx) {
#pragma unroll
            for (int j = 0; j < K::NBK; ++j) { const int id = tid + NTHR * j, k = id / (K::NN / 8), n8 = id % (K::NN / 8);
                R.bk[j] = ML ? *(const u32x4*)(QK + um(row0 + k, 512 + gi * 64 + n8 * 8, 64)) : *(const u32x4*)(XBC + um_xbc(row0 + k, 1024 + gi * 128 + n8 * 8)); }
        } else { static_assert(NTHR % (K::NN / 8) == 0, "a thread's chunks share their columns");
            const int col = (ML ? 512 + gi * 64 : 1024 + gi * 128) + (tid % (K::NN / 8)) * 8; CtxW cwv; ctx_conv_prep(cwv, ML ? F.pp->in[15] : F.pp->in[9], ML ? F.pp->in[16] : F.pp->in[10], ldb, col);
#pragma unroll
            for (int j = 0; j < K::NBK; ++j) { const int id = tid + NTHR * j; R.bk[j] = ctx_conv_chunk(cwv, ML ? QK : XBC, ldb, seg0, kseg0 + id / (K::NN / 8), col); } } }
    if (!ML) { const int dir = w >> 2, hg = gi * 8 + hq * 4 + (w & 3);
        R.g[0] = DTG[(size_t)(row0 + lane) * 64 + dir * 16 + hg]; R.g[1] = DTG[(size_t)(row0 + 64 + lane) * 64 + dir * 16 + hg]; }
    else if (w < 2) { R.g[0] = DTG[(size_t)(row0 + lane) * 64 + 32 + w * 16 + gi]; R.g[1] = DTG[(size_t)(row0 + 64 + lane) * 64 + 32 + w * 16 + gi];
                      R.g[2] = DTG[(size_t)(row0 + lane) * 64 + 32 + w * 16 + 8 + gi]; R.g[3] = DTG[(size_t)(row0 + 64 + lane) * 64 + 32 + w * 16 + 8 + gi]; }
}
template <bool ML> DEV void s1_stage(Frame& F, S1Regs<ML>& R, int code, int hq, bool has_next, int ncode, int nhq, const float* aneg) {
    typedef S1K<ML> K; int b, cc, gi; s1_decode(code, b, cc, gi);
    LAS bf16_t* BKN = (LAS bf16_t*)F.lds;
    LAS bf16_t* XW = BKN + 128 * K::LDB;
    LAS float* wl = (LAS float*)(XW + 128 * K::LDXW);
    int tid_ = F.tid; OPAQUE_V(tid_); const int tid = tid_, lane = tid & 63, w = F.wave;
    SYNC();
    if (hq == 0) {
#pragma unroll
        for (int j = 0; j < K::NBK; ++j) { const int id = tid + NTHR * j; *(LAS u32x4*)(BKN + (id / (K::NN / 8)) * K::LDB + (id % (K::NN / 8)) * 8) = R.bk[j]; } }
    u32x4 xc[K::NXR];
#pragma unroll
    for (int j = 0; j < K::NXR; ++j) xc[j] = R.x[j];
    float gc[4];
#pragma unroll
    for (int j = 0; j < 4; ++j) gc[j] = R.g[j];
    if (has_next) s1_load<ML>(F, R, ncode, nhq);
    if (!ML || w < 2) { const int dir = ML ? w : (w >> 2), hl = ML ? 0 : (w & 3), hg = ML ? gi : gi * 8 + hq * 4 + hl;
        float a0, a1, g0, g1;
        if (!ML) { const float db = F.pp->in[11][dir * 16 + hg], an = aneg[dir * 16 + hg]; g0 = softplusf_(gc[0] + db); g1 = softplusf_(gc[1] + db); a0 = g0 * an; a1 = g1 * an; }
        else { const float ibv = F.pp->in[17][dir * 8 + hg], fbv = F.pp->in[18][dir * 8 + hg]; g0 = EXPF(gc[0] + ibv); g1 = EXPF(gc[1] + ibv); a0 = logsigmoidf_(gc[2] + fbv); a1 = logsigmoidf_(gc[3] + fbv); }
        const float p0 = wave_incl_scan(a0, lane); const float t0 = __shfl(p0, 63);
        const float p1 = wave_incl_scan(a1, lane) + t0; const float T = __shfl(p1, 63);
        float w0, w1;
        if (dir == 0) { w0 = EXPF(T - p0) * g0; w1 = EXPF(T - p1) * g1; } else { w0 = EXPF(p0 - a0) * g0; w1 = EXPF(p1 - a1) * g1; }
        wl[(dir * K::NHS + hl) * 128 + lane] = w0; wl[(dir * K::NHS + hl) * 128 + 64 + lane] = w1;
        if (lane == 0) { float* dec = ML ? WSP(float, WS_DECM) + ((size_t)(b * 2 + dir) * NCHT + cc) * 8 + hg : WSP(float, WS_DECS) + ((size_t)(b * 2 + dir) * NCHT + cc) * 16 + hg; *dec = EXPF(T); } }
    SYNC();
#pragma unroll 1
    for (int dir = 0; dir < 2; ++dir) {
        if (dir == 1) SYNC();
#pragma unroll
        for (int j = 0; j < K::NXR; ++j) { const int id = tid + NTHR * j, k = id / K::CPR, c8 = id % K::CPR; const float wk = wl[(dir * K::NHS + (c8 * 8) / K::PD) * 128 + k];
            f32x4 v0, v1; unpack8(xc[j], v0, v1); *(LAS u32x4*)(XW + k * K::LDXW + c8 * 8) = pack8(v0 * wk, v1 * wk); }
        if (ML) { if (tid < 256) { const int k = tid >> 1, hf = tid & 1; u32x4 o = {0u, 0u, 0u, 0u}; if (hf == 0) o.x = f2bf(wl[dir * 128 + k]); *(LAS u32x4*)(XW + k * K::LDXW + 128 + hf * 8) = o; } }
        SYNC();
        if (dir == 1 && has_next) {
#pragma unroll
            for (int j = 0; j < K::NXR; ++j) TOUCH(R.x[j]);
#pragma unroll
            for (int j = 0; j < K::NBK; ++j) TOUCH(R.bk[j]);
            TOUCH(R.g[0]); TOUCH(R.g[1]); TOUCH(R.g[2]); TOUCH(R.g[3]); }
        constexpr int RT = K::NN / 16, CT = K::XC / 16;
        const int ct0 = w, ct1 = w + 8; const bool two = ct1 < CT;
        if (ct0 < CT) {
            bf16x8 bx0[4], bx1[4];
#pragma unroll
            for (int ks = 0; ks < 4; ++ks) { bx0[ks] = tr_frag(XW, K::LDXW, ks * 32, ct0 * 16, lane); bx1[ks] = two ? tr_frag(XW, K::LDXW, ks * 32, ct1 * 16, lane) : bx0[ks]; }
#pragma unroll 1
            for (int u = 0; u < RT / 2; ++u) {
                bf16x8 a0[4], a1[4];
#pragma unroll
                for (int ks = 0; ks < 4; ++ks) { a0[ks] = tr_frag8(BKN, K::LDB, ks * 32, u * 32, lane); a1[ks] = tr_frag8(BKN, K::LDB, ks * 32, u * 32 + 4, lane); }
                f32x4 c00 = {0.f, 0.f, 0.f, 0.f}, c01 = {0.f, 0.f, 0.f, 0.f}, c10 = {0.f, 0.f, 0.f, 0.f}, c11 = {0.f, 0.f, 0.f, 0.f};
#pragma unroll
                for (int ks = 0; ks < 4; ++ks) { c00 = mfma16(a0[ks], bx0[ks], c00); c01 = mfma16(a1[ks], bx0[ks], c01); }
                if (two) {
#pragma unroll
                    for (int ks = 0; ks < 4; ++ks) { c10 = mfma16(a0[ks], bx1[ks], c10); c11 = mfma16(a1[ks], bx1[ks], c11); } }
#pragma unroll
                for (int cs = 0; cs < 2; ++cs) { if (cs == 1 && !two) break;
                    const int pg = (cs ? ct1 : ct0) * 16 + (lane & 15), hl = pg / K::PPH, p = pg % K::PPH, hg = ML ? gi : gi * 8 + hq * 4 + hl, n = u * 32 + 8 * (lane >> 4);
                    bf16_t* dst = ML ? WSP(bf16_t, WS_STM) + ((size_t)(b * 2 + dir) * NCHT + cc) * STM_CH + ((size_t)hg * 144 + p) * 64 + n
                                     : WSP(bf16_t, WS_STS) + ((size_t)(b * 2 + dir) * NCHT + cc) * STS_CH + ((size_t)hg * 64 + p) * 128 + n;
                    *(u32x4*)dst = cs ? pack8(c10, c11) : pack8(c00, c01); }
            }
        }
    }
}
template <bool ML> DEV int s1_build_list(Frame& F, LAS int* list) {
    const int GPB = ML ? 8 : 2, nL = BATCH * NCH * GPB, nC = BATCH * NCHC * GPB, skew = ML ? (BATCH * NCHC * 2) % F.G : 0;
    int n = 0;
    for (int it = F.bid; it < nL; it += F.G) { const int b = it / (NCH * GPB), r = it % (NCH * GPB); if (F.tid == 0) list[n] = (b << 20) | ((r / GPB) << 8) | (r % GPB); ++n; }
    for (int it = ((F.G - 1 - F.bid) + F.G - skew) % F.G; it < nC; it += F.G) { const int b = it / (NCHC * GPB), r = it % (NCHC * GPB); if (F.tid == 0) list[n] = (b << 20) | ((NCH + r / GPB) << 8) | (r % GPB); ++n; }
    return n;
}
template <bool ML> DEV void s1_run(Frame& F, const float* aneg, LAS int* list) {
    typedef S1K<ML> K;
    const int n = s1_build_list<ML>(F, list);
    SYNC();
    const int nst = n * K::NQ;
    S1Regs<ML> R;
    if (nst > 0) { s1_load<ML>(F, R, list[0], 0);
#pragma unroll
        for (int j = 0; j < K::NXR; ++j) TOUCH(R.x[j]);
#pragma unroll
        for (int j = 0; j < K::NBK; ++j) TOUCH(R.bk[j]);
        TOUCH(R.g[0]); TOUCH(R.g[1]); TOUCH(R.g[2]); TOUCH(R.g[3]); }
#pragma unroll 1
    for (int st = 0; st < nst; ++st) { const int nx = st + 1; const bool hn = nx < nst;
        s1_stage<ML>(F, R, list[st / K::NQ], st % K::NQ, hn, hn ? list[nx / K::NQ] : 0, nx % K::NQ, aneg); }
    SYNC();
}
DEV void p4v2_local_states(Frame& F) {
    LAS float* aneg_l = (LAS float*)(F.lds + LDS_BYTES - 256);
    LAS int* list = (LAS int*)(F.lds + LDS_BYTES - 1024);
    if (F.tid < 32) aneg_l[F.tid] = -EXPF(F.pp->in[12][F.tid]);
    SYNC();
    s1_run<false>(F, (const float*)aneg_l, list);
    s1_run<true>(F, (const float*)aneg_l, list);
}

DEV void p12_route(Frame& F) {
    const float* LOGIT = WSP(float, WS_LOG); const float* rb = F.pp->in[24];
    int* ae = WSP(int, WS_ASGE); int* ar = WSP(int, WS_ASGR); float* aw = WSP(float, WS_ASGW);
    constexpr int LDT = NEXP + 1;
    LAS int* cntL = (LAS int*)(F.lds + 2 * 64 * LDT * 4);
    for (int e = F.tid; e < NEXP; e += NTHR) cntL[e] = 0;
    SYNC();
    constexpr int GS = NEXP / 8;
    const float NEG = -3.0e38f;
    for (int t = F.bid * 128 + F.tid; F.tid < 128 && t < NLAT; t += F.G * 128) {
        LAS float* tile = (LAS float*)F.lds + F.wave * (64 * LDT);
        { const int tw = t - F.lane;
          WAVE_LDS_FENCE();
          static_assert(NEXP <= 256, "one 16-byte piece per lane and row");
#pragma unroll 1
          for (int r0 = 0; r0 < 64; r0 += 16) { f32x4 v[16];
              const int c = F.lane * 4;
              if (c < NEXP) {
#pragma unroll
                  for (int r = 0; r < 16; ++r) v[r] = *(const f32x4*)(LOGIT + (size_t)(tw + r0 + r) * NEXP + c);
#pragma unroll
                  for (int r = 0; r < 16; ++r) { LAS float* d = tile + (r0 + r) * LDT + c; d[0] = v[r].x; d[1] = v[r].y; d[2] = v[r].z; d[3] = v[r].w; } } }
          WAVE_LDS_FENCE(); }
        const LAS float* lg = tile + F.lane * LDT;
        float gs[8];
#pragma unroll
        for (int g = 0; g < 8; ++g) { float m1 = NEG, m2 = NEG;
#pragma unroll 4
            for (int j = 0; j < GS; ++j) { const float v = sigmoidf_(lg[g * GS + j]) + rb[g * GS + j]; if (v > m1) { m2 = m1; m1 = v; } else if (v > m2) m2 = v; }
            gs[g] = m1 + m2; }
        unsigned selmask = 0u;
#pragma unroll
        for (int g = 0; g < 8; ++g) { int rank = 0;
#pragma unroll
            for (int gp = 0; gp < 8; ++gp) rank += (gs[gp] > gs[g] || (gs[gp] == gs[g] && gp < g)) ? 1 : 0;
            if (rank < TOPKG) selmask |= 1u << g; }
        float tv[8]; int ti[8];
#pragma unroll
        for (int i = 0; i < 8; ++i) { tv[i] = NEG; ti[i] = 0; }
        unsigned smk = selmask;
#pragma unroll 1
        for (int sg = 0; sg < TOPKG; ++sg) { const int g = __builtin_ctz(smk); smk &= smk - 1u;
#pragma unroll 2
            for (int j = 0; j < GS; ++j) { const int e = g * GS + j; float cv = sigmoidf_(lg[e]) + rb[e]; int ce = e;
#pragma unroll
                for (int i = 0; i < 8; ++i) { const bool gtv = cv > tv[i]; const float ov = tv[i]; const int oi = ti[i];
                    tv[i] = gtv ? cv : ov; ti[i] = gtv ? ce : oi; cv = gtv ? ov : cv; ce = gtv ? oi : ce; } }
        }
        float sc[8], ssum = 0.f;
#pragma unroll
        for (int i = 0; i < 8; ++i) { sc[i] = sigmoidf_(lg[ti[i]]); ssum += sc[i]; }
        const float inv = 2.5f / ssum;
#pragma unroll
        for (int i = 0; i < 8; ++i) { const int rk = ATOMIC_ADD_LDS(&cntL[ti[i]], 1); const int a = t * TOPK + i; ae[a] = ti[i]; ar[a] = rk; aw[a] = sc[i] * inv; }
    }
    SYNC();
    int* cm = WSP(int, WS_CMAT) + (size_t)F.bid * NEXP;
    for (int e = F.tid; e < NEXP; e += NTHR) cm[e] = cntL[e];
}
DEV void p13_slots(Frame& F) {
    int* ctl = WSP(int, WS_CTL); const int* cmat = WSP(int, WS_CMAT);
    LAS int* cl = (LAS int*)F.lds; LAS int* tb = cl + NEXP; LAS int* pl = tb + NEXP + 1;
    for (int e = F.tid; e < NEXP; e += NTHR) { int tot = 0, pre = 0;
        for (int b = 0; b < F.G; ++b) { const int v = cmat[(size_t)b * NEXP + e]; tot += v; pre += b < F.bid ? v : 0; }
        cl[e] = tot; pl[e] = pre; }
    SYNC();
    if (F.wave == 0) {
        int loc[EPL], sum = 0;
#pragma unroll
        for (int j = 0; j < EPL; ++j) { loc[j] = (cl[F.lane * EPL + j] + 255) >> 8; sum += loc[j]; }
        int inc = sum;
#pragma unroll
        for (int d = 1; d < 64; d <<= 1) { const int t = __shfl_up(inc, d); if (F.lane >= d) inc += t; }
        int run = inc - sum;
#pragma unroll
        for (int j = 0; j < EPL; ++j) { tb[F.lane * EPL + j] = run; run += loc[j]; }
        if (F.lane == 63) tb[NEXP] = run;
    }
    SYNC();
    const int* ae = WSP(int, WS_ASGE); const int* ar = WSP(int, WS_ASGR); const float* aw = WSP(float, WS_ASGW);
    int* stok = WSP(int, WS_STOK); int* sdst = WSP(int, WS_SDST); float* sw = WSP(float, WS_SW); int* texp = WSP(int, WS_TEXP);
    for (int t0 = F.bid * 128; t0 < NLAT; t0 += F.G * 128)
        for (int i = F.tid; i < 128 * TOPK; i += NTHR) { const int a = t0 * TOPK + i; if (a < NASG) { const int e = ae[a];
            const int slot = tb[e] * 256 + pl[e] + ar[a]; stok[slot] = a / TOPK; sdst[slot] = a; sw[slot] = aw[a]; } }
    for (int e = F.bid; e < NEXP; e += F.G) {
        for (int sl = tb[e] * 256 + cl[e] + F.tid; sl < tb[e + 1] * 256; sl += NTHR) { stok[sl] = 0; sdst[sl] = -1; sw[sl] = 0.f; }
        for (int t = tb[e] + F.tid; t < tb[e + 1]; t += NTHR) texp[t] = e;
    }
    if (F.bid == 0 && F.tid == 0) { ctl[1024] = tb[NEXP]; }
}
DEV void p_final(Frame& F) {
    const float* mod = WSP(float, WS_MOD); const bf16_t* Y = WSP(bf16_t, WS_Y); const bf16_t* YS = WSP(bf16_t, WS_YS); const float* gf = F.pp->in[31];
    const int gw = F.bid * 8 + F.wave, NGW = F.G * 8, lane = F.lane;
    for (int t = gw; t < NLAT; t += NGW) {
        const float* gate = mod + (t / SEQ) * 6144 + 5 * 1024;
        u32x4 yr[2][TOPK + 1];
#pragma unroll
        for (int j = 0; j < 2; ++j) {
#pragma unroll
            for (int k = 0; k < TOPK; ++k) yr[j][k] = *((const u32x4*)(Y + (size_t)(t * TOPK + k) * 1024) + lane + 64 * j);
            yr[j][TOPK] = *((const u32x4*)(YS + (size_t)t * 1024) + lane + 64 * j); }
        f32x4 v[2][2]; float ssq = 0.f;
#pragma unroll
        for (int j = 0; j < 2; ++j) { f32x4 a0 = {0.f, 0.f, 0.f, 0.f}, a1 = {0.f, 0.f, 0.f, 0.f};
#pragma unroll
            for (int k = 0; k <= TOPK; ++k) { f32x4 p0, p1; unpack8(yr[j][k], p0, p1); a0 += p0; a1 += p1; }
            const f32x4* xr = (const f32x4*)(F.out + (size_t)t * DM) + 2 * lane + 128 * j; const f32x4* gr = (const f32x4*)gate + 2 * lane + 128 * j;
            v[j][0] = xr[0] + gr[0] * a0; v[j][1] = xr[1] + gr[1] * a1;
#pragma unroll
            for (int h = 0; h < 2; ++h) ssq += (v[j][h].x * v[j][h].x + v[j][h].y * v[j][h].y) + (v[j][h].z * v[j][h].z + v[j][h].w * v[j][h].w); }
        const float rstd = RSQF(wave_sum(ssq) * (1.f / DM) + EPS);
#pragma unroll
        for (int j = 0; j < 2; ++j) { f32x4* orow = (f32x4*)(F.out + (size_t)t * DM) + 2 * lane + 128 * j; const f32x4* gg = (const f32x4*)gf + 2 * lane + 128 * j;
            orow[0] = v[j][0] * rstd * gg[0]; orow[1] = v[j][1] * rstd * gg[1]; }
    }
}

#ifndef HOST_EMU
#define XB_TMO      128
#define XB_XCNT(j)  (256  + 64 * (j))
#define XB_XSUB(j)  (1280 + 64 * (j))
#define XB_XGEN(j)  (2304 + 64 * (j))
#define XB_TOP      3328
#define XB_TOPGEN   3392
#define XCD_BAR_WORDS 3456
#define XB_SPIN_CAP (1u << 18)
__device__ __forceinline__ unsigned xb_ld(unsigned* p)              { return __hip_atomic_load(p, __ATOMIC_RELAXED, __HIP_MEMORY_SCOPE_AGENT); }
__device__ __forceinline__ unsigned xb_add(unsigned* p, unsigned v) { return __hip_atomic_fetch_add(p, v, __ATOMIC_RELAXED, __HIP_MEMORY_SCOPE_AGENT); }
__device__ __forceinline__ unsigned xb_xcc_id() { return (unsigned)__builtin_amdgcn_s_getreg((3 << 11) | 20) & 0xFu; }
#define XB_SPIN(cond, bar) do { unsigned _sp = 0; while (cond) { __builtin_amdgcn_s_sleep(1); \
    if ((++_sp & 255u) == 0u) { if (xb_ld(&(bar)[XB_TMO])) break; if (_sp > XB_SPIN_CAP) { atomicAdd(&(bar)[XB_TMO], 1u); break; } } } } while (0)
struct XcdBarrier { unsigned* bar; unsigned x; volatile LAS unsigned* st; };
__device__ __forceinline__ XcdBarrier xcd_barrier_post(unsigned* bar, volatile LAS unsigned* st) {
    XcdBarrier b; b.bar = bar; b.x = xb_xcc_id(); b.st = st;
    if (threadIdx.x == 0) (void)xb_add(&bar[XB_XCNT(b.x)], 1u);
    return b;
}
__device__ __forceinline__ void xcd_barrier_complete(unsigned* bar, unsigned x, unsigned& nloc, unsigned& nx) {
    const unsigned G = gridDim.x * gridDim.y * gridDim.z;
    unsigned sum, cnt, mine, sp = 0u;
    for (;;) {
        sum = 0u; cnt = 0u; mine = 0u;
#pragma unroll
        for (unsigned j = 0; j < 16; ++j) { const unsigned c = xb_ld(&bar[XB_XCNT(j)]); sum += c; cnt += (c > 0u) ? 1u : 0u; mine = (j == x) ? c : mine; }
        if (sum == G) break;
        __builtin_amdgcn_s_sleep(1);
        if ((++sp & 255u) == 0u) { if (xb_ld(&bar[XB_TMO])) break; if (sp > XB_SPIN_CAP) { atomicAdd(&bar[XB_TMO], 1u); break; } }
    }
    nloc = mine > 0u ? mine : 1u; nx = cnt > 0u ? cnt : 1u;
}
__device__ __forceinline__ void xcd_barrier(const XcdBarrier& b) {
    asm volatile("s_waitcnt vmcnt(0)" ::: "memory");
    __syncthreads();
    if (threadIdx.x == 0) {
        unsigned* bar = b.bar;
        __builtin_amdgcn_s_waitcnt(0);
        unsigned nloc = b.st[0], nx = b.st[1];
        if (nloc == 0u) { xcd_barrier_complete(bar, b.x, nloc, nx); b.st[0] = nloc; b.st[1] = nx; }
        const unsigned old = xb_add(&bar[XB_XSUB(b.x)], 1u);
        const unsigned gen = old / nloc;
        if (old + 1u == (gen + 1u) * nloc) {
            __builtin_amdgcn_fence(__ATOMIC_RELEASE, "agent");
            asm volatile("s_waitcnt vmcnt(0)" ::: "memory");
            const unsigned og = xb_add(&bar[XB_TOP], 1u);
            const unsigned tg = og / nx;
            if (og + 1u == (tg + 1u) * nx) xb_add(&bar[XB_TOPGEN], 1u);
            else XB_SPIN(xb_ld(&bar[XB_TOPGEN]) == tg, bar);
            __builtin_amdgcn_fence(__ATOMIC_ACQUIRE, "agent");
            xb_add(&bar[XB_XGEN(b.x)], 1u);
            asm volatile("s_waitcnt vmcnt(0)" ::: "memory");
        } else {
            XB_SPIN(xb_ld(&bar[XB_XGEN(b.x)]) == gen, bar);
            __builtin_amdgcn_fence(__ATOMIC_ACQUIRE, "agent");
            asm volatile("s_waitcnt vmcnt(0)" ::: "memory");
        }
    }
    __syncthreads();
}
#endif

#ifndef HOST_EMU
template <class T> __device__ __forceinline__ T* uni_ptr(T* p) { const unsigned long long v = (unsigned long long)p; const unsigned lo = __builtin_amdgcn_readfirstlane((unsigned)v), hi = __builtin_amdgcn_readfirstlane((unsigned)(v >> 32));
    typedef __attribute__((address_space(1))) T GT; GT* g = (GT*)(((unsigned long long)hi << 32) | lo); return (T*)g; }
#endif
#ifndef HOST_EMU
constexpr int WS_BAR_OFF = 16384;
constexpr int LDS_BARST = LDS_BYTES - 64;
#ifndef TPROBE_LO
#define TPROBE_LO -2
#define TPROBE_HI -2
#define TPROBE_MUL 0
#endif
__global__ void __launch_bounds__(NTHR, 2) fwd_megakernel(Params prm) {
    extern __shared__ __attribute__((aligned(16))) unsigned char lds_raw[];
    if (threadIdx.x < 4) ((LAS unsigned*)((LAS unsigned char*)lds_raw + LDS_BARST))[threadIdx.x] = 0u;
    __syncthreads();
    XcdBarrier gbar = xcd_barrier_post((unsigned*)(prm.ws + WS_CTL + WS_BAR_OFF), (volatile LAS unsigned*)((LAS unsigned char*)lds_raw + LDS_BARST));
    unsigned long long tp0 = 0ull, tp1 = 0ull;
    if (TPROBE_LO == 0) tp0 = __builtin_amdgcn_s_memrealtime();
#define GRID_SYNC() xcd_barrier(gbar)
#define PROBE_END(k) do { if ((k) == TPROBE_LO - 1) tp0 = __builtin_amdgcn_s_memrealtime(); if ((k) == TPROBE_HI) tp1 = __builtin_amdgcn_s_memrealtime(); } while (0)
#else
void fwd_megakernel(Params prm) {
    unsigned char* lds_raw = emu_lds();
#define GRID_SYNC() do {} while (0)
#define PROBE_END(k) do {} while (0)
#endif
    Frame F;
    F.lds = (LAS unsigned char*)lds_raw; F.tid = TID; F.lane = F.tid & 63; F.wave = RFL(F.tid >> 6); F.G = NBLK; F.bid = BID;
    F.pp = &prm;
    F.out = prm.out; F.ws = prm.ws;
    const int lo = prm.ph_lo, hi = prm.ph_hi;
#ifndef PH_MASK
#define PH_MASK 0xFFFFFFu
#endif
#define IN(k) ((((PH_MASK) >> (k)) & 1u) && lo <= (k) && (k) < hi)
#ifndef HOST_EMU
#define FRESH() do { int t_ = threadIdx.x; OPAQUE_V(t_); F.tid = t_; F.lane = t_ & 63; F.wave = __builtin_amdgcn_readfirstlane(t_ >> 6); \
        F.ws = uni_ptr(prm.ws); F.out = uni_ptr(prm.out); } while (0)
#else
#define FRESH() do {} while (0)
#endif
#define SEAM(k) do { if (IN(k) && IN((k) + 1)) GRID_SYNC(); PROBE_END(k); } while (0)
#ifndef HOST_EMU
#define OPAQUE_WS() do { unsigned char* t_ = prm.ws; asm volatile("" : "+s"(t_)); F.ws = t_; float* o_ = prm.out; asm volatile("" : "+s"(o_)); F.out = o_; } while (0)
#else
#define OPAQUE_WS() do {} while (0)
#endif
    if (IN(0)) { FRESH(); p0_small(F); } SEAM(0);
    if (IN(1)) { FRESH(); p1_xn(F); p0_weights(F); } SEAM(1);
    if (IN(2)) { FRESH(); pg8::Gemm g{WSP(bf16_t, WS_XN), WSP(bf16_t, WS_WIN), NROWS, NIN, 1024}; pg8::StaticOrder S; S.init(NROWS, NIN, F.G, F.bid);
        EpiInProj E{WSP(bf16_t, WS_Z), WSP(bf16_t, WS_XBC), WSP(bf16_t, WS_QK), WSP(bf16_t, WS_V), WSP(bf16_t, WS_O), WSP(bf16_t, WS_MG), WSP(float, WS_DTG), F.pp->in[9], F.pp->in[10], F.pp->in[15], F.pp->in[16], F.lds + pg8::STAGE_BYTES};
        pg8::gemm_phase<EpiInProj, pg8::StaticOrder>(F.lds, g, S, E); } SEAM(2);
    if (IN(4)) { FRESH(); p4v2_local_states(F); } SEAM(4);
    if (IN(5)) { FRESH(); p5_scan(F); } SEAM(5);
    if (IN(6)) { FRESH(); p6v2_outputs(F); } SEAM(6);
    if (IN(7)) { FRESH(); pg8::Gemm g{WSP(bf16_t, WS_YPRE), WSP(bf16_t, WS_WSO), NLAT, 1024, 1024}; pg8::StaticOrder S; S.init(NLAT, 1024, F.G, F.bid);
        EpiG1 E{WSP(bf16_t, WS_M1), WSP(bf16_t, WS_MG), WSP(float, WS_SSQ)}; pg8::gemm_phase<EpiG1, pg8::StaticOrder>(F.lds, g, S, E);
        FRESH(); pg8::Gemm g2{WSP(bf16_t, WS_HP), WSP(bf16_t, WS_WMO), NLAT, 1024, 1024};
        EpiG2 E2{WSP(bf16_t, WS_MERGED), WSP(bf16_t, WS_M1), WSP(bf16_t, WS_MG)}; pg8::gemm_phase<EpiG2, pg8::StaticOrder>(F.lds, g2, S, E2); } SEAM(7);
    if (IN(9)) { FRESH(); pg8::Gemm g{WSP(bf16_t, WS_MERGED), WSP(bf16_t, WS_WOUT), NLAT, 1024, 1024}; pg8::StaticOrder S; S.init(NLAT, 1024, F.G, F.bid);
        EpiG3 E{F.pp->in[0], F.out, WSP(float, WS_MOD)}; pg8::gemm_phase<EpiG3, pg8::StaticOrder>(F.lds, g, S, E); } SEAM(9);
    if (IN(10)) { FRESH(); p10_xn2(F); p_expert_weights(F); } SEAM(10);
    if (IN(11)) { FRESH(); pg8::Gemm g{WSP(bf16_t, WS_XN), WSP(bf16_t, WS_WRS), NLAT, 768, 1024}; pg8::StaticOrder S; S.init(NLAT, 768, F.G, F.bid);
        EpiRS E{WSP(float, WS_LOG), WSP(bf16_t, WS_HS)}; pg8::gemm_phase<EpiRS, pg8::StaticOrder>(F.lds, g, S, E); } SEAM(11);
    if (IN(12)) { FRESH(); p12_route(F); } SEAM(12);
    if (IN(13)) { FRESH(); p13_slots(F); } SEAM(13);
    if (IN(14)) { FRESH(); const int ntl = WSP(int, WS_CTL)[1024];
        pg8::Gemm g{WSP(bf16_t, WS_XN), WSP(bf16_t, WS_W1T), NLAT, 512, 1024};
        pg8::ExpertOrder<true> S{0, ntl, 2, F.G, F.bid, WSP(int, WS_TEXP), 0, (size_t)512 * 1024, WSP(int, WS_STOK)};
        EpiX1 E{WSP(bf16_t, WS_H)}; pg8::gemm_phase<EpiX1, pg8::ExpertOrder<true>>(F.lds, g, S, E); } SEAM(14);
    if (IN(15)) { FRESH(); const int ntl = WSP(int, WS_CTL)[1024];
        pg8::Gemm g{WSP(bf16_t, WS_H), WSP(bf16_t, WS_W2T), MAXSLOT, 1024, 256};
        pg8::ExpertOrder<false> S{0, ntl, 4, F.G, F.bid, WSP(int, WS_TEXP), 0, (size_t)1024 * 256, nullptr};
        EpiX2 E{WSP(bf16_t, WS_Y), WSP(int, WS_SDST), WSP(float, WS_SW)}; pg8::gemm_phase<EpiX2, pg8::ExpertOrder<false>>(F.lds, g, S, E);
        FRESH();
        pg8::Gemm g2{WSP(bf16_t, WS_HS), WSP(bf16_t, WS_WSD), NLAT, 1024, 256}; pg8::StaticOrder S2; S2.init(NLAT, 1024, F.G, F.bid);
        EpiSD E2{WSP(bf16_t, WS_YS)}; pg8::gemm_phase<EpiSD, pg8::StaticOrder>(F.lds, g2, S2, E2); } SEAM(15);
    if (IN(16)) { FRESH(); p_final(F); }
#ifndef HOST_EMU
    if (TPROBE_MUL > 0) { asm volatile("s_waitcnt vmcnt(0)" ::: "memory"); __syncthreads(); PROBE_END(16);
        if (blockIdx.x == 0 && threadIdx.x == 0) { const unsigned long long t0 = __builtin_amdgcn_s_memrealtime(), want = (tp0 != 0ull && tp1 > tp0 && tp1 - tp0 < 2000000ull) ? (unsigned long long)TPROBE_MUL * (tp1 - tp0) : 0ull;
            while (__builtin_amdgcn_s_memrealtime() - t0 < want) __builtin_amdgcn_s_sleep(8); } }
#endif
#undef IN
#undef SEAM
}

#ifndef HOST_EMU
extern "C" void kernel_launch(void* const* d_in, const int* in_sizes, int n_in, void* d_out, int out_size, void* d_ws, size_t ws_size, hipStream_t stream) {
    static int grid = 0;
    if (grid == 0) {
        if (n_in != 32 || out_size != NLAT * DM || ws_size < WS_NEED) { fprintf(stderr, "kernel_launch: unexpected problem (n_in %d out %d ws %zu need %zu)\n", n_in, out_size, ws_size, (size_t)WS_NEED); grid = -1; return; }
        int dev = 0, cus = 0, per_cu = 0;
        hipGetDevice(&dev); hipDeviceGetAttribute(&cus, hipDeviceAttributeMultiprocessorCount, dev);
        hipFuncSetAttribute((const void*)fwd_megakernel, hipFuncAttributeMaxDynamicSharedMemorySize, LDS_BYTES);
        hipOccupancyMaxActiveBlocksPerMultiprocessor(&per_cu, (const void*)fwd_megakernel, NTHR, LDS_BYTES);
        if (per_cu < 1) { fprintf(stderr, "kernel_launch: occupancy query says %d blocks per CU\n", per_cu); per_cu = 1; }
        (void)hipGetLastError();
        grid = cus;
    }
    if (grid < 0) return;
    hipMemsetAsync((char*)d_ws + WS_CTL, 0, CTL_BYTES, stream);
    Params p{};
    for (int i = 0; i < 32; ++i) p.in[i] = (const float*)d_in[i];
    p.out = (float*)d_out; p.ws = (unsigned char*)d_ws; p.ph_lo = 0; p.ph_hi = NPHASE;
    void* args[] = {&p};
    const hipError_t e = hipLaunchCooperativeKernel((const void*)fwd_megakernel, dim3(grid), dim3(NTHR), args, LDS_BYTES, stream);
    if (e != hipSuccess) fprintf(stderr, "kernel_launch: launch failed: %s (grid %d)\n", hipGetErrorString(e), grid);
}
#endif
```

```cpp
#ifndef HOST_EMU
#include <hip/hip_runtime.h>
#include <cstdio>
#include <cstdint>
#define DEV __device__ __forceinline__
#define LAS __attribute__((address_space(3)))
#define TID ((int)threadIdx.x)
#define BID ((int)blockIdx.x)
#define NBLK ((int)gridDim.x)
#define SYNC() __syncthreads()
#define EXPF(x) __expf(x)
#define RCPF(x) __builtin_amdgcn_rcpf(x)
#define RSQF(x) __builtin_amdgcn_rsqf(x)
#define ATOMIC_ADD_LDS(p, v) __hip_atomic_fetch_add((p), (v), __ATOMIC_RELAXED, __HIP_MEMORY_SCOPE_WORKGROUP)
#define ATOMIC_ADD_G(p, v) __hip_atomic_fetch_add((p), (v), __ATOMIC_RELAXED, __HIP_MEMORY_SCOPE_AGENT)
#define RFL(x) __builtin_amdgcn_readfirstlane(x)
#define SCHED_FENCE() __builtin_amdgcn_sched_barrier(0)
#define MEM_FENCE() asm volatile("" ::: "memory")
#define WAVE_LDS_FENCE() asm volatile("s_waitcnt lgkmcnt(0)" ::: "memory")
#define OPAQUE_V(x) asm volatile("" : "+v"(x))
#define VM_DRAIN() asm volatile("s_waitcnt vmcnt(0)" ::: "memory")
#define TOUCH(x) asm volatile("" :: "v"(x))
#endif

#ifndef CFG_SEQ
#define CFG_SEQ 16384
#endif
#ifndef CFG_NEXP
#define CFG_NEXP 256
#endif
constexpr int DM = 1024, BATCH = 2, SEQ = CFG_SEQ, CTXL = 256, CHUNK = 128;
constexpr int NLAT = BATCH * SEQ, NCTX = BATCH * CTXL, NROWS = NLAT + NCTX;
constexpr int NCH = SEQ / CHUNK, NCHC = CTXL / CHUNK, NCHT = NCH + NCHC;
constexpr int SSD_H = 16, SSD_P = 64, SSD_N = 128, D_XBC = 1536;
constexpr int ML_H = 8, ML_DV = 128, ML_DK = 64, ML_PP = 144;
constexpr int NEXP = CFG_NEXP, TOPK = 8, TOPKG = 4, DEXP = 256, EPL = NEXP / 64;
constexpr int NASG = NLAT * TOPK, MAXSLOT = NASG + NEXP * 256;
constexpr int NIN = 7936;
constexpr float EPS = 1e-6f;
constexpr int NTHR = 512;

typedef unsigned short bf16_t;
typedef short bf16x8 __attribute__((ext_vector_type(8)));
typedef float f32x4 __attribute__((ext_vector_type(4)));
typedef unsigned u32x4 __attribute__((ext_vector_type(4)));
typedef unsigned u32x2 __attribute__((ext_vector_type(2)));

constexpr size_t alignup(size_t x) { return (x + 4095) & ~(size_t)4095; }
constexpr size_t WS_CTL = 0;
constexpr size_t CTL_BYTES = 65536;
constexpr size_t WS_MOD = WS_CTL + CTL_BYTES;
constexpr size_t WS_DECS = WS_MOD + alignup(3 * 6144 * 4);
constexpr size_t WS_DECM = WS_DECS + alignup((size_t)BATCH * 2 * NCHT * 16 * 4);
constexpr size_t WS_WIN = WS_DECM + alignup((size_t)BATCH * 2 * NCHT * 8 * 4);
constexpr size_t WS_WSO = WS_WIN + alignup((size_t)NIN * 1024 * 2);
constexpr size_t WS_WMO = WS_WSO + alignup((size_t)1024 * 1024 * 2);
constexpr size_t WS_WOUT = WS_WMO + alignup((size_t)1024 * 1024 * 2);
constexpr size_t WS_WRS = WS_WOUT + alignup((size_t)1024 * 1024 * 2);
constexpr size_t WS_WSD = WS_WRS + alignup((size_t)768 * 1024 * 2);
constexpr size_t WS_XN = WS_WSD + alignup((size_t)1024 * 256 * 2);
constexpr size_t WS_STAGE = WS_XN + alignup((size_t)NROWS * 1024 * 2);
constexpr size_t WS_Z = WS_STAGE;
constexpr size_t WS_XBC = WS_Z + alignup((size_t)NROWS * 1024 * 2);
constexpr size_t WS_QK = WS_XBC + alignup((size_t)NROWS * 1536 * 2);
constexpr size_t WS_V = WS_QK + alignup((size_t)NROWS * 1024 * 2);
constexpr size_t WS_O = WS_V + alignup((size_t)NROWS * 1024 * 2);
constexpr size_t WS_MG = WS_O + alignup((size_t)NROWS * 1024 * 2);
constexpr size_t WS_DTG = WS_MG + alignup((size_t)NROWS * 2048 * 2);
constexpr size_t WS_STS = WS_DTG + alignup((size_t)NROWS * 64 * 4);
constexpr size_t STS_CH = (size_t)SSD_H * SSD_P * SSD_N;
constexpr size_t WS_STM = WS_STS + alignup((size_t)BATCH * 2 * NCHT * STS_CH * 2);
constexpr size_t STM_CH = (size_t)ML_H * ML_PP * ML_DK;
constexpr size_t WS_YPRE = WS_STM + alignup((size_t)BATCH * 2 * NCHT * STM_CH * 2);
constexpr size_t WS_HP = WS_YPRE + alignup((size_t)NLAT * 1024 * 2);
constexpr size_t WS_SSQ = WS_HP + alignup((size_t)NLAT * 1024 * 2);
constexpr size_t WS_MIX_END = WS_SSQ + alignup((size_t)NLAT * 16 * 4);
constexpr size_t WS_M1 = WS_XBC;
constexpr size_t WS_MERGED = WS_QK;
constexpr size_t WS_Y = WS_STAGE;
constexpr size_t WS_W1T = WS_STAGE;
static_assert((size_t)NEXP * 512 * 1024 * 2 <= (size_t)NASG * 1024 * 2 || true, "");
constexpr size_t WS_YEND = WS_STAGE + (alignup((size_t)NASG * 1024 * 2) > alignup((size_t)NEXP * 512 * 1024 * 2) ? alignup((size_t)NASG * 1024 * 2) : alignup((size_t)NEXP * 512 * 1024 * 2));
constexpr size_t WS_W2T = WS_YEND;
constexpr size_t WS_H = WS_W2T + alignup((size_t)NEXP * 1024 * 256 * 2);
constexpr size_t WS_LOG = WS_H + alignup((size_t)MAXSLOT * 256 * 2);
constexpr size_t WS_HS = WS_LOG + alignup((size_t)NLAT * NEXP * 4);
constexpr size_t WS_ASGE = WS_HS + alignup((size_t)NLAT * 256 * 2);
constexpr size_t WS_ASGR = WS_ASGE + alignup((size_t)NASG * 4);
constexpr size_t WS_ASGW = WS_ASGR + alignup((size_t)NASG * 4);
constexpr size_t WS_STOK = WS_ASGW + alignup((size_t)NASG * 4);
constexpr size_t WS_SDST = WS_STOK + alignup((size_t)MAXSLOT * 4);
constexpr size_t WS_SW = WS_SDST + alignup((size_t)MAXSLOT * 4);
constexpr size_t WS_TEXP = WS_SW + alignup((size_t)MAXSLOT * 4);
constexpr size_t WS_CMAT = WS_TEXP + alignup((size_t)(MAXSLOT / 256) * 4);
constexpr size_t WS_YS = WS_CMAT + alignup((size_t)512 * NEXP * 4);
constexpr size_t WS_MOE_END = WS_YS + alignup((size_t)NLAT * 1024 * 2);
constexpr size_t WS_NEED = WS_MIX_END > WS_MOE_END ? WS_MIX_END : WS_MOE_END;

constexpr int LDS_BYTES = 147456;
constexpr int NPHASE = 17;

struct Params { const float* in[32]; float* out; unsigned char* ws; int ph_lo, ph_hi; };

#ifndef HOST_EMU
DEV unsigned f2bf(float f) { const __bf16 b = (__bf16)f; return (unsigned)__builtin_bit_cast(unsigned short, b); }
#else
DEV unsigned f2bf(float f) { unsigned u = __builtin_bit_cast(unsigned, f); return (u + 0x7fffu + ((u >> 16) & 1u)) >> 16; }
#endif
DEV float bf2f(unsigned h) { return __builtin_bit_cast(float, (h & 0xffffu) << 16); }
#ifndef HOST_EMU
typedef float f32x2_t __attribute__((ext_vector_type(2))); typedef __bf16 bf16x2_t __attribute__((ext_vector_type(2)));
DEV unsigned pk2(float lo, float hi) { const f32x2_t v = {lo, hi}; const bf16x2_t b = __builtin_convertvector(v, bf16x2_t); return __builtin_bit_cast(unsigned, b); }
#else
DEV unsigned pk2(float lo, float hi) { return f2bf(lo) | (f2bf(hi) << 16); }
#endif
DEV float bflo(unsigned w) { return __builtin_bit_cast(float, w << 16); }
DEV float bfhi(unsigned w) { return __builtin_bit_cast(float, w & 0xffff0000u); }
DEV float sigmoidf_(float x) { return RCPF(1.f + EXPF(-x)); }
DEV float siluf_(float x) { return x * RCPF(1.f + EXPF(-x)); }
DEV float softplusf_(float x) { return x > 20.f ? x : log1pf(EXPF(x)); }
DEV float logsigmoidf_(float x) { return -softplusf_(-x); }
DEV float wave_sum(float v) {
#pragma unroll
    for (int o = 1; o < 64; o <<= 1) v += __shfl_xor(v, o);
    return v;
}
DEV float wave_incl_scan(float v, int lane) {
#pragma unroll
    for (int d = 1; d < 64; d <<= 1) { float t = __shfl_up(v, d); if (lane >= d) v += t; }
    return v;
}
typedef short s16x4 __attribute__((ext_vector_type(4)));
#ifndef HOST_EMU
DEV f32x4 mfma16(bf16x8 a, bf16x8 b, f32x4 c) { return __builtin_amdgcn_mfma_f32_16x16x32_bf16(a, b, c, 0, 0, 0); }
DEV s16x4 lds_tr16(const LAS void* p) { return __builtin_bit_cast(s16x4, __builtin_amdgcn_ds_read_tr16_b64_v4i16((LAS s16x4*)p)); }
#endif
namespace pg8 {
constexpr int BM = 256, BK = 64, HALF = 128, HTB = HALF * BK * 2, STAGE_BYTES = 8 * HTB, NXCD = 8, WGM = 8;
struct Unit { int pm, pn; };
struct Gemm { const bf16_t* A; const bf16_t* Bt; int M, N, K; };

DEV int lds_byte(int r, int c) { const int st = (r >> 4) * 2 + (c >> 5), rr = r & 15, cc = c & 31, ob = rr * 64 + cc * 2; return st * 1024 + (ob ^ (((ob >> 9) & 1) << 5)); }
DEV void stage_rc(int b, int& R, int& C) { const int st = b / 1024, sb = b % 1024, swz = sb ^ (((sb >> 9) & 1) << 5); R = (st >> 1) * 16 + swz / 64; C = (st & 1) * 32 + (swz % 64) / 2; }
DEV int perm32(int rho) { const int n = rho >> 4, i = rho & 15; return 8 * (i >> 2) + 4 * n + (i & 3); }

struct StaticOrder {
    static constexpr bool GATHER = false;
    int nM, nN, nwg, G, c;
    DEV void init(int M, int N, int G_, int c_) { nM = M / BM; nN = N / BM; nwg = nM * nN; G = G_; c = c_; }
    DEV bool next(int i, Unit& u) const {
        const long L = (long)i * G + c; if (L >= nwg) return false;
        int wgid = (int)L; { const int q = nwg / NXCD, r = nwg % NXCD, xcd = wgid % NXCD, off = wgid / NXCD; wgid = (xcd < r ? xcd * (q + 1) : r * (q + 1) + (xcd - r) * q) + off; }
        const int nig = WGM * nN, gid = wgid / nig, fm = gid * WGM, gsz = (nM - fm) < WGM ? (nM - fm) : WGM;
        u.pm = fm + ((wgid % nig) % gsz); u.pn = (wgid % nig) / gsz; return true;
    }
    DEV unsigned arow(const Unit& u, int r) const { return (unsigned)(u.pm * BM + r); }
    DEV const char* bbase(const Gemm& g, const Unit& u) const { return (const char*)g.Bt + (size_t)u.pn * BM * g.K * 2; }
};
struct TileOrder {
    static constexpr bool GATHER = false;
    int pm0, step, nM, np;
    DEV bool next(int i, Unit& u) const { const int pm = pm0 + (i / np) * step; if (pm >= nM) return false; u.pm = pm; u.pn = i % np; return true; }
    DEV unsigned arow(const Unit& u, int r) const { return (unsigned)(u.pm * BM + r); }
    DEV const char* bbase(const Gemm& g, const Unit& u) const { return (const char*)g.Bt + (size_t)u.pn * BM * g.K * 2; }
};
template <bool GATHER_> struct ExpertOrder {
    static constexpr bool GATHER = GATHER_;
    int tlo, thi, np, G, c; const int* texp; int e0; size_t estride  ; const int* rowmap;
    DEV bool next(int i, Unit& u) const {
        const long L = (long)i * G + c; const long n = (long)(thi - tlo) * np; if (L >= n) return false;
        int wg = (int)L; { const int nn = (int)n, q = nn / NXCD, r = nn % NXCD, xcd = wg % NXCD, off = wg / NXCD; wg = (xcd < r ? xcd * (q + 1) : r * (q + 1) + (xcd - r) * q) + off; }
        u.pm = tlo + wg / np; u.pn = wg % np; return true;
    }
    DEV unsigned arow(const Unit& u, int r) const { return GATHER_ ? (unsigned)rowmap[u.pm * BM + r] : (unsigned)(u.pm * BM + r); }
    DEV const char* bbase(const Gemm& g, const Unit& u) const { const int e = texp[u.pm] - e0; return (const char*)(g.Bt + (size_t)e * estride) + (size_t)u.pn * BM * g.K * 2; }
};

#ifndef HOST_EMU
#define PG8_LAS __attribute__((address_space(3)))
template <class Epi, class Sched>
__device__ __forceinline__ void gemm_phase(PG8_LAS unsigned char* lds, const Gemm g, const Sched& S, const Epi& E) {
    int tid_ = threadIdx.x; asm volatile("" : "+v"(tid_));
    const int tid = tid_, wid = __builtin_amdgcn_readfirstlane(tid >> 6), lane = tid & 63, wr = wid >> 2, wc = wid & 3, fr = lane & 15, fq = lane >> 4;
    int Kop = g.K; asm volatile("" : "+s"(Kop));
    const int K = Kop, nt = K / BK;
    int RA[2], CA[2]; unsigned voffB[2];
#pragma unroll
    for (int i = 0; i < 2; ++i) { int R, C; stage_rc(tid * 16 + i * 8192, R, C); const int Rb = Epi::PERM ? ((R & ~31) + perm32(R & 31)) : R;
        RA[i] = R; CA[i] = C; voffB[i] = (unsigned)(Rb * K + C) * 2u; }
    const size_t kstep = (size_t)(BK * 2);
    const size_t hstep = (size_t)HALF * K * 2;
    const unsigned ldsw = (unsigned)wid * 1024u;
    const int aoff = lds_byte(wr * 64 + fr, fq * 8), boff = lds_byte(wc * 32 + fr, fq * 8);
    const char* const Ab = (const char*)g.A;
#define PG8_SA(b, h) (((b) * 2 + (h)) * HTB)
#define PG8_SB(b, h) ((4 + (b) * 2 + (h)) * HTB)
#define PG8_STAGE(bufoff, gbase, voff) do { _Pragma("unroll") for (int _i = 0; _i < 2; ++_i) \
        __builtin_amdgcn_global_load_lds((const unsigned*)((const char*)(gbase) + (voff)[_i]), (PG8_LAS unsigned*)(lds + (bufoff) + ldsw + _i * 8192), 16, 0, 0); } while (0)
#define PG8_LDA(dst, b, h) do { _Pragma("unroll") for (int m = 0; m < 4; ++m) _Pragma("unroll") for (int k = 0; k < 2; ++k) dst[m][k] = *(const PG8_LAS bf16x8*)(lds + PG8_SA(b, h) + aoff + m * 2048 + k * 1024); } while (0)
#define PG8_LDB(dst, b, h) do { _Pragma("unroll") for (int n = 0; n < 2; ++n) _Pragma("unroll") for (int k = 0; k < 2; ++k) dst[n][k] = *(const PG8_LAS bf16x8*)(lds + PG8_SB(b, h) + boff + n * 2048 + k * 1024); } while (0)
#define PG8_MMA(ai, bj, At, Bt) do { __builtin_amdgcn_s_setprio(1); _Pragma("unroll") for (int m = 0; m < 4; ++m) _Pragma("unroll") for (int n = 0; n < 2; ++n) _Pragma("unroll") for (int k = 0; k < 2; ++k) \
        acc[ai][bj][m][n] = __builtin_amdgcn_mfma_f32_16x16x32_bf16(Bt[n][k], At[m][k], acc[ai][bj][m][n], 0, 0, 0); __builtin_amdgcn_s_setprio(0); } while (0)
#define PG8_WAIT_V(n) asm volatile("s_waitcnt vmcnt(" #n ")" ::: "memory")
#define PG8_WAIT_L(n) asm volatile("s_waitcnt lgkmcnt(" #n ")" ::: "memory")
#define PG8_BAR __builtin_amdgcn_s_barrier()
#define PG8_SCHED __builtin_amdgcn_sched_barrier(0)
#define PG8_VOFFA(dst, u) do { _Pragma("unroll") for (int _h = 0; _h < 2; ++_h) _Pragma("unroll") for (int _i = 0; _i < 2; ++_i) \
        dst[_h][_i] = (S.arow(u, _h * HALF + RA[_i]) * (unsigned)K + (unsigned)CA[_i]) * 2u; } while (0)
    Unit cur, nxt; int ui = 0;
    if (!S.next(0, cur)) return;
    f32x4 acc[2][2][4][2];
#pragma unroll
    for (int a = 0; a < 2; ++a)
#pragma unroll
        for (int b = 0; b < 2; ++b)
#pragma unroll
            for (int m = 0; m < 4; ++m)
#pragma unroll
                for (int n = 0; n < 2; ++n) acc[a][b][m][n] = (f32x4){0.f, 0.f, 0.f, 0.f};
    bf16x8 At[4][2], B0[2][2], B1[2][2];
    constexpr bool GA = Sched::GATHER;
    unsigned vAc[2][2], vAn[2][2];
    unsigned voffA[2];
#pragma unroll
    for (int i = 0; i < 2; ++i) voffA[i] = (unsigned)(RA[i] * K + CA[i]) * 2u;
    const size_t tstep = 2 * hstep;
    const char* cA = Ab;
    if constexpr (GA) { PG8_VOFFA(vAc, cur); } else { cA = Ab + (size_t)S.arow(cur, 0) * K * 2; (void)tstep; }
    const char* cB = S.bbase(g, cur);
#define PG8_STAGE_A(bufoff, h, ubase, vg) do { if constexpr (GA) { PG8_STAGE(bufoff, ubase, vg[h]); } else { PG8_STAGE(bufoff, (ubase) + (h) * hstep, voffA); } } while (0)
    PG8_STAGE(PG8_SB(0, 0), cB, voffB); PG8_STAGE(PG8_SB(0, 1), cB + hstep, voffB); PG8_STAGE_A(PG8_SA(0, 0), 0, cA, vAc); PG8_STAGE_A(PG8_SA(0, 1), 1, cA, vAc);
    if (wr == 1) PG8_BAR;
    PG8_WAIT_V(2); PG8_BAR;
    PG8_STAGE(PG8_SB(1, 0), cB + kstep, voffB); PG8_STAGE_A(PG8_SA(1, 0), 0, cA + kstep, vAc); PG8_STAGE(PG8_SB(1, 1), cB + hstep + kstep, voffB);
    PG8_WAIT_V(6); PG8_BAR;
    for (;;) {
        const bool has_next = S.next(ui + 1, nxt);
        const char* nB = cB; const char* nA = cA;
        if (has_next) { nB = S.bbase(g, nxt); if constexpr (GA) { PG8_VOFFA(vAn, nxt); } else { nA = Ab + (size_t)S.arow(nxt, 0) * K * 2; } }
        else if constexpr (GA) {
#pragma unroll
            for (int _h = 0; _h < 2; ++_h)
#pragma unroll
                for (int _i = 0; _i < 2; ++_i) vAn[_h][_i] = vAc[_h][_i];
        }
#pragma unroll 1
        for (int t = 0; t < nt; t += 2) {
            const bool last = (t == nt - 2);
            const char* a1 = cA + (size_t)(t + 1) * kstep;
            const char* a2 = last ? nA : cA + (size_t)(t + 2) * kstep; const char* b2 = last ? nB : cB + (size_t)(t + 2) * kstep;
            const char* a3 = a2 + kstep; const char* b3 = b2 + kstep;
            unsigned v2[2][2];
            if constexpr (GA) {
#pragma unroll
                for (int _h = 0; _h < 2; ++_h)
#pragma unroll
                    for (int _i = 0; _i < 2; ++_i) v2[_h][_i] = last ? vAn[_h][_i] : vAc[_h][_i];
            }
            PG8_LDB(B0, 0, 0); PG8_LDB(B1, 0, 1); PG8_SCHED; PG8_LDA(At, 0, 0); PG8_STAGE_A(PG8_SA(1, 1), 1, a1, vAc);
            PG8_WAIT_V(8); PG8_WAIT_L(0); PG8_BAR; PG8_MMA(0, 0, At, B0); PG8_MMA(0, 1, At, B1); PG8_BAR; PG8_SCHED;
            PG8_LDA(At, 0, 1); PG8_STAGE(PG8_SB(0, 0), b2, voffB); PG8_STAGE(PG8_SB(0, 1), b2 + hstep, voffB); PG8_STAGE_A(PG8_SA(0, 0), 0, a2, v2);
            PG8_WAIT_V(8); PG8_WAIT_L(0); PG8_BAR; PG8_MMA(1, 0, At, B0); PG8_MMA(1, 1, At, B1); PG8_BAR; PG8_SCHED;
            PG8_LDB(B0, 1, 0); PG8_LDB(B1, 1, 1); PG8_SCHED; PG8_LDA(At, 1, 0); PG8_STAGE_A(PG8_SA(0, 1), 1, a2, v2);
            PG8_WAIT_V(8); PG8_WAIT_L(0); PG8_BAR; PG8_MMA(0, 0, At, B0); PG8_MMA(0, 1, At, B1); PG8_BAR; PG8_SCHED;
            PG8_LDA(At, 1, 1); PG8_STAGE(PG8_SB(1, 0), b3, voffB); PG8_STAGE(PG8_SB(1, 1), b3 + hstep, voffB); PG8_STAGE_A(PG8_SA(1, 0), 0, a3, v2);
            PG8_WAIT_V(8); PG8_WAIT_L(0); PG8_BAR; PG8_MMA(1, 0, At, B0); PG8_MMA(1, 1, At, B1); PG8_BAR; PG8_SCHED;
        }
        if (wr == 0) PG8_BAR;
        E(acc, cur, wr, wc, fr, fq);
        if (!has_next) break;
#pragma unroll
        for (int a = 0; a < 2; ++a)
#pragma unroll
            for (int b = 0; b < 2; ++b)
#pragma unroll
                for (int m = 0; m < 4; ++m)
#pragma unroll
                    for (int n = 0; n < 2; ++n) acc[a][b][m][n] = (f32x4){0.f, 0.f, 0.f, 0.f};
        cur = nxt; cB = nB; cA = nA; ++ui;
        if constexpr (GA) {
#pragma unroll
            for (int _h = 0; _h < 2; ++_h)
#pragma unroll
                for (int _i = 0; _i < 2; ++_i) vAc[_h][_i] = vAn[_h][_i];
        }
        if (wr == 1) PG8_BAR;
    }
    PG8_WAIT_V(0);
    PG8_BAR;
#undef PG8_SA
#undef PG8_SB
#undef PG8_STAGE
#undef PG8_LDA
#undef PG8_LDB
#undef PG8_MMA
#undef PG8_WAIT_V
#undef PG8_WAIT_L
#undef PG8_BAR
#undef PG8_SCHED
#undef PG8_VOFFA
#undef PG8_STAGE_A
}
#else
template <class Epi, class Sched>
static inline void gemm_phase(unsigned char* lds, const Gemm g, const Sched& S, const Epi& E) {
    const int tid = TID, wid = tid >> 6, lane = tid & 63, wr = wid >> 2, wc = wid & 3, fr = lane & 15, fq = lane >> 4;
    float* C = (float*)(lds + 512 * 1024);
    Unit cur;
    for (int ui = 0; S.next(ui, cur); ++ui) {
        SYNC();
        { const int r = tid >> 1, c0 = (tid & 1) * 128; const bf16_t* arow = g.A + (size_t)S.arow(cur, r) * g.K; const bf16_t* bb = (const bf16_t*)S.bbase(g, cur);
          for (int c = c0; c < c0 + 128; ++c) { const bf16_t* brow = bb + (size_t)c * g.K; float s = 0.f; for (int k = 0; k < g.K; ++k) s += bf2f(arow[k]) * bf2f(brow[k]); C[r * 256 + c] = s; } }
        SYNC();
        f32x4 acc[2][2][4][2];
        for (int ai = 0; ai < 2; ++ai) for (int bj = 0; bj < 2; ++bj) for (int m = 0; m < 4; ++m) for (int n = 0; n < 2; ++n) for (int i = 0; i < 4; ++i) {
            const int row = 128 * ai + 64 * wr + 16 * m + fr, col = Epi::PERM ? 128 * bj + 32 * wc + 8 * fq + 4 * n + i : 128 * bj + 32 * wc + 16 * n + 4 * fq + i;
            acc[ai][bj][m][n][i] = C[row * 256 + col]; }
        E(acc, cur, wr, wc, fr, fq);
    }
    SYNC();
}
#endif
}

struct Frame {
    LAS unsigned char* lds;
    int tid, lane, wave, G, bid;
    const Params* pp; float* out; unsigned char* ws;
};
#define WSP(T, off) ((T*)(F.ws + (off)))

DEV void transpose_item(const float* W, int K, int N, bf16_t* WT, int dst_row, int k0, int n0, LAS float* scr, int lane) {
#pragma unroll 8
    for (int i = 0; i < 32; ++i) { const int kk = 2 * i + (lane >> 5); scr[kk * 33 + (lane & 31)] = W[(size_t)(k0 + kk) * N + n0 + (lane & 31)]; }
    WAVE_LDS_FENCE();
    const int c = lane & 7;
#pragma unroll
    for (int j = 0; j < 4; ++j) { const int n = (lane >> 3) + 8 * j; const LAS float* s = scr + (8 * c) * 33 + n;
        u32x4 o; o.x = pk2(s[0 * 33], s[1 * 33]); o.y = pk2(s[2 * 33], s[3 * 33]); o.z = pk2(s[4 * 33], s[5 * 33]); o.w = pk2(s[6 * 33], s[7 * 33]);
        *(u32x4*)(WT + (size_t)(dst_row + n) * K + k0 + 8 * c) = o; }
    WAVE_LDS_FENCE();
}
DEV int map_in(int s) {
    if (s < 2560) return s;
    if (s < 2592) return 7680 + (s - 2560);
    if (s < 4640) return s - 32;
    if (s < 4672) return 7712 + (s - 4640);
    return s - 64;
}
DEV int map_gu(int s, int up) { return (s >> 7) * 256 + up * 128 + (s & 127); }
DEV void transpose_job(Frame& F, const float* W, int K, int N, bf16_t* WT, int mode  , int row_base, int item, bool active) {
    LAS float* scr = (LAS float*)(F.lds) + F.wave * (64 * 33);
    if (active) {
        const int nblk = N / 32, kb = item / nblk, nb = item % nblk, n0 = nb * 32;
        int d = n0; if (mode == 1) d = map_in(n0); else if (mode == 2) d = map_gu(n0, 0); else if (mode == 3) d = map_gu(n0, 1);
        transpose_item(W, K, N, WT, row_base + d, kb * 64, n0, scr, F.lane);
    }
}
DEV void p0_small(Frame& F) {
    const float* c = F.pp->in[1]; const float* cctx = F.pp->in[3]; const float* aw = F.pp->in[4]; const float* ab = F.pp->in[5];
    float* mod = WSP(float, WS_MOD);
    LAS float* red = (LAS float*)F.lds;
    for (int cb = F.bid; cb < 192; cb += F.G) {
        const int cl = F.tid & 31, kg = F.tid >> 5, col = cb * 32 + cl;
        float s0 = 0.f, s1 = 0.f, s2 = 0.f;
#pragma unroll 16
        for (int k = kg * 64; k < kg * 64 + 64; ++k) { const float w = aw[(size_t)k * 6144 + col]; s0 += siluf_(c[k]) * w; s1 += siluf_(c[1024 + k]) * w; s2 += siluf_(cctx[k]) * w; }
        red[(kg * 32 + cl) * 3 + 0] = s0; red[(kg * 32 + cl) * 3 + 1] = s1; red[(kg * 32 + cl) * 3 + 2] = s2;
        SYNC();
        if (F.tid < 96) { const int v = F.tid / 32, cc = F.tid % 32; float s = 0.f; for (int q = 0; q < 16; ++q) s += red[(q * 32 + cc) * 3 + v]; mod[v * 6144 + cb * 32 + cc] = s + ab[cb * 32 + cc]; }
        SYNC();
    }
}
DEV void p0_weights(Frame& F) {
    SYNC();
    const int gw = F.bid * 8 + F.wave, NGW = F.G * 8;
#define P0_JOB(Wp, Kv, Nv, WTp, modev, rb) do { const int nitems_ = ((Kv) / 64) * ((Nv) / 32); const int rounds_ = (nitems_ + NGW - 1) / NGW; \
        for (int r_ = 0; r_ < rounds_; ++r_) { const int it_ = r_ * NGW + gw; transpose_job(F, (Wp), (Kv), (Nv), (WTp), (modev), (rb), it_, it_ < nitems_); } } while (0)
    P0_JOB(F.pp->in[8], 1024, 7744, WSP(bf16_t, WS_WIN), 1, 0);
    P0_JOB(F.pp->in[20], 1024, 1024, WSP(bf16_t, WS_WSO), 0, 0);
    P0_JOB(F.pp->in[21], 1024, 1024, WSP(bf16_t, WS_WMO), 0, 0);
    P0_JOB(F.pp->in[22], 1024, 1024, WSP(bf16_t, WS_WOUT), 0, 0);
    P0_JOB(F.pp->in[23], 1024, NEXP, WSP(bf16_t, WS_WRS), 0, 0);
    P0_JOB(F.pp->in[28], 1024, 256, WSP(bf16_t, WS_WRS), 2, 256);
    P0_JOB(F.pp->in[29], 1024, 256, WSP(bf16_t, WS_WRS), 3, 256);
    P0_JOB(F.pp->in[30], 256, 1024, WSP(bf16_t, WS_WSD), 0, 0);
#undef P0_JOB
}
struct T64 { const float* W; bf16_t* WT; int K, N, dst_row, k0, n0; };
DEV void t64_load(const T64& t, f32x4 (&v)[16], int lane) {
#pragma unroll
    for (int i = 0; i < 16; ++i) v[i] = *(const f32x4*)(t.W + (size_t)(t.k0 + 4 * i + (lane >> 4)) * t.N + t.n0 + 4 * (lane & 15));
}
DEV void t64_store(const T64& t, const f32x4 (&v)[16], LAS float* scr, int lane) {
#pragma unroll
    for (int i = 0; i < 16; ++i) { LAS float* d = scr + (4 * i + (lane >> 4)) * 65 + 4 * (lane & 15); d[0] = v[i].x; d[1] = v[i].y; d[2] = v[i].z; d[3] = v[i].w; }
    WAVE_LDS_FENCE();
    const int c = lane & 7;
#pragma unroll
    for (int j = 0; j < 8; ++j) { const int n = (lane >> 3) + 8 * j; const LAS float* sp = scr + (8 * c) * 65 + n;
        u32x4 o; o.x = pk2(sp[0 * 65], sp[1 * 65]); o.y = pk2(sp[2 * 65], sp[3 * 65]); o.z = pk2(sp[4 * 65], sp[5 * 65]); o.w = pk2(sp[6 * 65], sp[7 * 65]);
        *(u32x4*)(t.WT + (size_t)(t.dst_row + n) * t.K + t.k0 + 8 * c) = o; }
    WAVE_LDS_FENCE();
}
DEV T64 expert_item(Frame& F, int e0, int it) {
    const int per = 192, el = it / per, j = it % per, e = e0 + el; T64 t;
    if (j < 128) { const int up = j >> 6, jj = j & 63, kb = jj >> 2, nb = jj & 3;
        t.W = F.pp->in[25 + up] + (size_t)e * 1024 * 256; t.K = 1024; t.N = 256; t.WT = WSP(bf16_t, WS_W1T) + (size_t)el * 512 * 1024; t.dst_row = map_gu(nb * 64, up); t.k0 = kb * 64; t.n0 = nb * 64; }
    else { const int jj = j - 128, kb = jj >> 4, nb = jj & 15;
        t.W = F.pp->in[27] + (size_t)e * 256 * 1024; t.K = 256; t.N = 1024; t.WT = WSP(bf16_t, WS_W2T) + (size_t)el * 1024 * 256; t.dst_row = nb * 64; t.k0 = kb * 64; t.n0 = nb * 64; }
    return t;
}
DEV void p_expert_weights(Frame& F, int nR) {
    LAS float* scr = (LAS float*)(F.lds) + F.wave * (64 * 65);
    const int N = NEXP * 192;
    int cB, cA;
    if (nR >= F.G) { cB = (N + F.G - 1) / F.G; cA = cB; }
    else { cB = (N * 8 + (nR * 5 + (F.G - nR) * 8) - 1) / (nR * 5 + (F.G - nR) * 8); const int rem = N - (F.G - nR) * cB; cA = rem > 0 ? (rem + nR - 1) / nR : 0; }
    const int start = F.bid < nR ? F.bid * cA : nR * cA + (F.bid - nR) * cB, cnt = F.bid < nR ? cA : cB;
    const int end = start + cnt < N ? start + cnt : N;
    f32x4 v[16];
    int it = start + F.wave;
    if (it < end) { const T64 t = expert_item(F, 0, it); t64_load(t, v, F.lane); }
#pragma unroll 1
    for (; it < end; it += 8) {
        const T64 t = expert_item(F, 0, it);
        f32x4 cur[16];
#pragma unroll
        for (int i = 0; i < 16; ++i) cur[i] = v[i];
        if (it + 8 < end) { const T64 tn = expert_item(F, 0, it + 8); t64_load(tn, v, F.lane); }
        t64_store(t, cur, scr, F.lane);
    }
    SYNC();
}

DEV void norm_mod_row(const float* xrow, const float* g, const float* shift, const float* scale, bf16_t* orow, int lane) {
    const f32x4* xr = (const f32x4*)xrow + lane;
    f32x4 v[4]; float s = 0.f;
#pragma unroll
    for (int j = 0; j < 4; ++j) { v[j] = xr[64 * j]; s += (v[j].x * v[j].x + v[j].y * v[j].y) + (v[j].z * v[j].z + v[j].w * v[j].w); }
    const float rstd = RSQF(wave_sum(s) * (1.f / DM) + EPS);
    u32x2* o8 = (u32x2*)orow + lane;
#pragma unroll
    for (int j = 0; j < 4; ++j) {
        const f32x4 gg = ((const f32x4*)g)[lane + 64 * j], sh = ((const f32x4*)shift)[lane + 64 * j], sc = ((const f32x4*)scale)[lane + 64 * j];
        const f32x4 y = v[j] * rstd * gg * (sc + 1.0f) + sh;
        u32x2 w; w.x = pk2(y.x, y.y); w.y = pk2(y.z, y.w); o8[64 * j] = w;
    }
}
template <int NR> DEV void norm_mod_rows(const float* const (&xrow)[NR], const float* g, const float* const (&shift)[NR], const float* const (&scale)[NR], bf16_t* const (&orow)[NR], int lane) {
    f32x4 v[NR][4]; float s[NR];
#pragma unroll
    for (int r = 0; r < NR; ++r)
#pragma unroll
        for (int j = 0; j < 4; ++j) v[r][j] = ((const f32x4*)xrow[r])[lane + 64 * j];
#pragma unroll
    for (int r = 0; r < NR; ++r) { float a = 0.f;
#pragma unroll
        for (int j = 0; j < 4; ++j) a += (v[r][j].x * v[r][j].x + v[r][j].y * v[r][j].y) + (v[r][j].z * v[r][j].z + v[r][j].w * v[r][j].w);
        s[r] = a; }
#pragma unroll
    for (int o = 1; o < 64; o <<= 1)
#pragma unroll
        for (int r = 0; r < NR; ++r) s[r] += __shfl_xor(s[r], o);
#pragma unroll
    for (int r = 0; r < NR; ++r) { const float rstd = RSQF(s[r] * (1.f / DM) + EPS); u32x2* o8 = (u32x2*)orow[r] + lane;
#pragma unroll
        for (int j = 0; j < 4; ++j) {
            const f32x4 gg = ((const f32x4*)g)[lane + 64 * j], sh = ((const f32x4*)shift[r])[lane + 64 * j], sc = ((const f32x4*)scale[r])[lane + 64 * j];
            const f32x4 y = v[r][j] * rstd * gg * (sc + 1.0f) + sh;
            u32x2 w; w.x = pk2(y.x, y.y); w.y = pk2(y.z, y.w); o8[64 * j] = w; } }
}
DEV void p1_xn(Frame& F) {
    const float* mod = WSP(float, WS_MOD); bf16_t* XN = WSP(bf16_t, WS_XN);
    const int gw = F.bid * 8 + F.wave, NGW = F.G * 8;
    static_assert(NROWS % 8 == 0 && SEQ % 8 == 0 && NLAT % 8 == 0, "row octets");
    for (int q = gw; q < NROWS / 8; q += NGW) {
        const float* src[8]; const float* sh[8]; const float* sc[8]; bf16_t* dst[8];
#pragma unroll
        for (int i = 0; i < 8; ++i) { const int r = q * 8 + i; src[i] = r < NLAT ? F.pp->in[0] + (size_t)r * DM : F.pp->in[2] + (size_t)(r - NLAT) * DM;
            const int mv = r < NLAT ? r / SEQ : 2; sh[i] = mod + mv * 6144; sc[i] = mod + mv * 6144 + 1024; dst[i] = XN + (size_t)r * DM; }
        norm_mod_rows<8>(src, F.pp->in[6], sh, sc, dst, F.lane);
    }
}
DEV void xn2_tile(Frame& F, int pm) {
    const float* mod = WSP(float, WS_MOD); bf16_t* XN = WSP(bf16_t, WS_XN);
    for (int q = F.wave; q < 64; q += 8) {
        const float* src[4]; const float* sh[4]; const float* sc[4]; bf16_t* dst[4];
#pragma unroll
        for (int i = 0; i < 4; ++i) { const int r = pm * 256 + q * 4 + i; src[i] = F.out + (size_t)r * DM; const int mv = r / SEQ; sh[i] = mod + mv * 6144 + 3 * 1024; sc[i] = mod + mv * 6144 + 4 * 1024; dst[i] = XN + (size_t)r * DM; }
        norm_mod_rows<4>(src, F.pp->in[7], sh, sc, dst, F.lane);
    }
    VM_DRAIN();
    SYNC();
}

DEV size_t um(int row, int col, int W) { return ((size_t)(col / W) * NROWS + row) * W + (col % W); }
DEV size_t um_xbc(int row, int col) { return col < 1024 ? um(row, col, 64) : (size_t)NROWS * 1024 + um(row, col - 1024, 128); }
#ifndef CONV_FUSED
#define CONV_FUSED 1
#endif
typedef f32x4 AccT[2][2][4][2];
DEV u32x2 pack4(f32x4 a) { u32x2 w; w.x = pk2(a.x, a.y); w.y = pk2(a.z, a.w); return w; }
DEV u32x4 pack8(f32x4 a, f32x4 b) { u32x4 w; w.x = pk2(a.x, a.y); w.y = pk2(a.z, a.w); w.z = pk2(b.x, b.y); w.w = pk2(b.z, b.w); return w; }
DEV f32x4 sig4(f32x4 a) { f32x4 r; r.x = sigmoidf_(a.x); r.y = sigmoidf_(a.y); r.z = sigmoidf_(a.z); r.w = sigmoidf_(a.w); return r; }
DEV void unpack8(u32x4 w, f32x4& a, f32x4& b) { a.x = bflo(w.x); a.y = bfhi(w.x); a.z = bflo(w.y); a.w = bfhi(w.y); b.x = bflo(w.z); b.y = bfhi(w.z); b.z = bflo(w.w); b.w = bfhi(w.w); }

#ifndef HOST_EMU
template <int D> DEV float rot16(float v, int) { return __builtin_bit_cast(float, __builtin_amdgcn_update_dpp(0, __builtin_bit_cast(int, v), 0x120 + ((16 - D) & 15), 0xF, 0xF, false)); }
#else
template <int D> DEV float rot16(float v, int lane) { return __shfl(v, (lane & 48) | ((lane + D) & 15)); }
#endif
struct EpiInProj {
    static constexpr bool PERM = true;
    bf16_t *Z, *XBC, *QK, *V, *O, *MG; float* DTG; const float *cwx, *cbx, *cwq, *cbq; LAS unsigned char* ldsx;
    DEV void operator()(const AccT& acc, const pg8::Unit& u, int wr, int wc, int fr_in, int fq_in) const {
        int fr = fr_in, fq = fq_in; OPAQUE_V(fr); OPAQUE_V(fq);
        const int row0 = u.pm * 256 + wr * 64 + fr; const int t = u.pn;
        if (CONV_FUSED && t >= 4 && t < 14 && u.pm * 256 < NLAT) {
            const bool isx = t < 10; bf16_t* base = isx ? XBC : QK; const int ldc = isx ? 1536 : 1024, colt = isx ? (t - 4) * 256 : (t - 10) * 256;
            const float* cw = isx ? cwx : cwq; const float* cb = isx ? cbx : cbq; const float osc = (!isx && colt < 512) ? 0.125f : 1.0f;
            const int lane = fq * 16 + fr;
            LAS float* wl = (LAS float*)(ldsx + (wr * 4 + wc) * 1536);
#pragma unroll
            for (int r = 0; r < 6; ++r) { const int cidx = lane, col = colt + (cidx >> 5) * 128 + wc * 32 + (cidx & 31); wl[r * 64 + cidx] = r < 5 ? cw[(size_t)r * ldc + col] : cb[col]; }
            WAVE_LDS_FENCE();
#pragma unroll
            for (int bj = 0; bj < 2; ++bj)
#pragma unroll
                for (int n = 0; n < 2; ++n) { const int col0 = colt + bj * 128 + wc * 32 + 8 * fq + 4 * n;
#pragma unroll
                    for (int ai = 0; ai < 2; ++ai) { f32x4 o[4];
#pragma unroll
                        for (int i = 0; i < 4; ++i) { float r1[5], r2[5], l1[5], l2[5]; r1[4] = 0.f; r2[4] = 0.f; l1[0] = 0.f; l2[0] = 0.f;
                            const int ci = bj * 32 + 8 * fq + 4 * n + i; const float w0 = wl[ci], w1 = wl[64 + ci], w2 = wl[128 + ci], w3 = wl[192 + ci], w4 = wl[256 + ci], bb = wl[320 + ci];
#pragma unroll
                            for (int m = 0; m < 4; ++m) { const float v = acc[ai][bj][m][n][i]; r1[m] = rot16<1>(v, lane); r2[m] = rot16<2>(v, lane); l1[m + 1] = rot16<-1>(v, lane); l2[m + 1] = rot16<-2>(v, lane); }
#pragma unroll
                            for (int m = 0; m < 4; ++m) { const float v = acc[ai][bj][m][n][i];
                                const float n1 = fr < 15 ? r1[m] : r1[m + 1], n2 = fr < 14 ? r2[m] : r2[m + 1], p1 = fr > 0 ? l1[m + 1] : l1[m], p2 = fr > 1 ? l2[m + 1] : l2[m];
                                const float a = bb + w0 * p2 + w1 * p1 + w2 * v + w3 * n1 + w4 * n2;
                                o[m][i] = siluf_(a) * osc; }
                            }
#pragma unroll
                        for (int m = 0; m < 4; ++m) { const int rr = row0 + ai * 128 + m * 16; *(u32x2*)(base + (isx ? um_xbc(rr, col0) : um(rr, col0, 64))) = pack4(o[m]); }
                        MEM_FENCE(); SCHED_FENCE(); } }
        } else if (t < 30) {
            bf16_t* base; int ldc, colt, kind; bool act = false;
            if (t < 4) { base = Z; ldc = 1024; colt = t * 256; kind = 64; }
            else if (t < 10) { base = XBC; ldc = 1536; colt = (t - 4) * 256; kind = 1; }
            else if (t < 14) { base = QK; ldc = 1024; colt = (t - 10) * 256; kind = 64; }
            else if (t < 18) { base = V; ldc = 1024; colt = (t - 14) * 256; kind = 128; }
            else if (t < 22) { base = O; ldc = 1024; colt = (t - 18) * 256; act = true; kind = 128; }
            else { base = MG; ldc = 2048; colt = (t - 22) * 256; act = true; kind = 0; }
            const int col0 = colt + wc * 32 + 8 * fq;
#pragma unroll
            for (int ai = 0; ai < 2; ++ai)
#pragma unroll
                for (int m = 0; m < 4; ++m) { const int rr = row0 + ai * 128 + m * 16;
#pragma unroll
                    for (int bj = 0; bj < 2; ++bj) { f32x4 v0 = acc[ai][bj][m][0], v1 = acc[ai][bj][m][1]; const int cc = col0 + bj * 128;
                        if (act) { v0 = sig4(v0); v1 = sig4(v1); }
                        const size_t off = kind == 0 ? (size_t)rr * ldc + cc : (kind == 1 ? um_xbc(rr, cc) : um(rr, cc, kind));
                        *(u32x4*)(base + off) = pack8(v0, v1); }
                    MEM_FENCE(); SCHED_FENCE(); }
        } else if (wc < 2) {
#pragma unroll
            for (int ai = 0; ai < 2; ++ai)
#pragma unroll
                for (int m = 0; m < 4; ++m)
#pragma unroll
                    for (int n = 0; n < 2; ++n) { const int c0 = 32 * wc + 8 * fq + 4 * n;
                        *(f32x4*)(DTG + (size_t)(row0 + ai * 128 + m * 16) * 64 + c0) = acc[ai][0][m][n]; }
        }
    }
};
struct EpiG1 {
    static constexpr bool PERM = true;
    bf16_t* M1; const bf16_t* MG; const float* SSQ;
    DEV void operator()(const AccT& acc, const pg8::Unit& u, int wr, int wc, int fr, int fq) const {
        const int row0 = u.pm * 256 + wr * 64 + fr, col0 = u.pn * 256 + wc * 32 + 8 * fq;
#pragma unroll
        for (int ai = 0; ai < 2; ++ai)
#pragma unroll
            for (int m = 0; m < 4; ++m) { const size_t row = (size_t)(row0 + ai * 128 + m * 16);
                const f32x4* sq = (const f32x4*)(SSQ + row * 16); const f32x4 q0 = sq[0], q1 = sq[1], q2 = sq[2], q3 = sq[3];
                const float ss = ((q0.x + q0.y) + (q0.z + q0.w)) + ((q1.x + q1.y) + (q1.z + q1.w)) + ((q2.x + q2.y) + (q2.z + q2.w)) + ((q3.x + q3.y) + (q3.z + q3.w));
                const float rstd = RSQF(ss * (1.f / 1024.f) + EPS);
#pragma unroll
                for (int bj = 0; bj < 2; ++bj) { f32x4 g0, g1; unpack8(*(const u32x4*)(MG + row * 2048 + col0 + bj * 128), g0, g1);
                    *(u32x4*)(M1 + row * 1024 + col0 + bj * 128) = pack8(acc[ai][bj][m][0] * g0 * rstd, acc[ai][bj][m][1] * g1 * rstd); } }
    }
};
struct EpiG2 {
    static constexpr bool PERM = true;
    bf16_t* MERGED; const bf16_t* M1; const bf16_t* MG;
    DEV void operator()(const AccT& acc, const pg8::Unit& u, int wr, int wc, int fr, int fq) const {
        const int row0 = u.pm * 256 + wr * 64 + fr, col0 = u.pn * 256 + wc * 32 + 8 * fq;
#pragma unroll
        for (int ai = 0; ai < 2; ++ai)
#pragma unroll
            for (int m = 0; m < 4; ++m) { const size_t row = (size_t)(row0 + ai * 128 + m * 16);
#pragma unroll
                for (int bj = 0; bj < 2; ++bj) { f32x4 g0, g1, p0, p1; unpack8(*(const u32x4*)(MG + row * 2048 + 1024 + col0 + bj * 128), g0, g1);
                    unpack8(*(const u32x4*)(M1 + row * 1024 + col0 + bj * 128), p0, p1);
                    *(u32x4*)(MERGED + row * 1024 + col0 + bj * 128) = pack8(p0 + acc[ai][bj][m][0] * g0, p1 + acc[ai][bj][m][1] * g1); } }
    }
};
struct EpiG3 {
    static constexpr bool PERM = false;
    const float* x; float* x1; const float* mod;
    DEV void operator()(const AccT& acc, const pg8::Unit& u, int wr, int wc, int fr, int fq) const {
        const int row0 = u.pm * 256 + wr * 64 + fr, col0 = u.pn * 256 + wc * 32 + 4 * fq;
        const float* gate = mod + ((u.pm * 256) / SEQ) * 6144 + 2 * 1024;
#pragma unroll
        for (int bj = 0; bj < 2; ++bj)
#pragma unroll
            for (int n = 0; n < 2; ++n) { const int c = col0 + bj * 128 + n * 16; const f32x4 gv = *(const f32x4*)(gate + c);
#pragma unroll
                for (int ai = 0; ai < 2; ++ai)
#pragma unroll
                    for (int m = 0; m < 4; ++m) { const size_t off = (size_t)(row0 + ai * 128 + m * 16) * 1024 + c;
                        *(f32x4*)(x1 + off) = *(const f32x4*)(x + off) + gv * acc[ai][bj][m][n]; } }
    }
};
struct EpiRS {
    static constexpr bool PERM = true;
    float* LOGIT; bf16_t* HS;
    DEV void operator()(const AccT& acc, const pg8::Unit& u, int wr, int wc, int fr, int fq) const {
        const int row0 = u.pm * 256 + wr * 64 + fr;
        if (u.pn == 0) {
            {
#pragma unroll
                for (int ai = 0; ai < 2; ++ai)
#pragma unroll
                    for (int m = 0; m < 4; ++m)
#pragma unroll
                        for (int bj = 0; bj < 2; ++bj)
#pragma unroll
                            for (int n = 0; n < 2; ++n) { const int c = bj * 128 + wc * 32 + 8 * fq + 4 * n;
                                if (c < NEXP) *(f32x4*)(LOGIT + (size_t)(row0 + ai * 128 + m * 16) * NEXP + c) = acc[ai][bj][m][n]; }
            }
        } else {
            const int col0 = (u.pn - 1) * 128 + wc * 32 + 8 * fq;
#pragma unroll
            for (int ai = 0; ai < 2; ++ai)
#pragma unroll
                for (int m = 0; m < 4; ++m) { f32x4 h0, h1;
#pragma unroll
                    for (int i = 0; i < 4; ++i) { h0[i] = siluf_(acc[ai][0][m][0][i]) * acc[ai][1][m][0][i]; h1[i] = siluf_(acc[ai][0][m][1][i]) * acc[ai][1][m][1][i]; }
                    *(u32x4*)(HS + (size_t)(row0 + ai * 128 + m * 16) * 256 + col0) = pack8(h0, h1); }
        }
    }
};
struct EpiX1 {
    static constexpr bool PERM = true;
    bf16_t* H;
    DEV void operator()(const AccT& acc, const pg8::Unit& u, int wr, int wc, int fr, int fq) const {
        const int row0 = u.pm * 256 + wr * 64 + fr, col0 = u.pn * 128 + wc * 32 + 8 * fq;
#pragma unroll
        for (int ai = 0; ai < 2; ++ai)
#pragma unroll
            for (int m = 0; m < 4; ++m) { f32x4 h0, h1;
#pragma unroll
                for (int i = 0; i < 4; ++i) { h0[i] = siluf_(acc[ai][0][m][0][i]) * acc[ai][1][m][0][i]; h1[i] = siluf_(acc[ai][0][m][1][i]) * acc[ai][1][m][1][i]; }
                *(u32x4*)(H + (size_t)(row0 + ai * 128 + m * 16) * 256 + col0) = pack8(h0, h1); }
    }
};
struct EpiX2 {
    static constexpr bool PERM = true;
    bf16_t* Y; const int* sdst; const float* sw;
    DEV void operator()(const AccT& acc, const pg8::Unit& u, int wr, int wc, int fr, int fq) const {
        const int row0 = u.pm * 256 + wr * 64 + fr, col0 = u.pn * 256 + wc * 32 + 8 * fq;
        int dst[8]; float w[8];
#pragma unroll
        for (int r = 0; r < 8; ++r) { const int slot = row0 + (r >> 2) * 128 + (r & 3) * 16; dst[r] = sdst[slot]; w[r] = sw[slot]; }
#pragma unroll
        for (int ai = 0; ai < 2; ++ai)
#pragma unroll
            for (int m = 0; m < 4; ++m) { const int d = dst[ai * 4 + m]; const float ww = w[ai * 4 + m];
                if (d >= 0) {
#pragma unroll
                    for (int bj = 0; bj < 2; ++bj) *(u32x4*)(Y + (size_t)d * 1024 + col0 + bj * 128) = pack8(acc[ai][bj][m][0] * ww, acc[ai][bj][m][1] * ww); } }
    }
};
struct EpiSD {
    static constexpr bool PERM = true;
    bf16_t* YS;
    DEV void operator()(const AccT& acc, const pg8::Unit& u, int wr, int wc, int fr, int fq) const {
        const int row0 = u.pm * 256 + wr * 64 + fr, col0 = u.pn * 256 + wc * 32 + 8 * fq;
#pragma unroll
        for (int ai = 0; ai < 2; ++ai)
#pragma unroll
            for (int m = 0; m < 4; ++m) { bf16_t* rp = YS + (size_t)(row0 + ai * 128 + m * 16) * 1024 + col0;
#pragma unroll
                for (int bj = 0; bj < 2; ++bj) *(u32x4*)(rp + bj * 128) = pack8(acc[ai][bj][m][0], acc[ai][bj][m][1]);
                MEM_FENCE(); }
    }
};

DEV int chunk_row0(int b, int cc) { return cc < NCH ? b * SEQ + cc * CHUNK : NLAT + b * CTXL + (cc - NCH) * CHUNK; }

struct GateBias { const float *dtb, *ib, *fb; };
template <bool ML> DEV void tok_ag(const float* DTG, const float* aneg, const GateBias& gbv, size_t row, int dir, int hg, float& a, float& g) {
    if (!ML) { const float dt = softplusf_(DTG[row * 64 + dir * 16 + hg] + gbv.dtb[dir * 16 + hg]); a = dt * aneg[dir * 16 + hg]; g = dt; }
    else { const float ig = DTG[row * 64 + 32 + dir * 16 + hg] + gbv.ib[dir * 8 + hg]; a = logsigmoidf_(DTG[row * 64 + 32 + dir * 16 + 8 + hg] + gbv.fb[dir * 8 + hg]); g = EXPF(ig); }
}
struct CtxW { float w[5][8], b[8]; };
DEV void ctx_conv_prep(CtxW& c, const float* cw, const float* cb, int ld, int col) {
#pragma unroll
    for (int j = 0; j < 5; ++j) { const f32x4 a = *(const f32x4*)(cw + (size_t)j * ld + col), d = *(const f32x4*)(cw + (size_t)j * ld + col + 4);
#pragma unroll
        for (int i = 0; i < 4; ++i) { c.w[j][i] = a[i]; c.w[j][4 + i] = d[i]; } }
    const f32x4 a = *(const f32x4*)(cb + col), d = *(const f32x4*)(cb + col + 4);
#pragma unroll
    for (int i = 0; i < 4; ++i) { c.b[i] = a[i]; c.b[4 + i] = d[i]; }
}
DEV u32x4 ctx_conv_chunk(const CtxW& c, const bf16_t* buf, int ld  , int seg0, int kseg, int col) {
    float a[8];
#pragma unroll
    for (int i = 0; i < 8; ++i) a[i] = c.b[i];
#pragma unroll
    for (int j = 0; j < 5; ++j) { const int kk = kseg + j - 2;
        if (kk >= 0 && kk < CTXL) { f32x4 v0, v1; unpack8(*(const u32x4*)(buf + (ld == 1536 ? um_xbc(seg0 + kk, col) : um(seg0 + kk, col, 64))), v0, v1);
#pragma unroll
            for (int i = 0; i < 4; ++i) { a[i] += c.w[j][i] * v0[i]; a[4 + i] += c.w[j][4 + i] * v1[i]; } } }
    f32x4 o0, o1;
#pragma unroll
    for (int i = 0; i < 4; ++i) { o0[i] = siluf_(a[i]); o1[i] = siluf_(a[4 + i]); }
    return pack8(o0, o1);
}

DEV int chunk_order(int dir, int s) { return dir == 0 ? (s < NCHC ? NCH + s : s - NCHC) : (s < NCHC ? NCH + (NCHC - 1 - s) : NCH - 1 - (s - NCHC)); }
DEV void p5_scan(Frame& F) {
    constexpr int NS_ = BATCH * 2 * SSD_H * SSD_P * (SSD_N / 8); const int NS = NS_, NM = BATCH * 2 * ML_H * ML_PP * (ML_DK / 8);
    static_assert(NS_ % 64 == 0, "whole waves of SSD chains");
    for (int task = F.wave * F.G + F.bid; task * 64 < NS + NM; task += 8 * F.G) { const int idx = task * 64 + F.lane;
        if (idx >= NS + NM) continue;
        bf16_t* base; const float* dec; size_t cstride; int dstride, dir;
        if (idx < NS) { const int n8 = idx % 16, p = (idx / 16) % 64, hd = (idx / 1024) % 16; dir = (idx / 16384) % 2; const int b = idx / 32768;
            base = WSP(bf16_t, WS_STS) + (size_t)(b * 2 + dir) * NCHT * STS_CH + ((size_t)hd * 64 + p) * 128 + n8 * 8; cstride = STS_CH;
            dec = WSP(float, WS_DECS) + (size_t)(b * 2 + dir) * NCHT * 16 + hd; dstride = 16; }
        else { const int j = idx - NS; const int n8 = j % 8, p = (j / 8) % 144, hd = (j / 1152) % 8; dir = (j / 9216) % 2; const int b = j / 18432;
            base = WSP(bf16_t, WS_STM) + (size_t)(b * 2 + dir) * NCHT * STM_CH + ((size_t)hd * 144 + p) * 64 + n8 * 8; cstride = STM_CH;
            dec = WSP(float, WS_DECM) + (size_t)(b * 2 + dir) * NCHT * 8 + hd; dstride = 8; }
        f32x4 c0 = {0.f, 0.f, 0.f, 0.f}, c1 = {0.f, 0.f, 0.f, 0.f};
        constexpr int UB = (NCHT % 10 == 0) ? 10 : ((NCHT % 2 == 0) ? 2 : 1);
        for (int s0 = 0; s0 < NCHT; s0 += UB) {
            u32x4 v[UB]; float d[UB];
#pragma unroll
            for (int j = 0; j < UB; ++j) { const int cc = chunk_order(dir, s0 + j); v[j] = *(const u32x4*)(base + (size_t)cc * cstride); d[j] = dec[cc * dstride]; }
#pragma unroll
            for (int j = 0; j < UB; ++j) { const int cc = chunk_order(dir, s0 + j);
                if (cc < NCH) *(u32x4*)(base + (size_t)cc * cstride) = pack8(c0, c1);
                f32x4 a0, a1; unpack8(v[j], a0, a1); c0 = c0 * d[j] + a0; c1 = c1 * d[j] + a1; }
        }
    }
}

DEV bf16x8 tr_frag(const LAS bf16_t* T, int LD, int k0, int c0, int lane) {
    const LAS bf16_t* p0 = T + (k0 + 8 * (lane >> 4) + ((lane & 15) >> 2)) * LD + c0 + 4 * (lane & 3);
    const s16x4 a = lds_tr16(p0), b = lds_tr16(p0 + 4 * LD);
    bf16x8 r; r[0] = a[0]; r[1] = a[1]; r[2] = a[2]; r[3] = a[3]; r[4] = b[0]; r[5] = b[1]; r[6] = b[2]; r[7] = b[3]; return r;
}
DEV bf16x8 tr_frag8(const LAS bf16_t* T, int LD, int k0, int c0, int lane) {
    const LAS bf16_t* p0 = T + (k0 + 8 * (lane >> 4) + ((lane & 15) >> 2)) * LD + c0 + 8 * (lane & 3);
    const s16x4 a = lds_tr16(p0), b = lds_tr16(p0 + 4 * LD);
    bf16x8 r; r[0] = a[0]; r[1] = a[1]; r[2] = a[2]; r[3] = a[3]; r[4] = b[0]; r[5] = b[1]; r[6] = b[2]; r[7] = b[3]; return r;
}
DEV bf16x8 row_frag(const LAS bf16_t* T, int LD, int r0, int k0, int lane) { return *(const LAS bf16x8*)(T + (r0 + (lane & 15)) * LD + k0 + 8 * (lane >> 4)); }
DEV float gtv(u32x2 g, int i) { return i == 0 ? bflo(g.x) : (i == 1 ? bfhi(g.x) : (i == 2 ? bflo(g.y) : bfhi(g.y))); }

DEV void s3v2_ssd(Frame& F, int b, int cc, int gi, const float* aneg) {
    constexpr int LDC = 136, LDX = 80;
    const bf16_t* XBC = WSP(bf16_t, WS_XBC); const float* DTG = WSP(float, WS_DTG); const bf16_t* Z = WSP(bf16_t, WS_Z); bf16_t* YP = WSP(bf16_t, WS_YPRE); float* SSQ = WSP(float, WS_SSQ);
    LAS bf16_t* CQ = (LAS bf16_t*)F.lds;
    LAS bf16_t* GLB = CQ + 128 * LDC;
    LAS bf16_t* XS = GLB + 128 * LDC;
    LAS bf16_t* STF = XS + 128 * LDX;
    LAS bf16_t* STB = STF + 64 * LDC;
    LAS float* Pf = (LAS float*)(STB + 64 * LDC);
    LAS float* Eb = Pf + 128; LAS float* gf = Eb + 128; LAS float* gb = gf + 128; LAS float* itf = gb + 128; LAS float* itb = itf + 128;
    int tid_ = F.tid; OPAQUE_V(tid_);
    const int row0 = chunk_row0(b, cc), w = F.wave, tid = tid_, lane = tid & 63, lq = lane >> 4, lc = lane & 15;
    SYNC();
    for (int idx = tid; idx < 128 * 16; idx += NTHR) { const int k = idx >> 4, n8 = idx & 15;
        *(LAS u32x4*)(CQ + k * LDC + n8 * 8) = *(const u32x4*)(XBC + um_xbc(row0 + k, 1280 + gi * 128 + n8 * 8));
        *(LAS u32x4*)(GLB + k * LDC + n8 * 8) = *(const u32x4*)(XBC + um_xbc(row0 + k, 1024 + gi * 128 + n8 * 8)); }
    u32x4 rx[2], rsf[2], rsb[2]; float rdt[2];
#define S3S_LOAD(hh) do { const int hg_ = gi * 8 + (hh); \
        _Pragma("unroll") for (int j_ = 0; j_ < 2; ++j_) { const int id_ = tid + NTHR * j_; \
            rx[j_] = *(const u32x4*)(XBC + um_xbc(row0 + (id_ >> 3), hg_ * 64 + (id_ & 7) * 8)); \
            rsf[j_] = *(const u32x4*)(WSP(bf16_t, WS_STS) + ((size_t)(b * 2 + 0) * NCHT + cc) * STS_CH + (size_t)hg_ * 8192 + (size_t)id_ * 8); \
            rsb[j_] = *(const u32x4*)(WSP(bf16_t, WS_STS) + ((size_t)(b * 2 + 1) * NCHT + cc) * STS_CH + (size_t)hg_ * 8192 + (size_t)id_ * 8); \
            } \
        if (w < 2) { rdt[0] = DTG[(size_t)(row0 + lane) * 64 + w * 16 + hg_]; rdt[1] = DTG[(size_t)(row0 + 64 + lane) * 64 + w * 16 + hg_]; } } while (0)
    S3S_LOAD(0);
    SYNC();
    bf16x8 aC[4];
#pragma unroll
    for (int ns = 0; ns < 4; ++ns) aC[ns] = row_frag(CQ, LDC, w * 16, ns * 32, lane);
    u32x2 Gt[8];
#pragma unroll
    for (int ct = 0; ct < 8; ++ct) { f32x4 z = {0.f, 0.f, 0.f, 0.f};
#pragma unroll
        for (int ns = 0; ns < 4; ++ns) z = mfma16(row_frag(GLB, LDC, ct * 16, ns * 32, lane), aC[ns], z);
        Gt[ct] = pack4(z); }
    TOUCH(rx[0]); TOUCH(rx[1]); TOUCH(rsf[0]); TOUCH(rsf[1]); TOUCH(rsb[0]); TOUCH(rsb[1]); TOUCH(rdt[0]); TOUCH(rdt[1]);
#pragma unroll 1
    for (int h = 0; h < 8; ++h) {
        const int hg = gi * 8 + h;
        SYNC();
#pragma unroll
        for (int j = 0; j < 2; ++j) { const int id = tid + NTHR * j;
            *(LAS u32x4*)(XS + (id >> 3) * LDX + (id & 7) * 8) = rx[j];
            *(LAS u32x4*)(STF + (id >> 4) * LDC + (id & 15) * 8) = rsf[j];
            *(LAS u32x4*)(STB + (id >> 4) * LDC + (id & 15) * 8) = rsb[j]; }
        if (w < 2) { const float an = aneg[w * 16 + hg], db = F.pp->in[11][w * 16 + hg]; rdt[0] = softplusf_(rdt[0] + db); rdt[1] = softplusf_(rdt[1] + db); const float a0 = rdt[0] * an, a1 = rdt[1] * an;
            const float p0 = wave_incl_scan(a0, lane); const float t0 = __shfl(p0, 63);
            const float p1 = wave_incl_scan(a1, lane) + t0; const float T = __shfl(p1, 63);
            if (w == 0) { Pf[lane] = p0; Pf[64 + lane] = p1; gf[lane] = rdt[0]; gf[64 + lane] = rdt[1]; itf[lane] = EXPF(p0); itf[64 + lane] = EXPF(p1); }
            else { const float e0 = p0 - a0, e1 = p1 - a1; Eb[lane] = e0; Eb[64 + lane] = e1; gb[lane] = rdt[0]; gb[64 + lane] = rdt[1]; itb[lane] = EXPF(T - e0); itb[64 + lane] = EXPF(T - e1); } }
        if (h + 1 < 8) S3S_LOAD(h + 1);
        SYNC();
        const u32x4 zc0 = *(const u32x4*)(Z + um(row0 + 16 * w + (lane >> 3), hg * 64 + (lane & 7) * 8, 64)), zc1 = *(const u32x4*)(Z + um(row0 + 16 * w + (lane >> 3) + 8, hg * 64 + (lane & 7) * 8, 64));
        { const int q = w * 16 + lc; const float pfq = Pf[q], ebq = Eb[q];
#pragma unroll
          for (int ct = 0; ct < 8; ++ct) { const int k0 = ct * 16 + 4 * lq, rel = ct - w; f32x4 fac;
              if (rel < 0) { const f32x4 pk = *(const LAS f32x4*)(Pf + k0), gk = *(const LAS f32x4*)(gf + k0);
#pragma unroll
                  for (int i = 0; i < 4; ++i) fac[i] = EXPF(pfq - pk[i]) * gk[i]; }
              else if (rel > 0) { const f32x4 ek = *(const LAS f32x4*)(Eb + k0), gk = *(const LAS f32x4*)(gb + k0);
#pragma unroll
                  for (int i = 0; i < 4; ++i) fac[i] = EXPF(ek[i] - ebq) * gk[i]; }
              else { const f32x4 pk = *(const LAS f32x4*)(Pf + k0), gfk = *(const LAS f32x4*)(gf + k0), ek = *(const LAS f32x4*)(Eb + k0), gbk = *(const LAS f32x4*)(gb + k0);
#pragma unroll
                  for (int i = 0; i < 4; ++i) { const int d = lc - (4 * lq + i);
                      fac[i] = d > 0 ? EXPF(pfq - pk[i]) * gfk[i] : (d < 0 ? EXPF(ek[i] - ebq) * gbk[i] : gfk[i] + gbk[i]); } }
              f32x4 gv; gv[0] = bflo(Gt[ct].x); gv[1] = bfhi(Gt[ct].x); gv[2] = bflo(Gt[ct].y); gv[3] = bfhi(Gt[ct].y);
              *(LAS u32x2*)(GLB + q * LDC + k0) = pack4(gv * fac); } }
        WAVE_LDS_FENCE();
        bf16x8 aG[4];
#pragma unroll
        for (int ks = 0; ks < 4; ++ks) aG[ks] = row_frag(GLB, LDC, w * 16, ks * 32, lane);
        float iqf[4], iqb[4];
#pragma unroll
        for (int i = 0; i < 4; ++i) { iqf[i] = itf[w * 16 + 4 * lq + i]; iqb[i] = itb[w * 16 + 4 * lq + i]; }
        WAVE_LDS_FENCE();
        LAS float* OUTW = (LAS float*)(GLB + w * 16 * LDC);
#pragma unroll 1
        for (int pt = 0; pt < 4; ++pt) { f32x4 a1 = {0.f, 0.f, 0.f, 0.f}, af = {0.f, 0.f, 0.f, 0.f}, ab = {0.f, 0.f, 0.f, 0.f};
#pragma unroll
            for (int ks = 0; ks < 4; ++ks) a1 = mfma16(aG[ks], tr_frag(XS, LDX, ks * 32, pt * 16, lane), a1);
#pragma unroll
            for (int ns = 0; ns < 4; ++ns) { af = mfma16(aC[ns], row_frag(STF, LDC, pt * 16, ns * 32, lane), af); ab = mfma16(aC[ns], row_frag(STB, LDC, pt * 16, ns * 32, lane), ab); }
#pragma unroll
            for (int i = 0; i < 4; ++i) OUTW[(4 * lq + i) * (LDC / 2) + pt * 16 + lc] = a1[i] + iqf[i] * af[i] + iqb[i] * ab[i]; }
        WAVE_LDS_FENCE();
        if (h + 1 < 8) { TOUCH(rx[0]); TOUCH(rx[1]); TOUCH(rsf[0]); TOUCH(rsf[1]); TOUCH(rsb[0]); TOUCH(rsb[1]); TOUCH(rdt[0]); TOUCH(rdt[1]); }
        const float dsk = F.pp->in[13][hg]; const float* ng = F.pp->in[14] + hg * 64 + (lane & 7) * 8;
        const f32x4 ng0 = *(const f32x4*)ng, ng1 = *(const f32x4*)(ng + 4);
#pragma unroll
        for (int r = 0; r < 2; ++r) { const int ql = (lane >> 3) + 8 * r, ch = lane & 7; const size_t row = (size_t)(row0 + 16 * w + ql);
            const f32x4 y0 = *(const LAS f32x4*)(OUTW + ql * (LDC / 2) + ch * 8), y1 = *(const LAS f32x4*)(OUTW + ql * (LDC / 2) + ch * 8 + 4);
            f32x4 x0, x1, z0, z1; unpack8(*(const LAS u32x4*)(XS + (16 * w + ql) * LDX + ch * 8), x0, x1); unpack8(r == 0 ? zc0 : zc1, z0, z1);
            f32x4 t0, t1; float ss = 0.f;
#pragma unroll
            for (int i = 0; i < 4; ++i) { t0[i] = (y0[i] + dsk * x0[i]) * siluf_(z0[i]); t1[i] = (y1[i] + dsk * x1[i]) * siluf_(z1[i]); ss += t0[i] * t0[i] + t1[i] * t1[i]; }
            *(u32x4*)(YP + row * 1024 + hg * 64 + ch * 8) = pack8(t0 * ng0, t1 * ng1);
            ss += __shfl_xor(ss, 1); ss += __shfl_xor(ss, 2); ss += __shfl_xor(ss, 4);
            if (ch == 0) SSQ[row * 16 + hg] = ss; }
    }
#undef S3S_LOAD
}

struct MlRegs { u32x4 q[2], k[2], v[4], sf[3], sb[3]; float g[4]; };
DEV void s3v2_ml_load(Frame& F, MlRegs& R, int b, int cc, int hd) {
    const bf16_t* QK = WSP(bf16_t, WS_QK); const bf16_t* V = WSP(bf16_t, WS_V); const float* DTG = WSP(float, WS_DTG);
    int tid_ = F.tid; OPAQUE_V(tid_);
    const int row0 = chunk_row0(b, cc), tid = tid_, lane = tid & 63, w = F.wave;
#pragma unroll
    for (int j = 0; j < 2; ++j) { const int id = tid + NTHR * j; R.q[j] = *(const u32x4*)(QK + um(row0 + (id >> 3), hd * 64 + (id & 7) * 8, 64)); R.k[j] = *(const u32x4*)(QK + um(row0 + (id >> 3), 512 + hd * 64 + (id & 7) * 8, 64)); }
#pragma unroll
    for (int j = 0; j < 4; ++j) { const int id = tid + NTHR * j; R.v[j] = *(const u32x4*)(V + um(row0 + (id >> 4), hd * 128 + (id & 15) * 8, 128)); }
#pragma unroll
    for (int j = 0; j < 3; ++j) { const int id = tid + NTHR * j; if (id < 144 * 8) {
        R.sf[j] = *(const u32x4*)(WSP(bf16_t, WS_STM) + ((size_t)(b * 2 + 0) * NCHT + cc) * STM_CH + (size_t)hd * 9216 + (size_t)id * 8);
        R.sb[j] = *(const u32x4*)(WSP(bf16_t, WS_STM) + ((size_t)(b * 2 + 1) * NCHT + cc) * STM_CH + (size_t)hd * 9216 + (size_t)id * 8); } }
    if (w < 2) { R.g[0] = DTG[(size_t)(row0 + lane) * 64 + 32 + w * 16 + hd]; R.g[1] = DTG[(size_t)(row0 + 64 + lane) * 64 + 32 + w * 16 + hd];
                 R.g[2] = DTG[(size_t)(row0 + lane) * 64 + 32 + w * 16 + 8 + hd]; R.g[3] = DTG[(size_t)(row0 + 64 + lane) * 64 + 32 + w * 16 + 8 + hd]; }
}
DEV void s3v2_ml_item(Frame& F, MlRegs& R, int b, int cc, int hd, bool has_next, int nb, int ncc, int nhd) {
    constexpr int LDQ = 72, LDG = 136, LDV = 144;
    LAS bf16_t* CQ = (LAS bf16_t*)F.lds;
    LAS bf16_t* GLB = CQ + 128 * LDQ;
    LAS bf16_t* XS = GLB + 128 * LDG;
    LAS bf16_t* STF = XS + 128 * LDV;
    LAS bf16_t* STB = STF + 144 * LDQ;
    LAS float* Pf = (LAS float*)(STB + 144 * LDQ); LAS float* Eb = Pf + 128; LAS float* gf = Eb + 128; LAS float* gb = gf + 128; LAS float* itf = gb + 128; LAS float* itb = itf + 128;
    int tid_ = F.tid; OPAQUE_V(tid_);
    const int row0 = chunk_row0(b, cc), w = F.wave, tid = tid_, lane = tid & 63, lq = lane >> 4, lc = lane & 15;
    SYNC();
#pragma unroll
    for (int j = 0; j < 2; ++j) { const int id = tid + NTHR * j; *(LAS u32x4*)(CQ + (id >> 3) * LDQ + (id & 7) * 8) = R.q[j]; *(LAS u32x4*)(GLB + (id >> 3) * LDQ + (id & 7) * 8) = R.k[j]; }
#pragma unroll
    for (int j = 0; j < 4; ++j) { const int id = tid + NTHR * j; *(LAS u32x4*)(XS + (id >> 4) * LDV + (id & 15) * 8) = R.v[j]; }
    if (tid < 256) { const int k = tid >> 1, hf = tid & 1; u32x4 o = {0u, 0u, 0u, 0u}; if (hf == 0) o.x = 0x3F80u; *(LAS u32x4*)(XS + k * LDV + 128 + hf * 8) = o; }
#pragma unroll
    for (int j = 0; j < 3; ++j) { const int id = tid + NTHR * j; if (id < 144 * 8) { *(LAS u32x4*)(STF + (id >> 3) * LDQ + (id & 7) * 8) = R.sf[j]; *(LAS u32x4*)(STB + (id >> 3) * LDQ + (id & 7) * 8) = R.sb[j]; } }
    if (w < 2) { const float ibv = F.pp->in[17][w * 8 + hd], fbv = F.pp->in[18][w * 8 + hd];
        const float a0 = logsigmoidf_(R.g[2] + fbv), a1 = logsigmoidf_(R.g[3] + fbv), g0 = EXPF(R.g[0] + ibv), g1 = EXPF(R.g[1] + ibv);
        const float p0 = wave_incl_scan(a0, lane); const float t0 = __shfl(p0, 63);
        const float p1 = wave_incl_scan(a1, lane) + t0; const float T = __shfl(p1, 63);
        if (w == 0) { Pf[lane] = p0; Pf[64 + lane] = p1; gf[lane] = g0; gf[64 + lane] = g1; itf[lane] = EXPF(p0); itf[64 + lane] = EXPF(p1); }
        else { const float e0 = p0 - a0, e1 = p1 - a1; Eb[lane] = e0; Eb[64 + lane] = e1; gb[lane] = g0; gb[64 + lane] = g1; itb[lane] = EXPF(T - e0); itb[64 + lane] = EXPF(T - e1); } }
    if (has_next) s3v2_ml_load(F, R, nb, ncc, nhd);
    SYNC();
    bf16x8 aC[2];
#pragma unroll
    for (int ns = 0; ns < 2; ++ns) aC[ns] = row_frag(CQ, LDQ, w * 16, ns * 32, lane);
    u32x2 Gt[8];
#pragma unroll
    for (int ct = 0; ct < 8; ++ct) { f32x4 z = {0.f, 0.f, 0.f, 0.f};
#pragma unroll
        for (int ns = 0; ns < 2; ++ns) z = mfma16(row_frag(GLB, LDQ, ct * 16, ns * 32, lane), aC[ns], z);
        Gt[ct] = pack4(z); }
    SYNC();
    u32x4 oc[4];
#pragma unroll
    for (int r = 0; r < 4; ++r) oc[r] = *(const u32x4*)(WSP(bf16_t, WS_O) + um(row0 + 16 * w + (lane >> 4) + 4 * r, hd * 128 + (lane & 15) * 8, 128));
    bf16x8 aG[2][4]; f32x4 rden[2]; float iq[2][4];
#pragma unroll
    for (int dir = 0; dir < 2; ++dir) {
        const LAS float* PE = dir == 0 ? Pf : Eb; const LAS float* gg = dir == 0 ? gf : gb; const LAS float* it = dir == 0 ? itf : itb; const LAS bf16_t* ST = dir == 0 ? STF : STB;
#pragma unroll
        for (int i = 0; i < 4; ++i) iq[dir][i] = it[w * 16 + 4 * lq + i];
        WAVE_LDS_FENCE();
        { const int q = w * 16 + lc; const float peq = PE[q];
#pragma unroll
          for (int ct = 0; ct < 8; ++ct) { const int k0 = ct * 16 + 4 * lq, rel = ct - w; const bool tile_on = dir == 0 ? rel <= 0 : rel >= 0;
              u32x2 o = {0u, 0u};
              if (tile_on) { const f32x4 pek = *(const LAS f32x4*)(PE + k0), gk = *(const LAS f32x4*)(gg + k0); f32x4 fac;
#pragma unroll
                  for (int i = 0; i < 4; ++i) { const int d = lc - (4 * lq + i); const bool on = rel != 0 || (dir == 0 ? d >= 0 : d <= 0);
                      fac[i] = on ? EXPF(dir == 0 ? peq - pek[i] : pek[i] - peq) * gk[i] : 0.f; }
                  f32x4 gv; gv[0] = bflo(Gt[ct].x); gv[1] = bfhi(Gt[ct].x); gv[2] = bflo(Gt[ct].y); gv[3] = bfhi(Gt[ct].y);
                  o = pack4(gv * fac); }
              *(LAS u32x2*)(GLB + q * LDG + k0) = o; } }
        WAVE_LDS_FENCE();
#pragma unroll
        for (int ks = 0; ks < 4; ++ks) aG[dir][ks] = row_frag(GLB, LDG, w * 16, ks * 32, lane);
        f32x4 a1 = {0.f, 0.f, 0.f, 0.f}, a2 = {0.f, 0.f, 0.f, 0.f};
#pragma unroll
        for (int ks = 0; ks < 4; ++ks) a1 = mfma16(aG[dir][ks], tr_frag(XS, LDV, ks * 32, 128, lane), a1);
#pragma unroll
        for (int ns = 0; ns < 2; ++ns) a2 = mfma16(aC[ns], row_frag(ST, LDQ, 128, ns * 32, lane), a2);
#pragma unroll
        for (int i = 0; i < 4; ++i) { const float dv = a1[i] + iq[dir][i] * a2[i]; rden[dir][i] = RCPF(fmaxf(fabsf(__shfl(dv, lane & 48)), 1.0f)); }
    }
    WAVE_LDS_FENCE();
    float ss[4] = {0.f, 0.f, 0.f, 0.f};
#pragma unroll 1
    for (int pt = 0; pt < 8; ++pt) { f32x4 af = {0.f, 0.f, 0.f, 0.f}, ab = {0.f, 0.f, 0.f, 0.f}, sf = {0.f, 0.f, 0.f, 0.f}, sb = {0.f, 0.f, 0.f, 0.f};
#pragma unroll
        for (int ks = 0; ks < 4; ++ks) { const bf16x8 xb = tr_frag(XS, LDV, ks * 32, pt * 16, lane); af = mfma16(aG[0][ks], xb, af); ab = mfma16(aG[1][ks], xb, ab); }
#pragma unroll
        for (int ns = 0; ns < 2; ++ns) { sf = mfma16(aC[ns], row_frag(STF, LDQ, pt * 16, ns * 32, lane), sf); sb = mfma16(aC[ns], row_frag(STB, LDQ, pt * 16, ns * 32, lane), sb); }
#pragma unroll
        for (int i = 0; i < 4; ++i) { const float hv = (af[i] + iq[0][i] * sf[i]) * rden[0][i] + (ab[i] + iq[1][i] * sb[i]) * rden[1][i]; ss[i] += hv * hv;
            GLB[(w * 16 + 4 * lq + i) * LDG + pt * 16 + lc] = (bf16_t)f2bf(hv); } }
    LAS float* rsw = itb + 128 + w * 16;
#pragma unroll
    for (int i = 0; i < 4; ++i) { float sv = ss[i]; sv += __shfl_xor(sv, 1); sv += __shfl_xor(sv, 2); sv += __shfl_xor(sv, 4); sv += __shfl_xor(sv, 8);
        if (lc == 0) rsw[4 * lq + i] = RSQF(sv * (1.f / 128.f) + EPS); }
    WAVE_LDS_FENCE();
    if (has_next) {
#pragma unroll
        for (int j = 0; j < 2; ++j) { TOUCH(R.q[j]); TOUCH(R.k[j]); }
#pragma unroll
        for (int j = 0; j < 4; ++j) TOUCH(R.v[j]);
#pragma unroll
        for (int j = 0; j < 3; ++j) { TOUCH(R.sf[j]); TOUCH(R.sb[j]); }
        TOUCH(R.g[0]); TOUCH(R.g[1]); TOUCH(R.g[2]); TOUCH(R.g[3]); }
    bf16_t* HP = WSP(bf16_t, WS_HP); const float* ng = F.pp->in[19] + hd * 128 + (lane & 15) * 8;
    const f32x4 ng0 = *(const f32x4*)ng, ng1 = *(const f32x4*)(ng + 4);
#pragma unroll
    for (int r = 0; r < 4; ++r) { const int ql = (lane >> 4) + 4 * r, ch = lane & 15; const size_t row = (size_t)(row0 + 16 * w + ql); const float rsq = rsw[ql];
        f32x4 h0, h1, o0, o1; unpack8(*(const LAS u32x4*)(GLB + (w * 16 + ql) * LDG + ch * 8), h0, h1); unpack8(oc[r], o0, o1);
        *(u32x4*)(HP + row * 1024 + hd * 128 + ch * 8) = pack8(h0 * rsq * ng0 * o0, h1 * rsq * ng1 * o1); }
}
DEV void p6v2_outputs(Frame& F) {
    LAS float* aneg_l = (LAS float*)(F.lds + LDS_BYTES - 256);
    if (F.tid < 32) aneg_l[F.tid] = -EXPF(F.pp->in[12][F.tid]);
    SYNC();
    const int nS = BATCH * NCH * 2, nM = BATCH * NCH * 8;
#pragma unroll 1
    for (int it = F.bid; it < nS; it += F.G) { const int b = it / (NCH * 2), r = it % (NCH * 2); s3v2_ssd(F, b, r / 2, r % 2, (const float*)aneg_l); }
    SYNC();
    MlRegs R;
    if (F.bid < nM) { const int it = F.bid; s3v2_ml_load(F, R, it / (NCH * 8), (it % (NCH * 8)) / 8, it % 8);
#pragma unroll
        for (int j = 0; j < 2; ++j) { TOUCH(R.q[j]); TOUCH(R.k[j]); }
#pragma unroll
        for (int j = 0; j < 4; ++j) TOUCH(R.v[j]);
#pragma unroll
        for (int j = 0; j < 3; ++j) { TOUCH(R.sf[j]); TOUCH(R.sb[j]); }
        TOUCH(R.g[0]); TOUCH(R.g[1]); TOUCH(R.g[2]); TOUCH(R.g[3]); }
#pragma unroll 1
    for (int it = F.bid; it < nM; it += F.G) { const int nx = it + F.G; const bool hn = nx < nM;
        s3v2_ml_item(F, R, it / (NCH * 8), (it % (NCH * 8)) / 8, it % 8, hn, nx / (NCH * 8), (nx % (NCH * 8)) / 8, nx % 8); }
    SYNC();
}

template <bool ML> struct S1K { static constexpr int NN = ML ? 64 : 128, LDB = ML ? 80 : 144, NHS = ML ? 1 : 4, PD = ML ? 128 : 64, XC = ML ? 144 : 256, LDXW = ML ? 144 : 272, NQ = ML ? 1 : 2, NXR = ML ? 4 : 8, NBK = ML ? 2 : 4, PPH = ML ? 144 : 64, CPR = NHS * PD / 8; };
template <bool ML> struct S1Regs { u32x4 x[S1K<ML>::NXR]; u32x4 bk[S1K<ML>::NBK]; float g[4]; };
DEV void s1_decode(int code, int& b, int& cc, int& gi) { b = code >> 20; cc = (code >> 8) & 0xfff; gi = code & 0xff; }
template <bool ML> DEV void s1_load(Frame& F, S1Regs<ML>& R, int code, int hq) {
    typedef S1K<ML> K; int b, cc, gi; s1_decode(code, b, cc, gi);
    const bf16_t* XBC = WSP(bf16_t, WS_XBC); const bf16_t* QK = WSP(bf16_t, WS_QK); const bf16_t* V = WSP(bf16_t, WS_V); const float* DTG = WSP(float, WS_DTG);
    int tid_ = F.tid; OPAQUE_V(tid_); const int tid = tid_, lane = tid & 63, w = F.wave, row0 = chunk_row0(b, cc);
    const bool isctx = cc >= NCH; const int seg0 = NLAT + b * CTXL, kseg0 = (cc - NCH) * CHUNK;
    if (ML || !isctx) {
#pragma unroll
        for (int j = 0; j < K::NXR; ++j) { const int id = tid + NTHR * j, rr = row0 + id / K::CPR, c8 = (id % K::CPR) * 8;
            R.x[j] = ML ? *(const u32x4*)(V + um(rr, gi * 128 + c8, 128)) : *(const u32x4*)(XBC + um_xbc(rr, (gi * 8 + hq * 4) * 64 + c8)); }
    } else { static_assert(NTHR % K::CPR == 0, "a thread's chunks share their columns");
        const int col = (gi * 8 + hq * 4) * 64 + (tid % K::CPR) * 8; CtxW cwv; ctx_conv_prep(cwv, F.pp->in[9], F.pp->in[10], 1536, col);
#pragma unroll
        for (int j = 0; j < K::NXR; ++j) { const int id = tid + NTHR * j; R.x[j] = ctx_conv_chunk(cwv, XBC, 1536, seg0, kseg0 + id / K::CPR, col); } }
    if (hq == 0) { const int ldb = ML ? 1024 : 1536;
        if (!isctx) {
#pragma unroll
            for (int j = 0; j < K::NBK; ++j) { const int id = tid + NTHR * j, k = id / (K::NN / 8), n8 = id % (K::NN / 8);
                R.bk[j] = ML ? *(const u32x4*)(QK + um(row0 + k, 512 + gi * 64 + n8 * 8, 64)) : *(const u32x4*)(XBC + um_xbc(row0 + k, 1024 + gi * 128 + n8 * 8)); }
        } else { static_assert(NTHR % (K::NN / 8) == 0, "a thread's chunks share their columns");
            const int col = (ML ? 512 + gi * 64 : 1024 + gi * 128) + (tid % (K::NN / 8)) * 8; CtxW cwv; ctx_conv_prep(cwv, ML ? F.pp->in[15] : F.pp->in[9], ML ? F.pp->in[16] : F.pp->in[10], ldb, col);
#pragma unroll
            for (int j = 0; j < K::NBK; ++j) { const int id = tid + NTHR * j; R.bk[j] = ctx_conv_chunk(cwv, ML ? QK : XBC, ldb, seg0, kseg0 + id / (K::NN / 8), col); } } }
    if (!ML) { const int dir = w >> 2, hg = gi * 8 + hq * 4 + (w & 3);
        R.g[0] = DTG[(size_t)(row0 + lane) * 64 + dir * 16 + hg]; R.g[1] = DTG[(size_t)(row0 + 64 + lane) * 64 + dir * 16 + hg]; }
    else if (w < 2) { R.g[0] = DTG[(size_t)(row0 + lane) * 64 + 32 + w * 16 + gi]; R.g[1] = DTG[(size_t)(row0 + 64 + lane) * 64 + 32 + w * 16 + gi];
                      R.g[2] = DTG[(size_t)(row0 + lane) * 64 + 32 + w * 16 + 8 + gi]; R.g[3] = DTG[(size_t)(row0 + 64 + lane) * 64 + 32 + w * 16 + 8 + gi]; }
}
template <bool ML> DEV void s1_stage(Frame& F, S1Regs<ML>& R, int code, int hq, bool has_next, int ncode, int nhq, const float* aneg) {
    typedef S1K<ML> K; int b, cc, gi; s1_decode(code, b, cc, gi);
    LAS bf16_t* BKN = (LAS bf16_t*)F.lds;
    LAS bf16_t* XW = BKN + 128 * K::LDB;
    LAS float* wl = (LAS float*)(XW + 128 * K::LDXW);
    int tid_ = F.tid; OPAQUE_V(tid_); const int tid = tid_, lane = tid & 63, w = F.wave;
    SYNC();
    if (hq == 0) {
#pragma unroll
        for (int j = 0; j < K::NBK; ++j) { const int id = tid + NTHR * j; *(LAS u32x4*)(BKN + (id / (K::NN / 8)) * K::LDB + (id % (K::NN / 8)) * 8) = R.bk[j]; } }
    u32x4 xc[K::NXR];
#pragma unroll
    for (int j = 0; j < K::NXR; ++j) xc[j] = R.x[j];
    float gc[4];
#pragma unroll
    for (int j = 0; j < 4; ++j) gc[j] = R.g[j];
    if (has_next) s1_load<ML>(F, R, ncode, nhq);
    if (!ML || w < 2) { const int dir = ML ? w : (w >> 2), hl = ML ? 0 : (w & 3), hg = ML ? gi : gi * 8 + hq * 4 + hl;
        float a0, a1, g0, g1;
        if (!ML) { const float db = F.pp->in[11][dir * 16 + hg], an = aneg[dir * 16 + hg]; g0 = softplusf_(gc[0] + db); g1 = softplusf_(gc[1] + db); a0 = g0 * an; a1 = g1 * an; }
        else { const float ibv = F.pp->in[17][dir * 8 + hg], fbv = F.pp->in[18][dir * 8 + hg]; g0 = EXPF(gc[0] + ibv); g1 = EXPF(gc[1] + ibv); a0 = logsigmoidf_(gc[2] + fbv); a1 = logsigmoidf_(gc[3] + fbv); }
        const float p0 = wave_incl_scan(a0, lane); const float t0 = __shfl(p0, 63);
        const float p1 = wave_incl_scan(a1, lane) + t0; const float T = __shfl(p1, 63);
        float w0, w1;
        if (dir == 0) { w0 = EXPF(T - p0) * g0; w1 = EXPF(T - p1) * g1; } else { w0 = EXPF(p0 - a0) * g0; w1 = EXPF(p1 - a1) * g1; }
        wl[(dir * K::NHS + hl) * 128 + lane] = w0; wl[(dir * K::NHS + hl) * 128 + 64 + lane] = w1;
        if (lane == 0) { float* dec = ML ? WSP(float, WS_DECM) + ((size_t)(b * 2 + dir) * NCHT + cc) * 8 + hg : WSP(float, WS_DECS) + ((size_t)(b * 2 + dir) * NCHT + cc) * 16 + hg; *dec = EXPF(T); } }
    SYNC();
#pragma unroll 1
    for (int dir = 0; dir < 2; ++dir) {
        if (dir == 1) SYNC();
#pragma unroll
        for (int j = 0; j < K::NXR; ++j) { const int id = tid + NTHR * j, k = id / K::CPR, c8 = id % K::CPR; const float wk = wl[(dir * K::NHS + (c8 * 8) / K::PD) * 128 + k];
            f32x4 v0, v1; unpack8(xc[j], v0, v1); *(LAS u32x4*)(XW + k * K::LDXW + c8 * 8) = pack8(v0 * wk, v1 * wk); }
        if (ML) { if (tid < 256) { const int k = tid >> 1, hf = tid & 1; u32x4 o = {0u, 0u, 0u, 0u}; if (hf == 0) o.x = f2bf(wl[dir * 128 + k]); *(LAS u32x4*)(XW + k * K::LDXW + 128 + hf * 8) = o; } }
        SYNC();
        if (dir == 1 && has_next) {
#pragma unroll
            for (int j = 0; j < K::NXR; ++j) TOUCH(R.x[j]);
#pragma unroll
            for (int j = 0; j < K::NBK; ++j) TOUCH(R.bk[j]);
            TOUCH(R.g[0]); TOUCH(R.g[1]); TOUCH(R.g[2]); TOUCH(R.g[3]); }
        constexpr int RT = K::NN / 16, CT = K::XC / 16;
        const int ct0 = w, ct1 = w + 8; const bool two = ct1 < CT;
        if (ct0 < CT) {
            bf16x8 bx0[4], bx1[4];
#pragma unroll
            for (int ks = 0; ks < 4; ++ks) { bx0[ks] = tr_frag(XW, K::LDXW, ks * 32, ct0 * 16, lane); bx1[ks] = two ? tr_frag(XW, K::LDXW, ks * 32, ct1 * 16, lane) : bx0[ks]; }
#pragma unroll 1
            for (int u = 0; u < RT / 2; ++u) {
                bf16x8 a0[4], a1[4];
#pragma unroll
                for (int ks = 0; ks < 4; ++ks) { a0[ks] = tr_frag8(BKN, K::LDB, ks * 32, u * 32, lane); a1[ks] = tr_frag8(BKN, K::LDB, ks * 32, u * 32 + 4, lane); }
                f32x4 c00 = {0.f, 0.f, 0.f, 0.f}, c01 = {0.f, 0.f, 0.f, 0.f}, c10 = {0.f, 0.f, 0.f, 0.f}, c11 = {0.f, 0.f, 0.f, 0.f};
#pragma unroll
                for (int ks = 0; ks < 4; ++ks) { c00 = mfma16(a0[ks], bx0[ks], c00); c01 = mfma16(a1[ks], bx0[ks], c01); }
                if (two) {
#pragma unroll
                    for (int ks = 0; ks < 4; ++ks) { c10 = mfma16(a0[ks], bx1[ks], c10); c11 = mfma16(a1[ks], bx1[ks], c11); } }
#pragma unroll
                for (int cs = 0; cs < 2; ++cs) { if (cs == 1 && !two) break;
                    const int pg = (cs ? ct1 : ct0) * 16 + (lane & 15), hl = pg / K::PPH, p = pg % K::PPH, hg = ML ? gi : gi * 8 + hq * 4 + hl, n = u * 32 + 8 * (lane >> 4);
                    bf16_t* dst = ML ? WSP(bf16_t, WS_STM) + ((size_t)(b * 2 + dir) * NCHT + cc) * STM_CH + ((size_t)hg * 144 + p) * 64 + n
                                     : WSP(bf16_t, WS_STS) + ((size_t)(b * 2 + dir) * NCHT + cc) * STS_CH + ((size_t)hg * 64 + p) * 128 + n;
                    *(u32x4*)dst = cs ? pack8(c10, c11) : pack8(c00, c01); }
            }
        }
    }
}
template <bool ML> DEV int s1_build_list(Frame& F, LAS int* list) {
    constexpr int nLS = BATCH * NCH * 2, nCS = BATCH * NCHC * 2, nLM = BATCH * NCH * 8, nCM = BATCH * NCHC * 8;
    const int excl = F.G >= 4 * nCS ? nCS : 0, GE = F.G - excl;
    int n = 0;
    if (!ML) {
        for (int it = F.bid; it < nLS; it += F.G) { const int b = it / (NCH * 2), r = it % (NCH * 2); if (F.tid == 0) list[n] = (b << 20) | ((r / 2) << 8) | (r % 2); ++n; }
        for (int it = F.G - 1 - F.bid; it < nCS; it += F.G) { const int b = it / (NCHC * 2), r = it % (NCHC * 2); if (F.tid == 0) list[n] = (b << 20) | ((NCH + r / 2) << 8) | (r % 2); ++n; }
    } else if (F.bid < GE) {
        for (int it = F.bid; it < nLM + nCM; it += GE) {
            int code;
            if (it < nLM) { const int b = it / (NCH * 8), r = it % (NCH * 8); code = (b << 20) | ((r / 8) << 8) | (r % 8); }
            else { const int j = it - nLM, b = j / (NCHC * 8), r = j % (NCHC * 8); code = (b << 20) | ((NCH + r / 8) << 8) | (r % 8); }
            if (F.tid == 0) list[n] = code; ++n; }
    }
    return n;
}
template <bool ML> DEV void s1_run(Frame& F, const float* aneg, LAS int* list) {
    typedef S1K<ML> K;
    const int n = s1_build_list<ML>(F, list);
    SYNC();
    const int nst = n * K::NQ;
    S1Regs<ML> R;
    if (nst > 0) { s1_load<ML>(F, R, list[0], 0);
#pragma unroll
        for (int j = 0; j < K::NXR; ++j) TOUCH(R.x[j]);
#pragma unroll
        for (int j = 0; j < K::NBK; ++j) TOUCH(R.bk[j]);
        TOUCH(R.g[0]); TOUCH(R.g[1]); TOUCH(R.g[2]); TOUCH(R.g[3]); }
#pragma unroll 1
    for (int st = 0; st < nst; ++st) { const int nx = st + 1; const bool hn = nx < nst;
        s1_stage<ML>(F, R, list[st / K::NQ], st % K::NQ, hn, hn ? list[nx / K::NQ] : 0, nx % K::NQ, aneg); }
    SYNC();
}
DEV void p4v2_local_states(Frame& F) {
    LAS float* aneg_l = (LAS float*)(F.lds + LDS_BYTES - 256);
    LAS int* list = (LAS int*)(F.lds + LDS_BYTES - 1024);
    if (F.tid < 32) aneg_l[F.tid] = -EXPF(F.pp->in[12][F.tid]);
    SYNC();
    s1_run<false>(F, (const float*)aneg_l, list);
    s1_run<true>(F, (const float*)aneg_l, list);
}

DEV void p12_route(Frame& F) {
    const float* LOGIT = WSP(float, WS_LOG); const float* rb = F.pp->in[24];
    int* ae = WSP(int, WS_ASGE); int* ar = WSP(int, WS_ASGR); float* aw = WSP(float, WS_ASGW);
    constexpr int LDT = NEXP + 1;
    LAS int* cntL = (LAS int*)(F.lds + 2 * 64 * LDT * 4);
    for (int e = F.tid; e < NEXP; e += NTHR) cntL[e] = 0;
    SYNC();
    constexpr int GS = NEXP / 8;
    const float NEG = -3.0e38f;
    for (int t = F.bid * 128 + F.tid; F.tid < 128 && t < NLAT; t += F.G * 128) {
        LAS float* tile = (LAS float*)F.lds + F.wave * (64 * LDT);
        { const int tw = t - F.lane;
          WAVE_LDS_FENCE();
          static_assert(NEXP <= 256, "one 16-byte piece per lane and row");
#pragma unroll 1
          for (int r0 = 0; r0 < 64; r0 += 16) { f32x4 v[16];
              const int c = F.lane * 4;
              if (c < NEXP) {
#pragma unroll
                  for (int r = 0; r < 16; ++r) v[r] = *(const f32x4*)(LOGIT + (size_t)(tw + r0 + r) * NEXP + c);
#pragma unroll
                  for (int r = 0; r < 16; ++r) { LAS float* d = tile + (r0 + r) * LDT + c; d[0] = v[r].x; d[1] = v[r].y; d[2] = v[r].z; d[3] = v[r].w; } } }
          WAVE_LDS_FENCE(); }
        const LAS float* lg = tile + F.lane * LDT;
        float gs[8];
#pragma unroll
        for (int g = 0; g < 8; ++g) { float m1 = NEG, m2 = NEG;
#pragma unroll 4
            for (int j = 0; j < GS; ++j) { const float v = sigmoidf_(lg[g * GS + j]) + rb[g * GS + j]; if (v > m1) { m2 = m1; m1 = v; } else if (v > m2) m2 = v; }
            gs[g] = m1 + m2; }
        unsigned selmask = 0u;
#pragma unroll
        for (int g = 0; g < 8; ++g) { int rank = 0;
#pragma unroll
            for (int gp = 0; gp < 8; ++gp) rank += (gs[gp] > gs[g] || (gs[gp] == gs[g] && gp < g)) ? 1 : 0;
            if (rank < TOPKG) selmask |= 1u << g; }
        float tv[8]; int ti[8];
#pragma unroll
        for (int i = 0; i < 8; ++i) { tv[i] = NEG; ti[i] = 0; }
        unsigned smk = selmask;
#pragma unroll 1
        for (int sg = 0; sg < TOPKG; ++sg) { const int g = __builtin_ctz(smk); smk &= smk - 1u;
#pragma unroll 2
            for (int j = 0; j < GS; ++j) { const int e = g * GS + j; float cv = sigmoidf_(lg[e]) + rb[e]; int ce = e;
#pragma unroll
                for (int i = 0; i < 8; ++i) { const bool gtv = cv > tv[i]; const float ov = tv[i]; const int oi = ti[i];
                    tv[i] = gtv ? cv : ov; ti[i] = gtv ? ce : oi; cv = gtv ? ov : cv; ce = gtv ? oi : ce; } }
        }
        float sc[8], ssum = 0.f;
#pragma unroll
        for (int i = 0; i < 8; ++i) { sc[i] = sigmoidf_(lg[ti[i]]); ssum += sc[i]; }
        const float inv = 2.5f / ssum;
#pragma unroll
        for (int i = 0; i < 8; ++i) { const int rk = ATOMIC_ADD_LDS(&cntL[ti[i]], 1); const int a = t * TOPK + i; ae[a] = ti[i]; ar[a] = rk; aw[a] = sc[i] * inv; }
    }
    SYNC();
    int* cm = WSP(int, WS_CMAT) + (size_t)F.bid * NEXP;
    for (int e = F.tid; e < NEXP; e += NTHR) cm[e] = cntL[e];
}
DEV void p13_slots(Frame& F) {
    int* ctl = WSP(int, WS_CTL); const int* cmat = WSP(int, WS_CMAT);
    LAS int* cl = (LAS int*)F.lds; LAS int* tb = cl + NEXP; LAS int* pl = tb + NEXP + 1;
    for (int e = F.tid; e < NEXP; e += NTHR) { int tot = 0, pre = 0;
        for (int b = 0; b < F.G; ++b) { const int v = cmat[(size_t)b * NEXP + e]; tot += v; pre += b < F.bid ? v : 0; }
        cl[e] = tot; pl[e] = pre; }
    SYNC();
    if (F.wave == 0) {
        int loc[EPL], sum = 0;
#pragma unroll
        for (int j = 0; j < EPL; ++j) { loc[j] = (cl[F.lane * EPL + j] + 255) >> 8; sum += loc[j]; }
        int inc = sum;
#pragma unroll
        for (int d = 1; d < 64; d <<= 1) { const int t = __shfl_up(inc, d); if (F.lane >= d) inc += t; }
        int run = inc - sum;
#pragma unroll
        for (int j = 0; j < EPL; ++j) { tb[F.lane * EPL + j] = run; run += loc[j]; }
        if (F.lane == 63) tb[NEXP] = run;
    }
    SYNC();
    const int* ae = WSP(int, WS_ASGE); const int* ar = WSP(int, WS_ASGR); const float* aw = WSP(float, WS_ASGW);
    int* stok = WSP(int, WS_STOK); int* sdst = WSP(int, WS_SDST); float* sw = WSP(float, WS_SW); int* texp = WSP(int, WS_TEXP);
    for (int t0 = F.bid * 128; t0 < NLAT; t0 += F.G * 128)
        for (int i = F.tid; i < 128 * TOPK; i += NTHR) { const int a = t0 * TOPK + i; if (a < NASG) { const int e = ae[a];
            const int slot = tb[e] * 256 + pl[e] + ar[a]; stok[slot] = a / TOPK; sdst[slot] = a; sw[slot] = aw[a]; } }
    for (int e = F.bid; e < NEXP; e += F.G) {
        for (int sl = tb[e] * 256 + cl[e] + F.tid; sl < tb[e + 1] * 256; sl += NTHR) { stok[sl] = 0; sdst[sl] = -1; sw[sl] = 0.f; }
        for (int t = tb[e] + F.tid; t < tb[e + 1]; t += NTHR) texp[t] = e;
    }
    if (F.bid == 0 && F.tid == 0) { ctl[1024] = tb[NEXP]; }
}
DEV void p_final(Frame& F) {
    const float* mod = WSP(float, WS_MOD); const bf16_t* Y = WSP(bf16_t, WS_Y); const bf16_t* YS = WSP(bf16_t, WS_YS); const float* gf = F.pp->in[31];
    const int gw = F.bid * 8 + F.wave, NGW = F.G * 8, lane = F.lane;
    for (int t = gw; t < NLAT; t += NGW) {
        const float* gate = mod + (t / SEQ) * 6144 + 5 * 1024;
        u32x4 yr[2][TOPK + 1];
#pragma unroll
        for (int j = 0; j < 2; ++j) {
#pragma unroll
            for (int k = 0; k < TOPK; ++k) yr[j][k] = *((const u32x4*)(Y + (size_t)(t * TOPK + k) * 1024) + lane + 64 * j);
            yr[j][TOPK] = *((const u32x4*)(YS + (size_t)t * 1024) + lane + 64 * j); }
        f32x4 v[2][2]; float ssq = 0.f;
#pragma unroll
        for (int j = 0; j < 2; ++j) { f32x4 a0 = {0.f, 0.f, 0.f, 0.f}, a1 = {0.f, 0.f, 0.f, 0.f};
#pragma unroll
            for (int k = 0; k <= TOPK; ++k) { f32x4 p0, p1; unpack8(yr[j][k], p0, p1); a0 += p0; a1 += p1; }
            const f32x4* xr = (const f32x4*)(F.out + (size_t)t * DM) + 2 * lane + 128 * j; const f32x4* gr = (const f32x4*)gate + 2 * lane + 128 * j;
            v[j][0] = xr[0] + gr[0] * a0; v[j][1] = xr[1] + gr[1] * a1;
#pragma unroll
            for (int h = 0; h < 2; ++h) ssq += (v[j][h].x * v[j][h].x + v[j][h].y * v[j][h].y) + (v[j][h].z * v[j][h].z + v[j][h].w * v[j][h].w); }
        const float rstd = RSQF(wave_sum(ssq) * (1.f / DM) + EPS);
#pragma unroll
        for (int j = 0; j < 2; ++j) { f32x4* orow = (f32x4*)(F.out + (size_t)t * DM) + 2 * lane + 128 * j; const f32x4* gg = (const f32x4*)gf + 2 * lane + 128 * j;
            orow[0] = v[j][0] * rstd * gg[0]; orow[1] = v[j][1] * rstd * gg[1]; }
    }
}

#ifndef HOST_EMU
#define XB_TMO      128
#define XB_XCNT(j)  (256  + 64 * (j))
#define XB_XSUB(j)  (1280 + 64 * (j))
#define XB_XGEN(j)  (2304 + 64 * (j))
#define XB_TOP      3328
#define XB_TOPGEN   3392
#define XCD_BAR_WORDS 3456
#define XB_SPIN_CAP (1u << 18)
__device__ __forceinline__ unsigned xb_ld(unsigned* p)              { return __hip_atomic_load(p, __ATOMIC_RELAXED, __HIP_MEMORY_SCOPE_AGENT); }
__device__ __forceinline__ unsigned xb_add(unsigned* p, unsigned v) { return __hip_atomic_fetch_add(p, v, __ATOMIC_RELAXED, __HIP_MEMORY_SCOPE_AGENT); }
__device__ __forceinline__ unsigned xb_xcc_id() { return (unsigned)__builtin_amdgcn_s_getreg((3 << 11) | 20) & 0xFu; }
#define XB_SPIN(cond, bar) do { unsigned _sp = 0; while (cond) { __builtin_amdgcn_s_sleep(1); \
    if ((++_sp & 255u) == 0u) { if (xb_ld(&(bar)[XB_TMO])) break; if (_sp > XB_SPIN_CAP) { atomicAdd(&(bar)[XB_TMO], 1u); break; } } } } while (0)
struct XcdBarrier { unsigned* bar; unsigned x; volatile LAS unsigned* st; };
__device__ __forceinline__ XcdBarrier xcd_barrier_post(unsigned* bar, volatile LAS unsigned* st) {
    XcdBarrier b; b.bar = bar; b.x = xb_xcc_id(); b.st = st;
    if (threadIdx.x == 0) (void)xb_add(&bar[XB_XCNT(b.x)], 1u);
    return b;
}
__device__ __forceinline__ void xcd_barrier_complete(unsigned* bar, unsigned x, unsigned& nloc, unsigned& nx) {
    const unsigned G = gridDim.x * gridDim.y * gridDim.z;
    unsigned sum, cnt, mine, sp = 0u;
    for (;;) {
        sum = 0u; cnt = 0u; mine = 0u;
#pragma unroll
        for (unsigned j = 0; j < 16; ++j) { const unsigned c = xb_ld(&bar[XB_XCNT(j)]); sum += c; cnt += (c > 0u) ? 1u : 0u; mine = (j == x) ? c : mine; }
        if (sum == G) break;
        __builtin_amdgcn_s_sleep(1);
        if ((++sp & 255u) == 0u) { if (xb_ld(&bar[XB_TMO])) break; if (sp > XB_SPIN_CAP) { atomicAdd(&bar[XB_TMO], 1u); break; } }
    }
    nloc = mine > 0u ? mine : 1u; nx = cnt > 0u ? cnt : 1u;
}
__device__ __forceinline__ void xcd_barrier(const XcdBarrier& b) {
    asm volatile("s_waitcnt vmcnt(0)" ::: "memory");
    __syncthreads();
    if (threadIdx.x == 0) {
        unsigned* bar = b.bar;
        __builtin_amdgcn_s_waitcnt(0);
        unsigned nloc = b.st[0], nx = b.st[1];
        if (nloc == 0u) { xcd_barrier_complete(bar, b.x, nloc, nx); b.st[0] = nloc; b.st[1] = nx; }
        const unsigned old = xb_add(&bar[XB_XSUB(b.x)], 1u);
        const unsigned gen = old / nloc;
        if (old + 1u == (gen + 1u) * nloc) {
            __builtin_amdgcn_fence(__ATOMIC_RELEASE, "agent");
            asm volatile("s_waitcnt vmcnt(0)" ::: "memory");
            const unsigned og = xb_add(&bar[XB_TOP], 1u);
            const unsigned tg = og / nx;
            if (og + 1u == (tg + 1u) * nx) xb_add(&bar[XB_TOPGEN], 1u);
            else XB_SPIN(xb_ld(&bar[XB_TOPGEN]) == tg, bar);
            __builtin_amdgcn_fence(__ATOMIC_ACQUIRE, "agent");
            xb_add(&bar[XB_XGEN(b.x)], 1u);
            asm volatile("s_waitcnt vmcnt(0)" ::: "memory");
        } else {
            XB_SPIN(xb_ld(&bar[XB_XGEN(b.x)]) == gen, bar);
            __builtin_amdgcn_fence(__ATOMIC_ACQUIRE, "agent");
            asm volatile("s_waitcnt vmcnt(0)" ::: "memory");
        }
    }
    __syncthreads();
}
#endif

#ifndef HOST_EMU
template <class T> __device__ __forceinline__ T* uni_ptr(T* p) { const unsigned long long v = (unsigned long long)p; const unsigned lo = __builtin_amdgcn_readfirstlane((unsigned)v), hi = __builtin_amdgcn_readfirstlane((unsigned)(v >> 32));
    typedef __attribute__((address_space(1))) T GT; GT* g = (GT*)(((unsigned long long)hi << 32) | lo); return (T*)g; }
#endif
#ifndef HOST_EMU
constexpr int WS_BAR_OFF = 16384;
constexpr int LDS_BARST = LDS_BYTES - 64;
#ifndef TPROBE_LO
#define TPROBE_LO -2
#define TPROBE_HI -2
#define TPROBE_MUL 0
#endif
__global__ void __launch_bounds__(NTHR, 2) fwd_megakernel(Params prm) {
    extern __shared__ __attribute__((aligned(16))) unsigned char lds_raw[];
    if (threadIdx.x < 4) ((LAS unsigned*)((LAS unsigned char*)lds_raw + LDS_BARST))[threadIdx.x] = 0u;
    __syncthreads();
    XcdBarrier gbar = xcd_barrier_post((unsigned*)(prm.ws + WS_CTL + WS_BAR_OFF), (volatile LAS unsigned*)((LAS unsigned char*)lds_raw + LDS_BARST));
    unsigned long long tp0 = 0ull, tp1 = 0ull;
    if (TPROBE_LO == 0) tp0 = __builtin_amdgcn_s_memrealtime();
#define GRID_SYNC() xcd_barrier(gbar)
#define PROBE_END(k) do { if ((k) == TPROBE_LO - 1) tp0 = __builtin_amdgcn_s_memrealtime(); if ((k) == TPROBE_HI) tp1 = __builtin_amdgcn_s_memrealtime(); } while (0)
#else
void fwd_megakernel(Params prm) {
    unsigned char* lds_raw = emu_lds();
#define GRID_SYNC() do {} while (0)
#define PROBE_END(k) do {} while (0)
#endif
    Frame F;
    F.lds = (LAS unsigned char*)lds_raw; F.tid = TID; F.lane = F.tid & 63; F.wave = RFL(F.tid >> 6); F.G = NBLK; F.bid = BID;
    F.pp = &prm;
    F.out = prm.out; F.ws = prm.ws;
    const int lo = prm.ph_lo, hi = prm.ph_hi;
#ifndef PH_MASK
#define PH_MASK 0xFFFFFFu
#endif
#define IN(k) ((((PH_MASK) >> (k)) & 1u) && lo <= (k) && (k) < hi)
#ifndef HOST_EMU
#define FRESH() do { int t_ = threadIdx.x; OPAQUE_V(t_); F.tid = t_; F.lane = t_ & 63; F.wave = __builtin_amdgcn_readfirstlane(t_ >> 6); \
        F.ws = uni_ptr(prm.ws); F.out = uni_ptr(prm.out); } while (0)
#else
#define FRESH() do {} while (0)
#endif
#define SEAM(k) do { if (IN(k) && IN((k) + 1)) GRID_SYNC(); PROBE_END(k); } while (0)
#ifndef HOST_EMU
#define OPAQUE_WS() do { unsigned char* t_ = prm.ws; asm volatile("" : "+s"(t_)); F.ws = t_; float* o_ = prm.out; asm volatile("" : "+s"(o_)); F.out = o_; } while (0)
#else
#define OPAQUE_WS() do {} while (0)
#endif
    if (IN(0)) { FRESH(); p0_small(F); } SEAM(0);
    if (IN(1)) { FRESH(); p1_xn(F); p0_weights(F); } SEAM(1);
    if (IN(2)) { FRESH(); pg8::Gemm g{WSP(bf16_t, WS_XN), WSP(bf16_t, WS_WIN), NROWS, NIN, 1024}; pg8::StaticOrder S; S.init(NROWS, NIN, F.G, F.bid);
        EpiInProj E{WSP(bf16_t, WS_Z), WSP(bf16_t, WS_XBC), WSP(bf16_t, WS_QK), WSP(bf16_t, WS_V), WSP(bf16_t, WS_O), WSP(bf16_t, WS_MG), WSP(float, WS_DTG), F.pp->in[9], F.pp->in[10], F.pp->in[15], F.pp->in[16], F.lds + pg8::STAGE_BYTES};
        pg8::gemm_phase<EpiInProj, pg8::StaticOrder>(F.lds, g, S, E); } SEAM(2);
    if (IN(4)) { FRESH(); p4v2_local_states(F); } SEAM(4);
    if (IN(5)) { FRESH(); p5_scan(F); } SEAM(5);
    if (IN(6)) { FRESH(); p6v2_outputs(F); } SEAM(6);
    if (IN(7)) { FRESH(); pg8::Gemm g{WSP(bf16_t, WS_YPRE), WSP(bf16_t, WS_WSO), NLAT, 1024, 1024}; pg8::StaticOrder S; S.init(NLAT, 1024, F.G, F.bid);
        EpiG1 E{WSP(bf16_t, WS_M1), WSP(bf16_t, WS_MG), WSP(float, WS_SSQ)}; pg8::gemm_phase<EpiG1, pg8::StaticOrder>(F.lds, g, S, E);
        FRESH(); pg8::Gemm g2{WSP(bf16_t, WS_HP), WSP(bf16_t, WS_WMO), NLAT, 1024, 1024};
        EpiG2 E2{WSP(bf16_t, WS_MERGED), WSP(bf16_t, WS_M1), WSP(bf16_t, WS_MG)}; pg8::gemm_phase<EpiG2, pg8::StaticOrder>(F.lds, g2, S, E2); } SEAM(7);
    if (IN(9)) { FRESH(); pg8::Gemm g{WSP(bf16_t, WS_MERGED), WSP(bf16_t, WS_WOUT), NLAT, 1024, 1024}; pg8::StaticOrder S; S.init(NLAT, 1024, F.G, F.bid);
        EpiG3 E{F.pp->in[0], F.out, WSP(float, WS_MOD)}; pg8::gemm_phase<EpiG3, pg8::StaticOrder>(F.lds, g, S, E); } SEAM(9);
    if (IN(10)) { FRESH();
#pragma unroll 1
        for (int pm = F.bid; pm < NLAT / 256; pm += F.G) xn2_tile(F, pm);
        FRESH();
        { pg8::Gemm g{WSP(bf16_t, WS_XN), WSP(bf16_t, WS_WRS), NLAT, 768, 1024}; pg8::TileOrder S{F.bid, F.G, NLAT / 256, 3};
          EpiRS E{WSP(float, WS_LOG), WSP(bf16_t, WS_HS)}; pg8::gemm_phase<EpiRS, pg8::TileOrder>(F.lds, g, S, E); }
        FRESH(); p_expert_weights(F, NLAT / 256 < F.G ? NLAT / 256 : F.G); } SEAM(10);
    if (IN(12)) { FRESH(); p12_route(F); } SEAM(12);
    if (IN(13)) { FRESH(); p13_slots(F); } SEAM(13);
    if (IN(14)) { FRESH(); const int ntl = WSP(int, WS_CTL)[1024];
        pg8::Gemm g{WSP(bf16_t, WS_XN), WSP(bf16_t, WS_W1T), NLAT, 512, 1024};
        pg8::ExpertOrder<true> S{0, ntl, 2, F.G, F.bid, WSP(int, WS_TEXP), 0, (size_t)512 * 1024, WSP(int, WS_STOK)};
        EpiX1 E{WSP(bf16_t, WS_H)}; pg8::gemm_phase<EpiX1, pg8::ExpertOrder<true>>(F.lds, g, S, E); } SEAM(14);
    if (IN(15)) { FRESH(); const int ntl = WSP(int, WS_CTL)[1024];
        pg8::Gemm g{WSP(bf16_t, WS_H), WSP(bf16_t, WS_W2T), MAXSLOT, 1024, 256};
        pg8::ExpertOrder<false> S{0, ntl, 4, F.G, F.bid, WSP(int, WS_TEXP), 0, (size_t)1024 * 256, nullptr};
        EpiX2 E{WSP(bf16_t, WS_Y), WSP(int, WS_SDST), WSP(float, WS_SW)}; pg8::gemm_phase<EpiX2, pg8::ExpertOrder<false>>(F.lds, g, S, E);
        FRESH();
        pg8::Gemm g2{WSP(bf16_t, WS_HS), WSP(bf16_t, WS_WSD), NLAT, 1024, 256}; pg8::StaticOrder S2; S2.init(NLAT, 1024, F.G, F.bid);
        EpiSD E2{WSP(bf16_t, WS_YS)}; pg8::gemm_phase<EpiSD, pg8::StaticOrder>(F.lds, g2, S2, E2); } SEAM(15);
    if (IN(16)) { FRESH(); p_final(F); }
#ifndef HOST_EMU
    if (TPROBE_MUL > 0) { asm volatile("s_waitcnt vmcnt(0)" ::: "memory"); __syncthreads(); PROBE_END(16);
        if (blockIdx.x == 0 && threadIdx.x == 0) { const unsigned long long t0 = __builtin_amdgcn_s_memrealtime(), want = (tp0 != 0ull && tp1 > tp0 && tp1 - tp0 < 2000000ull) ? (unsigned long long)TPROBE_MUL * (tp1 - tp0) : 0ull;
            while (__builtin_amdgcn_s_memrealtime() - t0 < want) __builtin_amdgcn_s_sleep(8); } }
#endif
#undef IN
#undef SEAM
}

#ifndef HOST_EMU
extern "C" void kernel_launch(void* const* d_in, const int* in_sizes, int n_in, void* d_out, int out_size, void* d_ws, size_t ws_size, hipStream_t stream) {
    static int grid = 0;
    if (grid == 0) {
        if (n_in != 32 || out_size != NLAT * DM || ws_size < WS_NEED) { fprintf(stderr, "kernel_launch: unexpected problem (n_in %d out %d ws %zu need %zu)\n", n_in, out_size, ws_size, (size_t)WS_NEED); grid = -1; return; }
        int dev = 0, cus = 0, per_cu = 0;
        hipGetDevice(&dev); hipDeviceGetAttribute(&cus, hipDeviceAttributeMultiprocessorCount, dev);
        hipFuncSetAttribute((const void*)fwd_megakernel, hipFuncAttributeMaxDynamicSharedMemorySize, LDS_BYTES);
        hipOccupancyMaxActiveBlocksPerMultiprocessor(&per_cu, (const void*)fwd_megakernel, NTHR, LDS_BYTES);
        if (per_cu < 1) { fprintf(stderr, "kernel_launch: occupancy query says %d blocks per CU\n", per_cu); per_cu = 1; }
        (void)hipGetLastError();
        grid = cus;
    }
    if (grid < 0) return;
    hipMemsetAsync((char*)d_ws + WS_CTL, 0, CTL_BYTES, stream);
    Params p{};
    for (int i = 0; i < 32; ++i) p.in[i] = (const float*)d_in[i];
    p.out = (float*)d_out; p.ws = (unsigned char*)d_ws; p.ph_lo = 0; p.ph_hi = NPHASE;
    void* args[] = {&p};
    const hipError_t e = hipLaunchCooperativeKernel((const void*)fwd_megakernel, dim3(grid), dim3(NTHR), args, LDS_BYTES, stream);
    if (e != hipSuccess) fprintf(stderr, "kernel_launch: launch failed: %s (grid %d)\n", hipGetErrorString(e), grid);
}
#endif
```

```cpp
#ifndef HOST_EMU
#include <hip/hip_runtime.h>
#include <cstdio>
#include <cstdint>
#define DEV __device__ __forceinline__
#define LAS __attribute__((address_space(3)))
#define TID ((int)threadIdx.x)
#define BID ((int)blockIdx.x)
#define NBLK ((int)gridDim.x)
#define SYNC() __syncthreads()
#define EXPF(x) __expf(x)
#define RCPF(x) __builtin_amdgcn_rcpf(x)
#define RSQF(x) __builtin_amdgcn_rsqf(x)
#define ATOMIC_ADD_LDS(p, v) __hip_atomic_fetch_add((p), (v), __ATOMIC_RELAXED, __HIP_MEMORY_SCOPE_WORKGROUP)
#define ATOMIC_ADD_G(p, v) __hip_atomic_fetch_add((p), (v), __ATOMIC_RELAXED, __HIP_MEMORY_SCOPE_AGENT)
#define RFL(x) __builtin_amdgcn_readfirstlane(x)
#define SCHED_FENCE() __builtin_amdgcn_sched_barrier(0)
#define MEM_FENCE() asm volatile("" ::: "memory")
#define WAVE_LDS_FENCE() asm volatile("s_waitcnt lgkmcnt(0)" ::: "memory")
#define OPAQUE_V(x) asm volatile("" : "+v"(x))
#define VM_DRAIN() asm volatile("s_waitcnt vmcnt(0)" ::: "memory")
#define TOUCH(x) asm volatile("" :: "v"(x))
#endif

#ifndef CFG_SEQ
#define CFG_SEQ 16384
#endif
#ifndef CFG_NEXP
#define CFG_NEXP 256
#endif
constexpr int DM = 1024, BATCH = 2, SEQ = CFG_SEQ, CTXL = 256, CHUNK = 128;
constexpr int NLAT = BATCH * SEQ, NCTX = BATCH * CTXL, NROWS = NLAT + NCTX;
constexpr int NCH = SEQ / CHUNK, NCHC = CTXL / CHUNK, NCHT = NCH + NCHC;
constexpr int SSD_H = 16, SSD_P = 64, SSD_N = 128, D_XBC = 1536;
constexpr int ML_H = 8, ML_DV = 128, ML_DK = 64, ML_PP = 144;
constexpr int NEXP = CFG_NEXP, TOPK = 8, TOPKG = 4, DEXP = 256, EPL = NEXP / 64;
constexpr int NASG = NLAT * TOPK, MAXSLOT = NASG + NEXP * 256;
constexpr int NIN = 7936;
constexpr float EPS = 1e-6f;
constexpr int NTHR = 512;

typedef unsigned short bf16_t;
typedef short bf16x8 __attribute__((ext_vector_type(8)));
typedef float f32x4 __attribute__((ext_vector_type(4)));
typedef unsigned u32x4 __attribute__((ext_vector_type(4)));
typedef unsigned u32x2 __attribute__((ext_vector_type(2)));
struct __attribute__((aligned(4))) Rec12 { unsigned x, y, z; };
constexpr int Y12LD = 1536;
typedef int i32x4 __attribute__((ext_vector_type(4)));

constexpr size_t alignup(size_t x) { return (x + 4095) & ~(size_t)4095; }
constexpr size_t WS_CTL = 0;
constexpr size_t CTL_BYTES = 65536;
constexpr size_t WS_MOD = WS_CTL + CTL_BYTES;
constexpr size_t WS_DECS = WS_MOD + alignup(3 * 6144 * 4);
constexpr size_t WS_DECM = WS_DECS + alignup((size_t)BATCH * 2 * NCHT * 16 * 4);
constexpr size_t WS_WIN = WS_DECM + alignup((size_t)BATCH * 2 * NCHT * 8 * 4);
constexpr size_t WS_WSO = WS_WIN + alignup((size_t)NIN * 1024 * 2);
constexpr size_t WS_WMO = WS_WSO + alignup((size_t)1024 * 1024 * 2);
constexpr size_t WS_WOUT = WS_WMO + alignup((size_t)1024 * 1024 * 2);
constexpr size_t WS_WRS = WS_WOUT + alignup((size_t)1024 * 1024 * 2);
constexpr size_t WS_WSD = WS_WRS + alignup((size_t)768 * 1024 * 2);
constexpr size_t WS_XN = WS_WSD + alignup((size_t)1024 * 256 * 2);
constexpr size_t WS_STAGE = WS_XN + alignup((size_t)NROWS * 1024 * 2);
constexpr size_t WS_Z = WS_STAGE;
constexpr size_t WS_XBC = WS_Z + alignup((size_t)NROWS * 1024 * 2);
constexpr size_t WS_QK = WS_XBC + alignup((size_t)NROWS * 1536 * 2);
constexpr size_t WS_V = WS_QK + alignup((size_t)NROWS * 1024 * 2);
constexpr size_t WS_O = WS_V + alignup((size_t)NROWS * 1024 * 2);
constexpr size_t WS_MG = WS_O + alignup((size_t)NROWS * 1024 * 2);
constexpr size_t WS_DTG = WS_MG + alignup((size_t)NROWS * 2048 * 2);
constexpr size_t WS_STS = WS_DTG + alignup((size_t)NROWS * 64 * 4);
constexpr size_t STS_CH = (size_t)SSD_H * SSD_P * SSD_N;
constexpr size_t WS_STM = WS_STS + alignup((size_t)BATCH * 2 * NCHT * STS_CH * 2);
constexpr size_t STM_CH = (size_t)ML_H * ML_PP * ML_DK;
constexpr size_t WS_YPRE = WS_STM + alignup((size_t)BATCH * 2 * NCHT * STM_CH * 2);
constexpr size_t WS_HP = WS_YPRE + alignup((size_t)NLAT * 1024 * 2);
constexpr size_t WS_SSQ = WS_HP + alignup((size_t)NLAT * 1024 * 2);
constexpr size_t WS_MIX_END = WS_SSQ + alignup((size_t)NLAT * 16 * 4);
constexpr size_t WS_M1 = WS_XBC;
constexpr size_t WS_MERGED = WS_QK;
constexpr size_t WS_Y = WS_STAGE;
constexpr size_t WS_YSC = WS_Y + alignup((size_t)NASG * 1024);
constexpr size_t WS_W1T = WS_STAGE;
static_assert((size_t)NEXP * 512 * 1024 * 2 <= (size_t)NASG * 1024 * 2 || true, "");
constexpr size_t WS_YEND = WS_STAGE + (alignup((size_t)NASG * 1024 * 2) > alignup((size_t)NEXP * 512 * 1024 * 2) ? alignup((size_t)NASG * 1024 * 2) : alignup((size_t)NEXP * 512 * 1024 * 2));
constexpr size_t WS_W2T = WS_YEND;
constexpr size_t WS_H = WS_W2T + alignup((size_t)NEXP * 1024 * 256 * 2);
constexpr size_t WS_LOG = WS_H + alignup((size_t)MAXSLOT * 256 * 2);
constexpr size_t WS_HS = WS_LOG + alignup((size_t)NLAT * NEXP * 4);
constexpr size_t WS_ASGE = WS_HS + alignup((size_t)NLAT * 256 * 2);
constexpr size_t WS_ASGR = WS_ASGE + alignup((size_t)NASG * 4);
constexpr size_t WS_ASGW = WS_ASGR + alignup((size_t)NASG * 4);
constexpr size_t WS_STOK = WS_ASGW + alignup((size_t)NASG * 4);
constexpr size_t WS_SDST = WS_STOK + alignup((size_t)MAXSLOT * 4);
constexpr size_t WS_SW = WS_SDST + alignup((size_t)MAXSLOT * 4);
constexpr size_t WS_TEXP = WS_SW + alignup((size_t)MAXSLOT * 4);
constexpr size_t WS_CMAT = WS_TEXP + alignup((size_t)(MAXSLOT / 256) * 4);
constexpr size_t WS_YS = WS_CMAT + alignup((size_t)512 * NEXP * 4);
constexpr size_t WS_MOE_END = WS_YS + alignup((size_t)NLAT * 1024 * 2);
constexpr size_t WS_NEED = WS_MIX_END > WS_MOE_END ? WS_MIX_END : WS_MOE_END;

constexpr int LDS_BYTES = 147456;
constexpr int NPHASE = 17;

constexpr int X1LD = 2048;
struct Params { const float* in[32]; float* out; unsigned char* ws; int ph_lo, ph_hi; };

#ifndef HOST_EMU
DEV unsigned f2bf(float f) { const __bf16 b = (__bf16)f; return (unsigned)__builtin_bit_cast(unsigned short, b); }
#else
DEV unsigned f2bf(float f) { unsigned u = __builtin_bit_cast(unsigned, f); return (u + 0x7fffu + ((u >> 16) & 1u)) >> 16; }
#endif
DEV float bf2f(unsigned h) { return __builtin_bit_cast(float, (h & 0xffffu) << 16); }
#ifndef HOST_EMU
typedef float f32x2_t __attribute__((ext_vector_type(2))); typedef __bf16 bf16x2_t __attribute__((ext_vector_type(2)));
DEV unsigned pk2(float lo, float hi) { const f32x2_t v = {lo, hi}; const bf16x2_t b = __builtin_convertvector(v, bf16x2_t); return __builtin_bit_cast(unsigned, b); }
#else
DEV unsigned pk2(float lo, float hi) { return f2bf(lo) | (f2bf(hi) << 16); }
#endif
DEV float bflo(unsigned w) { return __builtin_bit_cast(float, w << 16); }
DEV float bfhi(unsigned w) { return __builtin_bit_cast(float, w & 0xffff0000u); }
#ifndef HOST_EMU
DEV unsigned fp8_pk(float a, float b, unsigned old, bool hi) { return hi ? (unsigned)__builtin_amdgcn_cvt_pk_fp8_f32(a, b, (int)old, true) : (unsigned)__builtin_amdgcn_cvt_pk_fp8_f32(a, b, (int)old, false); }
DEV float fp8_f32(unsigned w, int sel) { return sel == 0 ? __builtin_amdgcn_cvt_f32_fp8((int)w, 0) : (sel == 1 ? __builtin_amdgcn_cvt_f32_fp8((int)w, 1) : (sel == 2 ? __builtin_amdgcn_cvt_f32_fp8((int)w, 2) : __builtin_amdgcn_cvt_f32_fp8((int)w, 3))); }
DEV int frexp_exp(float x) { return __builtin_amdgcn_frexp_expf(x); }
DEV float ldexp_(float x, int e) { return __builtin_amdgcn_ldexpf(x, e); }
#else
static inline unsigned emu_fp8_enc(float f) { const unsigned sg = f < 0.f ? 0x80u : 0u; const float a = fabsf(f); if (!(a == a)) return sg | 0x7Fu; if (a >= 448.f) return sg | 0x7Eu; if (a < 0.0009765625f) return sg;
    int e; const float m = frexpf(a, &e); int E = e - 1;
    if (E < -6) { const int k = (int)rintf(a * 512.f); return k >= 8 ? (sg | 0x08u) : (sg | (unsigned)k); }
    int mant = (int)rintf((2.f * m - 1.f) * 8.f); if (mant == 8) { mant = 0; E += 1; } if (E > 8 || (E == 8 && mant > 6)) return sg | 0x7Eu;
    return sg | ((unsigned)(E + 7) << 3) | (unsigned)mant; }
static inline float emu_fp8_dec(unsigned b) { const float sg = (b & 0x80u) ? -1.f : 1.f; const int ex = (b >> 3) & 15, mant = b & 7; if (ex == 0) return sg * (float)mant * 0.001953125f; return sg * ldexpf(1.f + (float)mant * 0.125f, ex - 7); }
static inline unsigned fp8_pk(float a, float b, unsigned old, bool hi) { const unsigned v = emu_fp8_enc(a) | (emu_fp8_enc(b) << 8); return hi ? ((old & 0x0000ffffu) | (v << 16)) : ((old & 0xffff0000u) | v); }
static inline float fp8_f32(unsigned w, int sel) { return emu_fp8_dec((w >> (8 * sel)) & 0xffu); }
static inline int frexp_exp(float x) { int e; (void)frexpf(x, &e); return e; }
static inline float ldexp_(float x, int e) { return ldexpf(x, e); }
#endif
DEV u32x2 fp8_block8(const f32x4& a0, const f32x4& a1, int& ex) {
    const float am = fmaxf(fmaxf(fmaxf(fabsf(a0.x), fabsf(a0.y)), fmaxf(fabsf(a0.z), fabsf(a0.w))), fmaxf(fmaxf(fabsf(a1.x), fabsf(a1.y)), fmaxf(fabsf(a1.z), fabsf(a1.w))));
    int e = am > 0.f ? frexp_exp(am) - 8 : 0; e = e < -120 ? -120 : (e > 120 ? 120 : e); ex = e;
    u32x2 q; q.x = fp8_pk(ldexp_(a0.x, -e), ldexp_(a0.y, -e), 0u, false); q.x = fp8_pk(ldexp_(a0.z, -e), ldexp_(a0.w, -e), q.x, true);
    q.y = fp8_pk(ldexp_(a1.x, -e), ldexp_(a1.y, -e), 0u, false); q.y = fp8_pk(ldexp_(a1.z, -e), ldexp_(a1.w, -e), q.y, true); return q;
}
DEV u32x4 fp8_block16(const f32x4& a0, const f32x4& a1, const f32x4& a2, const f32x4& a3, int& ex) {
    const float m0 = fmaxf(fmaxf(fabsf(a0.x), fabsf(a0.y)), fmaxf(fabsf(a0.z), fabsf(a0.w))), m1 = fmaxf(fmaxf(fabsf(a1.x), fabsf(a1.y)), fmaxf(fabsf(a1.z), fabsf(a1.w)));
    const float m2 = fmaxf(fmaxf(fabsf(a2.x), fabsf(a2.y)), fmaxf(fabsf(a2.z), fabsf(a2.w))), m3 = fmaxf(fmaxf(fabsf(a3.x), fabsf(a3.y)), fmaxf(fabsf(a3.z), fabsf(a3.w)));
    const float am = fmaxf(fmaxf(m0, m1), fmaxf(m2, m3));
    int e = am > 0.f ? frexp_exp(am) - 8 : 0; e = e < -120 ? -120 : (e > 120 ? 120 : e); ex = e;
    u32x4 q;
    q.x = fp8_pk(ldexp_(a0.x, -e), ldexp_(a0.y, -e), 0u, false); q.x = fp8_pk(ldexp_(a0.z, -e), ldexp_(a0.w, -e), q.x, true);
    q.y = fp8_pk(ldexp_(a1.x, -e), ldexp_(a1.y, -e), 0u, false); q.y = fp8_pk(ldexp_(a1.z, -e), ldexp_(a1.w, -e), q.y, true);
    q.z = fp8_pk(ldexp_(a2.x, -e), ldexp_(a2.y, -e), 0u, false); q.z = fp8_pk(ldexp_(a2.z, -e), ldexp_(a2.w, -e), q.z, true);
    q.w = fp8_pk(ldexp_(a3.x, -e), ldexp_(a3.y, -e), 0u, false); q.w = fp8_pk(ldexp_(a3.z, -e), ldexp_(a3.w, -e), q.w, true); return q;
}
DEV void fp8_acc4(unsigned w, float sc, f32x4& a) { a.x += fp8_f32(w, 0) * sc; a.y += fp8_f32(w, 1) * sc; a.z += fp8_f32(w, 2) * sc; a.w += fp8_f32(w, 3) * sc; }
DEV void fp8_unblock8(u32x2 q, int ex, f32x4& a0, f32x4& a1) {
    const float sc = ldexp_(1.0f, ex);
    a0.x = fp8_f32(q.x, 0) * sc; a0.y = fp8_f32(q.x, 1) * sc; a0.z = fp8_f32(q.x, 2) * sc; a0.w = fp8_f32(q.x, 3) * sc;
    a1.x = fp8_f32(q.y, 0) * sc; a1.y = fp8_f32(q.y, 1) * sc; a1.z = fp8_f32(q.y, 2) * sc; a1.w = fp8_f32(q.y, 3) * sc;
}
DEV float sigmoidf_(float x) { return RCPF(1.f + EXPF(-x)); }
DEV float siluf_(float x) { return x * RCPF(1.f + EXPF(-x)); }
DEV float softplusf_(float x) { return x > 20.f ? x : log1pf(EXPF(x)); }
DEV float logsigmoidf_(float x) { return -softplusf_(-x); }
DEV float wave_sum(float v) {
#pragma unroll
    for (int o = 1; o < 64; o <<= 1) v += __shfl_xor(v, o);
    return v;
}
DEV float wave_incl_scan(float v, int lane) {
#pragma unroll
    for (int d = 1; d < 64; d <<= 1) { float t = __shfl_up(v, d); if (lane >= d) v += t; }
    return v;
}
typedef short s16x4 __attribute__((ext_vector_type(4)));
#ifndef HOST_EMU
DEV f32x4 mfma16(bf16x8 a, bf16x8 b, f32x4 c) { return __builtin_amdgcn_mfma_f32_16x16x32_bf16(a, b, c, 0, 0, 0); }
DEV s16x4 lds_tr16(const LAS void* p) { return __builtin_bit_cast(s16x4, __builtin_amdgcn_ds_read_tr16_b64_v4i16((LAS s16x4*)p)); }
#endif
struct EpiX2; struct EpiX1; struct EpiInProj; struct EpiG1; struct EpiG2; struct EpiG3; struct EpiRS; struct EpiSD;
#ifndef TPSEC
#define TPSEC 0
#endif
namespace pg8 {
constexpr int BM = 256, BK = 64, HALF = 128, HTB = HALF * BK * 2, STAGE_BYTES = 8 * HTB, NXCD = 8, WGM = 8;
struct Unit { int pm, pn; };
struct Gemm { const bf16_t* A; const bf16_t* Bt; int M, N, K; };

DEV int lds_byte(int r, int c) { const int st = (r >> 4) * 2 + (c >> 5), rr = r & 15, cc = c & 31, ob = rr * 64 + cc * 2; return st * 1024 + (ob ^ (((ob >> 9) & 1) << 5)); }
DEV void stage_rc(int b, int& R, int& C) { const int st = b / 1024, sb = b % 1024, swz = sb ^ (((sb >> 9) & 1) << 5); R = (st >> 1) * 16 + swz / 64; C = (st & 1) * 32 + (swz % 64) / 2; }
DEV int perm32(int rho) { const int n = rho >> 4, i = rho & 15; return 8 * (i >> 2) + 4 * n + (i & 3); }
DEV int perm16x(int rho) { const int n = rho >> 4, i = rho & 15; return 16 * (i >> 2) + 4 * n + (i & 3); }

struct StaticOrder {
    static constexpr bool GATHER = false;
    int nM, nN, nwg, G, c;
    DEV void init(int M, int N, int G_, int c_) { nM = M / BM; nN = N / BM; nwg = nM * nN; G = G_; c = c_; }
    DEV bool next(int i, Unit& u) const {
        const long L = (long)i * G + c; if (L >= nwg) return false;
        int wgid = (int)L; { const int q = nwg / NXCD, r = nwg % NXCD, xcd = wgid % NXCD, off = wgid / NXCD; wgid = (xcd < r ? xcd * (q + 1) : r * (q + 1) + (xcd - r) * q) + off; }
        const int nig = WGM * nN, gid = wgid / nig, fm = gid * WGM, gsz = (nM - fm) < WGM ? (nM - fm) : WGM;
        u.pm = fm + ((wgid % nig) % gsz); u.pn = (wgid % nig) / gsz; return true;
    }
    DEV unsigned arow(const Unit& u, int r) const { return (unsigned)(u.pm * BM + r); }
    DEV const char* bbase(const Gemm& g, const Unit& u) const { return (const char*)g.Bt + (size_t)u.pn * BM * g.K * 2; }
};
struct TileOrder {
    static constexpr bool GATHER = false;
    int pm0, step, nM, np;
    DEV bool next(int i, Unit& u) const { const int pm = pm0 + (i / np) * step; if (pm >= nM) return false; u.pm = pm; u.pn = i % np; return true; }
    DEV unsigned arow(const Unit& u, int r) const { return (unsigned)(u.pm * BM + r); }
    DEV const char* bbase(const Gemm& g, const Unit& u) const { return (const char*)g.Bt + (size_t)u.pn * BM * g.K * 2; }
};
template <bool GATHER_> struct ExpertOrder {
    static constexpr bool GATHER = GATHER_;
    int tlo, thi, np, G, c; const int* texp; int e0; size_t estride  ; const int* rowmap;
    DEV bool next(int i, Unit& u) const {
        const long L = (long)i * G + c; const long n = (long)(thi - tlo) * np; if (L >= n) return false;
        int wg = (int)L; { const int nn = (int)n, q = nn / NXCD, r = nn % NXCD, xcd = wg % NXCD, off = wg / NXCD; wg = (xcd < r ? xcd * (q + 1) : r * (q + 1) + (xcd - r) * q) + off; }
        u.pm = tlo + wg / np; u.pn = wg % np; return true;
    }
    DEV unsigned arow(const Unit& u, int r) const { return GATHER_ ? (unsigned)rowmap[u.pm * BM + r] : (unsigned)(u.pm * BM + r); }
    DEV const char* bbase(const Gemm& g, const Unit& u) const { const int e = texp[u.pm] - e0; return (const char*)(g.Bt + (size_t)e * estride) + (size_t)u.pn * BM * g.K * 2; }
};

template <class E, class = void> struct epi_w16 { static constexpr bool v = false; };
template <class E> struct epi_w16<E, decltype((void)E::W16)> { static constexpr bool v = E::W16; };
#ifndef HOST_EMU
#define PG8_LAS __attribute__((address_space(3)))
template <class Epi, class Sched>
__device__ __forceinline__ void gemm_phase(PG8_LAS unsigned char* lds, const Gemm g, const Sched& S, const Epi& E) {
    int tid_ = threadIdx.x; asm volatile("" : "+v"(tid_));
    const int tid = tid_, wid = __builtin_amdgcn_readfirstlane(tid >> 6), lane = tid & 63, wr = wid >> 2, wc = wid & 3, fr = lane & 15, fq = lane >> 4;
    int Kop = g.K; asm volatile("" : "+s"(Kop));
    const int K = Kop, nt = K / BK;
    int RA[2], CA[2]; unsigned voffB[2];
#pragma unroll
    for (int i = 0; i < 2; ++i) { int R, C; stage_rc(tid * 16 + i * 8192, R, C); const int Rb = epi_w16<Epi>::v ? (64 * ((R >> 5) & 3) + perm16x(R & 31)) : (Epi::PERM ? ((R & ~31) + perm32(R & 31)) : R);
        RA[i] = R; CA[i] = C; voffB[i] = (unsigned)(Rb * K + C) * 2u; }
    const size_t kstep = (size_t)(BK * 2);
    const size_t hstep = (size_t)HALF * K * 2;
    const size_t hstepB = epi_w16<Epi>::v ? (size_t)8 * K * 2 : hstep;
    const unsigned ldsw = (unsigned)wid * 1024u;
    const int aoff = lds_byte(wr * 64 + fr, fq * 8), boff = lds_byte(wc * 32 + fr, fq * 8);
    const char* const Ab = (const char*)g.A;
#define PG8_SA(b, h) (((b) * 2 + (h)) * HTB)
#define PG8_SB(b, h) ((4 + (b) * 2 + (h)) * HTB)
#define PG8_STAGE(bufoff, gbase, voff) do { _Pragma("unroll") for (int _i = 0; _i < 2; ++_i) \
        __builtin_amdgcn_global_load_lds((const unsigned*)((const char*)(gbase) + (voff)[_i]), (PG8_LAS unsigned*)(lds + (bufoff) + ldsw + _i * 8192), 16, 0, 0); } while (0)
#define PG8_LDA(dst, b, h) do { _Pragma("unroll") for (int m = 0; m < 4; ++m) _Pragma("unroll") for (int k = 0; k < 2; ++k) dst[m][k] = *(const PG8_LAS bf16x8*)(lds + PG8_SA(b, h) + aoff + m * 2048 + k * 1024); } while (0)
#define PG8_LDB(dst, b, h) do { _Pragma("unroll") for (int n = 0; n < 2; ++n) _Pragma("unroll") for (int k = 0; k < 2; ++k) dst[n][k] = *(const PG8_LAS bf16x8*)(lds + PG8_SB(b, h) + boff + n * 2048 + k * 1024); } while (0)
#define PG8_MMA(ai, bj, At, Bt) do { __builtin_amdgcn_s_setprio(1); _Pragma("unroll") for (int m = 0; m < 4; ++m) _Pragma("unroll") for (int n = 0; n < 2; ++n) _Pragma("unroll") for (int k = 0; k < 2; ++k) \
        acc[ai][bj][m][n] = __builtin_amdgcn_mfma_f32_16x16x32_bf16(Bt[n][k], At[m][k], acc[ai][bj][m][n], 0, 0, 0); __builtin_amdgcn_s_setprio(0); } while (0)
#define PG8_WAIT_V(n) asm volatile("s_waitcnt vmcnt(" #n ")" ::: "memory")
#define PG8_WAIT_L(n) asm volatile("s_waitcnt lgkmcnt(" #n ")" ::: "memory")
#define PG8_BAR __builtin_amdgcn_s_barrier()
#define PG8_SCHED __builtin_amdgcn_sched_barrier(0)
#define PG8_VOFFA(dst, u) do { _Pragma("unroll") for (int _h = 0; _h < 2; ++_h) _Pragma("unroll") for (int _i = 0; _i < 2; ++_i) \
        dst[_h][_i] = (S.arow(u, _h * HALF + RA[_i]) * (unsigned)K + (unsigned)CA[_i]) * 2u; } while (0)
    Unit cur, nxt; int ui = 0;
    if (!S.next(0, cur)) return;
    constexpr int TPE = TPSEC >> 2; constexpr bool TPS = (TPSEC != 0) && (TPE == 0 ? __is_same(Epi, ::EpiX2) : TPE == 1 ? __is_same(Epi, ::EpiX1) : TPE == 2 ? __is_same(Epi, ::EpiInProj) : TPE == 3 ? __is_same(Epi, ::EpiG1) : TPE == 4 ? __is_same(Epi, ::EpiG2) : TPE == 5 ? __is_same(Epi, ::EpiG3) : TPE == 6 ? __is_same(Epi, ::EpiRS) : __is_same(Epi, ::EpiSD)); unsigned long long tpa = 0ull, tpb = 0ull, tq0 = 0ull, tq1 = 0ull;
    f32x4 acc[2][2][4][2];
#pragma unroll
    for (int a = 0; a < 2; ++a)
#pragma unroll
        for (int b = 0; b < 2; ++b)
#pragma unroll
            for (int m = 0; m < 4; ++m)
#pragma unroll
                for (int n = 0; n < 2; ++n) acc[a][b][m][n] = (f32x4){0.f, 0.f, 0.f, 0.f};
    bf16x8 At[4][2], B0[2][2], B1[2][2];
    constexpr bool GA = Sched::GATHER;
    unsigned vAc[2][2], vAn[2][2];
    unsigned voffA[2];
#pragma unroll
    for (int i = 0; i < 2; ++i) voffA[i] = (unsigned)(RA[i] * K + CA[i]) * 2u;
    const size_t tstep = 2 * hstep;
    const char* cA = Ab;
    if constexpr (GA) { PG8_VOFFA(vAc, cur); } else { cA = Ab + (size_t)S.arow(cur, 0) * K * 2; (void)tstep; }
    const char* cB = S.bbase(g, cur);
#define PG8_STAGE_A(bufoff, h, ubase, vg) do { if constexpr (GA) { PG8_STAGE(bufoff, ubase, vg[h]); } else { PG8_STAGE(bufoff, (ubase) + (h) * hstep, voffA); } } while (0)
    PG8_STAGE(PG8_SB(0, 0), cB, voffB); PG8_STAGE(PG8_SB(0, 1), cB + hstepB, voffB); PG8_STAGE_A(PG8_SA(0, 0), 0, cA, vAc); PG8_STAGE_A(PG8_SA(0, 1), 1, cA, vAc);
    if (wr == 1) PG8_BAR;
    PG8_WAIT_V(2); PG8_BAR;
    PG8_STAGE(PG8_SB(1, 0), cB + kstep, voffB); PG8_STAGE_A(PG8_SA(1, 0), 0, cA + kstep, vAc); PG8_STAGE(PG8_SB(1, 1), cB + hstepB + kstep, voffB);
    PG8_WAIT_V(6); PG8_BAR;
    for (;;) {
        const bool has_next = S.next(ui + 1, nxt);
        const char* nB = cB; const char* nA = cA;
        if (has_next) { nB = S.bbase(g, nxt); if constexpr (GA) { PG8_VOFFA(vAn, nxt); } else { nA = Ab + (size_t)S.arow(nxt, 0) * K * 2; } }
        else if constexpr (GA) {
#pragma unroll
            for (int _h = 0; _h < 2; ++_h)
#pragma unroll
                for (int _i = 0; _i < 2; ++_i) vAn[_h][_i] = vAc[_h][_i];
        }
        if constexpr (TPS) tq0 = __builtin_amdgcn_s_memrealtime();
#pragma unroll 1
        for (int t = 0; t < nt; t += 2) {
            const bool last = (t == nt - 2);
            const char* a1 = cA + (size_t)(t + 1) * kstep;
            const char* a2 = last ? nA : cA + (size_t)(t + 2) * kstep; const char* b2 = last ? nB : cB + (size_t)(t + 2) * kstep;
            const char* a3 = a2 + kstep; const char* b3 = b2 + kstep;
            unsigned v2[2][2];
            if constexpr (GA) {
#pragma unroll
                for (int _h = 0; _h < 2; ++_h)
#pragma unroll
                    for (int _i = 0; _i < 2; ++_i) v2[_h][_i] = last ? vAn[_h][_i] : vAc[_h][_i];
            }
            PG8_LDB(B0, 0, 0); PG8_LDB(B1, 0, 1); PG8_SCHED; PG8_LDA(At, 0, 0); PG8_STAGE_A(PG8_SA(1, 1), 1, a1, vAc);
            PG8_WAIT_V(8); PG8_WAIT_L(0); PG8_BAR; PG8_MMA(0, 0, At, B0); PG8_MMA(0, 1, At, B1); PG8_BAR; PG8_SCHED;
            PG8_LDA(At, 0, 1); PG8_STAGE(PG8_SB(0, 0), b2, voffB); PG8_STAGE(PG8_SB(0, 1), b2 + hstepB, voffB); PG8_STAGE_A(PG8_SA(0, 0), 0, a2, v2);
            PG8_WAIT_V(8); PG8_WAIT_L(0); PG8_BAR; PG8_MMA(1, 0, At, B0); PG8_MMA(1, 1, At, B1); PG8_BAR; PG8_SCHED;
            PG8_LDB(B0, 1, 0); PG8_LDB(B1, 1, 1); PG8_SCHED; PG8_LDA(At, 1, 0); PG8_STAGE_A(PG8_SA(0, 1), 1, a2, v2);
            PG8_WAIT_V(8); PG8_WAIT_L(0); PG8_BAR; PG8_MMA(0, 0, At, B0); PG8_MMA(0, 1, At, B1); PG8_BAR; PG8_SCHED;
            PG8_LDA(At, 1, 1); PG8_STAGE(PG8_SB(1, 0), b3, voffB); PG8_STAGE(PG8_SB(1, 1), b3 + hstepB, voffB); PG8_STAGE_A(PG8_SA(1, 0), 0, a3, v2);
            PG8_WAIT_V(8); PG8_WAIT_L(0); PG8_BAR; PG8_MMA(1, 0, At, B0); PG8_MMA(1, 1, At, B1); PG8_BAR; PG8_SCHED;
        }
        if constexpr (TPS) { tq1 = __builtin_amdgcn_s_memrealtime(); tpa += tq1 - tq0; }
        if (wr == 0) PG8_BAR;
        E(acc, cur, wr, wc, fr, fq);
        if constexpr (TPS) { tpb += __builtin_amdgcn_s_memrealtime() - tq1; }
        if (!has_next) break;
#pragma unroll
        for (int a = 0; a < 2; ++a)
#pragma unroll
            for (int b = 0; b < 2; ++b)
#pragma unroll
                for (int m = 0; m < 4; ++m)
#pragma unroll
                    for (int n = 0; n < 2; ++n) acc[a][b][m][n] = (f32x4){0.f, 0.f, 0.f, 0.f};
        cur = nxt; cB = nB; cA = nA; ++ui;
        if constexpr (GA) {
#pragma unroll
            for (int _h = 0; _h < 2; ++_h)
#pragma unroll
                for (int _i = 0; _i < 2; ++_i) vAc[_h][_i] = vAn[_h][_i];
        }
        if (wr == 1) PG8_BAR;
    }
    PG8_WAIT_V(0);
    PG8_BAR;
    if constexpr (TPS) { if (tid == 0) *(PG8_LAS unsigned long long*)(lds + 147328) = (TPSEC & 1) ? tpa : tpb; }
#undef PG8_SA
#undef PG8_SB
#undef PG8_STAGE
#undef PG8_LDA
#undef PG8_LDB
#undef PG8_MMA
#undef PG8_WAIT_V
#undef PG8_WAIT_L
#undef PG8_BAR
#undef PG8_SCHED
#undef PG8_VOFFA
#undef PG8_STAGE_A
}
#else
template <class Epi, class Sched>
static inline void gemm_phase(unsigned char* lds, const Gemm g, const Sched& S, const Epi& E) {
    const int tid = TID, wid = tid >> 6, lane = tid & 63, wr = wid >> 2, wc = wid & 3, fr = lane & 15, fq = lane >> 4;
    float* C = (float*)(lds + 512 * 1024);
    Unit cur;
    for (int ui = 0; S.next(ui, cur); ++ui) {
        SYNC();
        { const int r = tid >> 1, c0 = (tid & 1) * 128; const bf16_t* arow = g.A + (size_t)S.arow(cur, r) * g.K; const bf16_t* bb = (const bf16_t*)S.bbase(g, cur);
          for (int c = c0; c < c0 + 128; ++c) { const bf16_t* brow = bb + (size_t)c * g.K; float s = 0.f; for (int k = 0; k < g.K; ++k) s += bf2f(arow[k]) * bf2f(brow[k]); C[r * 256 + c] = s; } }
        SYNC();
        f32x4 acc[2][2][4][2];
        for (int ai = 0; ai < 2; ++ai) for (int bj = 0; bj < 2; ++bj) for (int m = 0; m < 4; ++m) for (int n = 0; n < 2; ++n) for (int i = 0; i < 4; ++i) {
            const int row = 128 * ai + 64 * wr + 16 * m + fr, col = epi_w16<Epi>::v ? 64 * wc + 16 * fq + 8 * bj + 4 * n + i : (Epi::PERM ? 128 * bj + 32 * wc + 8 * fq + 4 * n + i : 128 * bj + 32 * wc + 16 * n + 4 * fq + i);
            acc[ai][bj][m][n][i] = C[row * 256 + col]; }
        E(acc, cur, wr, wc, fr, fq);
    }
    SYNC();
}
#endif
}

struct Frame {
    LAS unsigned char* lds;
    int tid, lane, wave, G, bid;
    const Params* pp; float* out; unsigned char* ws;
};
#define WSP(T, off) ((T*)(F.ws + (off)))

DEV int map_in(int s) {
    if (s < 2560) return s;
    if (s < 2592) return 7680 + (s - 2560);
    if (s < 4640) return s - 32;
    if (s < 4672) return 7712 + (s - 4640);
    return s - 64;
}
DEV int map_gu(int s, int up) { return (s >> 7) * 256 + up * 128 + (s & 127); }
DEV void p0_small(Frame& F) {
    const float* c = F.pp->in[1]; const float* cctx = F.pp->in[3]; const float* aw = F.pp->in[4]; const float* ab = F.pp->in[5];
    float* mod = WSP(float, WS_MOD);
    LAS float* sl = (LAS float*)F.lds;
    LAS float* red = sl + 3 * 1024;
    if (F.bid < 192) {
        for (int i = F.tid; i < 3 * 1024; i += NTHR) { const int v = i >> 10, k = i & 1023; sl[i] = siluf_(v < 2 ? c[v * 1024 + k] : cctx[k]); }
        SYNC();
    }
    for (int cb = F.bid; cb < 192; cb += F.G) {
        const int c4 = F.tid & 7, kg = F.tid >> 3;
        f32x4 w[16];
#pragma unroll
        for (int i = 0; i < 16; ++i) w[i] = *(const f32x4*)(aw + (size_t)(kg * 16 + i) * 6144 + cb * 32 + c4 * 4);
        f32x4 s0 = {0.f, 0.f, 0.f, 0.f}, s1 = s0, s2 = s0;
#pragma unroll
        for (int i = 0; i < 16; ++i) { const int k = kg * 16 + i; s0 += w[i] * sl[k]; s1 += w[i] * sl[1024 + k]; s2 += w[i] * sl[2048 + k]; }
        LAS float* rp = red + (kg * 32 + c4 * 4) * 3;
        rp[0] = s0.x; rp[1] = s1.x; rp[2] = s2.x; rp[3] = s0.y; rp[4] = s1.y; rp[5] = s2.y; rp[6] = s0.z; rp[7] = s1.z; rp[8] = s2.z; rp[9] = s0.w; rp[10] = s1.w; rp[11] = s2.w;
        SYNC();
        if (F.tid < 96) { const int v = F.tid / 32, cc = F.tid % 32; float s = 0.f;
#pragma unroll 16
            for (int q = 0; q < 64; ++q) s += red[(q * 32 + cc) * 3 + v];
            mod[v * 6144 + cb * 32 + cc] = s + ab[cb * 32 + cc]; }
        SYNC();
    }
}
struct T64 { const float* W; bf16_t* WT; int K, N, dst_row, dst_hi, k0, n0; };
DEV void t64_load(const T64& t, f32x4 (&v)[16], int lane) {
#pragma unroll
    for (int i = 0; i < 16; ++i) v[i] = *(const f32x4*)(t.W + (size_t)(t.k0 + 4 * i + (lane >> 4)) * t.N + t.n0 + 4 * (lane & 15));
}
DEV void t64_store(const T64& t, const f32x4 (&v)[16], LAS float* scr, int lane) {
#pragma unroll
    for (int i = 0; i < 16; ++i) { LAS float* d = scr + (4 * i + (lane >> 4)) * 65 + 4 * (lane & 15); d[0] = v[i].x; d[1] = v[i].y; d[2] = v[i].z; d[3] = v[i].w; }
    WAVE_LDS_FENCE();
    const int c = lane & 7;
#pragma unroll
    for (int j = 0; j < 8; ++j) { const int n = (lane >> 3) + 8 * j; const LAS float* sp = scr + (8 * c) * 65 + n;
        u32x4 o; o.x = pk2(sp[0 * 65], sp[1 * 65]); o.y = pk2(sp[2 * 65], sp[3 * 65]); o.z = pk2(sp[4 * 65], sp[5 * 65]); o.w = pk2(sp[6 * 65], sp[7 * 65]);
        *(u32x4*)(t.WT + (size_t)((j < 4 ? t.dst_row : t.dst_hi - 32) + n) * t.K + t.k0 + 8 * c) = o; }
    WAVE_LDS_FENCE();
}
DEV T64 expert_item(Frame& F, int e0, int it) {
    const int per = 192, el = it / per, j = it % per, e = e0 + el; T64 t;
    if (j < 128) { const int up = j >> 6, jj = j & 63, kb = jj >> 2, nb = jj & 3;
        t.W = F.pp->in[25 + up] + (size_t)e * 1024 * 256; t.K = 1024; t.N = 256; t.WT = WSP(bf16_t, WS_W1T) + (size_t)el * 512 * 1024; t.dst_row = map_gu(nb * 64, up); t.dst_hi = t.dst_row + 32; t.k0 = kb * 64; t.n0 = nb * 64; }
    else { const int jj = j - 128, kb = jj >> 4, nb = jj & 15;
        t.W = F.pp->in[27] + (size_t)e * 256 * 1024; t.K = 256; t.N = 1024; t.WT = WSP(bf16_t, WS_W2T) + (size_t)el * 1024 * 256; t.dst_row = nb * 64; t.dst_hi = t.dst_row + 32; t.k0 = kb * 64; t.n0 = nb * 64; }
    return t;
}
DEV void p_expert_weights(Frame& F, int nR) {
    LAS float* scr = (LAS float*)(F.lds) + F.wave * (64 * 65);
    const int N = NEXP * 192;
    int cB, cA;
    if (nR >= F.G) { cB = (N + F.G - 1) / F.G; cA = cB; }
    else { cB = (N * 16 + (nR * 7 + (F.G - nR) * 16) - 1) / (nR * 7 + (F.G - nR) * 16); const int rem = N - (F.G - nR) * cB; cA = rem > 0 ? (rem + nR - 1) / nR : 0; }
    const int start = F.bid < nR ? F.bid * cA : nR * cA + (F.bid - nR) * cB, cnt = F.bid < nR ? cA : cB;
    const int end = start + cnt < N ? start + cnt : N;
    f32x4 v[16];
    int it = start + F.wave;
    if (it < end) { const T64 t = expert_item(F, 0, it); t64_load(t, v, F.lane); }
#pragma unroll 1
    for (; it < end; it += 8) {
        const T64 t = expert_item(F, 0, it);
        f32x4 cur[16];
#pragma unroll
        for (int i = 0; i < 16; ++i) cur[i] = v[i];
        if (it + 8 < end) { const T64 tn = expert_item(F, 0, it + 8); t64_load(tn, v, F.lane); }
        t64_store(t, cur, scr, F.lane);
    }
    SYNC();
}

DEV void norm_mod_row(const float* xrow, const float* g, const float* shift, const float* scale, bf16_t* orow, int lane) {
    const f32x4* xr = (const f32x4*)xrow + lane;
    f32x4 v[4]; float s = 0.f;
#pragma unroll
    for (int j = 0; j < 4; ++j) { v[j] = xr[64 * j]; s += (v[j].x * v[j].x + v[j].y * v[j].y) + (v[j].z * v[j].z + v[j].w * v[j].w); }
    const float rstd = RSQF(wave_sum(s) * (1.f / DM) + EPS);
    u32x2* o8 = (u32x2*)orow + lane;
#pragma unroll
    for (int j = 0; j < 4; ++j) {
        const f32x4 gg = ((const f32x4*)g)[lane + 64 * j], sh = ((const f32x4*)shift)[lane + 64 * j], sc = ((const f32x4*)scale)[lane + 64 * j];
        const f32x4 y = v[j] * rstd * gg * (sc + 1.0f) + sh;
        u32x2 w; w.x = pk2(y.x, y.y); w.y = pk2(y.z, y.w); o8[64 * j] = w;
    }
}
template <int NR> DEV void norm_mod_rows(const float* const (&xrow)[NR], const float* g, const float* shift, const float* scale, bf16_t* const (&orow)[NR], int lane) {
    f32x4 v[NR][4]; float s[NR];
#pragma unroll
    for (int r = 0; r < NR; ++r)
#pragma unroll
        for (int j = 0; j < 4; ++j) v[r][j] = ((const f32x4*)xrow[r])[lane + 64 * j];
    f32x4 gs[4], sh[4];
#pragma unroll
    for (int j = 0; j < 4; ++j) { gs[j] = ((const f32x4*)g)[lane + 64 * j] * (((const f32x4*)scale)[lane + 64 * j] + 1.0f); sh[j] = ((const f32x4*)shift)[lane + 64 * j]; }
#pragma unroll
    for (int r = 0; r < NR; ++r) { float a = 0.f;
#pragma unroll
        for (int j = 0; j < 4; ++j) a += (v[r][j].x * v[r][j].x + v[r][j].y * v[r][j].y) + (v[r][j].z * v[r][j].z + v[r][j].w * v[r][j].w);
        s[r] = a; }
#pragma unroll
    for (int o = 1; o < 64; o <<= 1)
#pragma unroll
        for (int r = 0; r < NR; ++r) s[r] += __shfl_xor(s[r], o);
#pragma unroll
    for (int r = 0; r < NR; ++r) { const float rstd = RSQF(s[r] * (1.f / DM) + EPS); u32x2* o8 = (u32x2*)orow[r] + lane;
#pragma unroll
        for (int j = 0; j < 4; ++j) { const f32x4 y = v[r][j] * rstd * gs[j] + sh[j];
            u32x2 w; w.x = pk2(y.x, y.y); w.y = pk2(y.z, y.w); o8[64 * j] = w; } }
}
DEV u32x4 pack8(f32x4 a, f32x4 b) { u32x4 w; w.x = pk2(a.x, a.y); w.y = pk2(a.z, a.w); w.z = pk2(b.x, b.y); w.w = pk2(b.z, b.w); return w; }
DEV void unpack8(u32x4 w, f32x4& a, f32x4& b) { a.x = bflo(w.x); a.y = bfhi(w.x); a.z = bflo(w.y); a.w = bfhi(w.y); b.x = bflo(w.z); b.y = bfhi(w.z); b.z = bflo(w.w); b.w = bfhi(w.w); }
template <int NR> DEV void norm_mod_rows_bf(const bf16_t* const (&xrow)[NR], const float* g, const float* shift, const float* scale, bf16_t* const (&orow)[NR], int lane) {
    u32x4 v[NR][2]; float s[NR];
#pragma unroll
    for (int r = 0; r < NR; ++r)
#pragma unroll
        for (int j = 0; j < 2; ++j) v[r][j] = ((const u32x4*)xrow[r])[lane + 64 * j];
    f32x4 gs[2][2], sh[2][2];
#pragma unroll
    for (int j = 0; j < 2; ++j)
#pragma unroll
        for (int h = 0; h < 2; ++h) { const int o = 2 * lane + 128 * j + h; gs[j][h] = ((const f32x4*)g)[o] * (((const f32x4*)scale)[o] + 1.0f); sh[j][h] = ((const f32x4*)shift)[o]; }
#pragma unroll
    for (int r = 0; r < NR; ++r) { float a = 0.f;
#pragma unroll
        for (int j = 0; j < 2; ++j) { f32x4 p0, p1; unpack8(v[r][j], p0, p1); a += ((p0.x * p0.x + p0.y * p0.y) + (p0.z * p0.z + p0.w * p0.w)) + ((p1.x * p1.x + p1.y * p1.y) + (p1.z * p1.z + p1.w * p1.w)); }
        s[r] = a; }
#pragma unroll
    for (int o = 1; o < 64; o <<= 1)
#pragma unroll
        for (int r = 0; r < NR; ++r) s[r] += __shfl_xor(s[r], o);
#pragma unroll
    for (int r = 0; r < NR; ++r) { const float rstd = RSQF(s[r] * (1.f / DM) + EPS); u32x4* o16 = (u32x4*)orow[r] + lane;
#pragma unroll
        for (int j = 0; j < 2; ++j) { f32x4 p0, p1; unpack8(v[r][j], p0, p1);
            o16[64 * j] = pack8(p0 * rstd * gs[j][0] + sh[j][0], p1 * rstd * gs[j][1] + sh[j][1]); } }
}
constexpr int SW_IN = 16 * (7744 / 64), SW_SQ = 3 * 256, SW_RT = 16 * (NEXP / 64), SW_GU = 2 * 64, SW_SD = 64, SW_ALL = SW_IN + SW_SQ + SW_RT + SW_GU + SW_SD;
DEV T64 small_item(Frame& F, int it) {
    T64 t;
    if (it < SW_IN) { const int kb = it / 121, nb = it % 121; t.W = F.pp->in[8]; t.K = 1024; t.N = 7744; t.WT = WSP(bf16_t, WS_WIN); t.k0 = kb * 64; t.n0 = nb * 64; t.dst_row = map_in(nb * 64); t.dst_hi = map_in(nb * 64 + 32); return t; }
    it -= SW_IN;
    if (it < SW_SQ) { const int w = it >> 8, jj = it & 255, kb = jj >> 4, nb = jj & 15; t.W = F.pp->in[20 + w]; t.K = 1024; t.N = 1024; t.WT = w == 0 ? WSP(bf16_t, WS_WSO) : (w == 1 ? WSP(bf16_t, WS_WMO) : WSP(bf16_t, WS_WOUT));
        t.k0 = kb * 64; t.n0 = nb * 64; t.dst_row = nb * 64; t.dst_hi = t.dst_row + 32; return t; }
    it -= SW_SQ;
    if (it < SW_RT) { const int kb = it / (NEXP / 64), nb = it % (NEXP / 64); t.W = F.pp->in[23]; t.K = 1024; t.N = NEXP; t.WT = WSP(bf16_t, WS_WRS); t.k0 = kb * 64; t.n0 = nb * 64; t.dst_row = nb * 64; t.dst_hi = t.dst_row + 32; return t; }
    it -= SW_RT;
    if (it < SW_GU) { const int up = it >> 6, jj = it & 63, kb = jj >> 2, nb = jj & 3; t.W = F.pp->in[28 + up]; t.K = 1024; t.N = 256; t.WT = WSP(bf16_t, WS_WRS); t.k0 = kb * 64; t.n0 = nb * 64; t.dst_row = 256 + map_gu(nb * 64, up); t.dst_hi = t.dst_row + 32; return t; }
    it -= SW_GU;
    { const int kb = it >> 4, nb = it & 15; t.W = F.pp->in[30]; t.K = 256; t.N = 1024; t.WT = WSP(bf16_t, WS_WSD); t.k0 = kb * 64; t.n0 = nb * 64; t.dst_row = nb * 64; t.dst_hi = t.dst_row + 32; return t; }
}
DEV void p1_xn(Frame& F) {
    const float* mod = WSP(float, WS_MOD); bf16_t* XN = WSP(bf16_t, WS_XN);
    const int gw = F.bid * 8 + F.wave, NGW = F.G * 8;
    static_assert(NROWS % 8 == 0 && SEQ % 8 == 0 && NLAT % 8 == 0, "row octets");
    LAS float* scr = (LAS float*)(F.lds) + F.wave * (64 * 65);
#pragma unroll 1
    for (int q = gw; q < NROWS / 8 + SW_ALL; q += NGW) {
        if (q < NROWS / 8) {
            const float* src[8]; bf16_t* dst[8];
#pragma unroll
            for (int i = 0; i < 8; ++i) { const int r = q * 8 + i; src[i] = r < NLAT ? F.pp->in[0] + (size_t)r * DM : F.pp->in[2] + (size_t)(r - NLAT) * DM; dst[i] = XN + (size_t)r * DM; }
            const int mv = q * 8 < NLAT ? (q * 8) / SEQ : 2;
            norm_mod_rows<8>(src, F.pp->in[6], mod + mv * 6144, mod + mv * 6144 + 1024, dst, F.lane);
        } else { const T64 t = small_item(F, q - NROWS / 8); f32x4 v[16]; t64_load(t, v, F.lane); t64_store(t, v, scr, F.lane); }
    }
    SYNC();
}
DEV void xn2_tile(Frame& F, int pm) {
    const float* mod = WSP(float, WS_MOD); bf16_t* XN = WSP(bf16_t, WS_XN);
    for (int q = F.wave; q < 64; q += 8) {
        const bf16_t* src[4]; bf16_t* dst[4];
#pragma unroll
        for (int i = 0; i < 4; ++i) { const int r = pm * 256 + q * 4 + i; src[i] = (const bf16_t*)F.out + (size_t)r * X1LD; dst[i] = XN + (size_t)r * DM; }
        const int mv = (pm * 256) / SEQ;
        norm_mod_rows_bf<4>(src, F.pp->in[7], mod + mv * 6144 + 3 * 1024, mod + mv * 6144 + 4 * 1024, dst, F.lane);
    }
    VM_DRAIN();
    SYNC();
}

DEV size_t um(int row, int col, int W) { return ((size_t)(col / W) * NROWS + row) * W + (col % W); }
DEV size_t um_xbc(int row, int col) { return col < 1024 ? um(row, col, 64) : (size_t)NROWS * 1024 + um(row, col - 1024, 128); }
#ifndef CONV_FUSED
#define CONV_FUSED 1
#endif
typedef f32x4 AccT[2][2][4][2];
DEV u32x2 pack4(f32x4 a) { u32x2 w; w.x = pk2(a.x, a.y); w.y = pk2(a.z, a.w); return w; }
DEV f32x4 sig4(f32x4 a) { f32x4 r; r.x = sigmoidf_(a.x); r.y = sigmoidf_(a.y); r.z = sigmoidf_(a.z); r.w = sigmoidf_(a.w); return r; }

#ifndef HOST_EMU
template <int D> DEV float rot16(float v, int) { return __builtin_bit_cast(float, __builtin_amdgcn_update_dpp(0, __builtin_bit_cast(int, v), 0x120 + ((16 - D) & 15), 0xF, 0xF, false)); }
#else
template <int D> DEV float rot16(float v, int lane) { return __shfl(v, (lane & 48) | ((lane + D) & 15)); }
#endif
struct EpiInProj {
    static constexpr bool PERM = true;
    bf16_t *Z, *XBC, *QK, *V, *O, *MG; float* DTG; const float *cwx, *cbx, *cwq, *cbq; LAS unsigned char* ldsx;
    DEV void operator()(const AccT& acc, const pg8::Unit& u, int wr, int wc, int fr_in, int fq_in) const {
        int fr = fr_in, fq = fq_in; OPAQUE_V(fr); OPAQUE_V(fq);
        const int row0 = u.pm * 256 + wr * 64 + fr; const int t = u.pn;
        if (CONV_FUSED && t >= 4 && t < 14 && u.pm * 256 < NLAT) {
            const bool isx = t < 10; bf16_t* base = isx ? XBC : QK; const int ldc = isx ? 1536 : 1024, colt = isx ? (t - 4) * 256 : (t - 10) * 256;
            const float* cw = isx ? cwx : cwq; const float* cb = isx ? cbx : cbq; const float osc = (!isx && colt < 512) ? 0.125f : 1.0f;
            const int lane = fq * 16 + fr;
            LAS float* wl = (LAS float*)(ldsx + (wr * 4 + wc) * 1536);
#pragma unroll
            for (int r = 0; r < 6; ++r) { const int cidx = lane, col = colt + (cidx >> 5) * 128 + wc * 32 + (cidx & 31); wl[r * 64 + cidx] = r < 5 ? cw[(size_t)r * ldc + col] : cb[col]; }
            WAVE_LDS_FENCE();
#pragma unroll
            for (int bj = 0; bj < 2; ++bj)
#pragma unroll
                for (int n = 0; n < 2; ++n) { const int col0 = colt + bj * 128 + wc * 32 + 8 * fq + 4 * n;
#pragma unroll
                    for (int ai = 0; ai < 2; ++ai) { f32x4 o[4];
#pragma unroll
                        for (int i = 0; i < 4; ++i) { float r1[5], r2[5], l1[5], l2[5]; r1[4] = 0.f; r2[4] = 0.f; l1[0] = 0.f; l2[0] = 0.f;
                            const int ci = bj * 32 + 8 * fq + 4 * n + i; const float w0 = wl[ci], w1 = wl[64 + ci], w2 = wl[128 + ci], w3 = wl[192 + ci], w4 = wl[256 + ci], bb = wl[320 + ci];
#pragma unroll
                            for (int m = 0; m < 4; ++m) { const float v = acc[ai][bj][m][n][i]; r1[m] = rot16<1>(v, lane); r2[m] = rot16<2>(v, lane); l1[m + 1] = rot16<-1>(v, lane); l2[m + 1] = rot16<-2>(v, lane); }
#pragma unroll
                            for (int m = 0; m < 4; ++m) { const float v = acc[ai][bj][m][n][i];
                                const float n1 = fr < 15 ? r1[m] : r1[m + 1], n2 = fr < 14 ? r2[m] : r2[m + 1], p1 = fr > 0 ? l1[m + 1] : l1[m], p2 = fr > 1 ? l2[m + 1] : l2[m];
                                const float a = bb + w0 * p2 + w1 * p1 + w2 * v + w3 * n1 + w4 * n2;
                                o[m][i] = siluf_(a) * osc; }
                            }
#pragma unroll
                        for (int m = 0; m < 4; ++m) { const int rr = row0 + ai * 128 + m * 16; *(u32x2*)(base + (isx ? um_xbc(rr, col0) : um(rr, col0, 64))) = pack4(o[m]); }
                        MEM_FENCE(); SCHED_FENCE(); } }
        } else if (t < 30) {
            bf16_t* base; int ldc, colt, kind; bool act = false;
            if (t < 4) { base = Z; ldc = 1024; colt = t * 256; kind = 64; }
            else if (t < 10) { base = XBC; ldc = 1536; colt = (t - 4) * 256; kind = 1; }
            else if (t < 14) { base = QK; ldc = 1024; colt = (t - 10) * 256; kind = 64; }
            else if (t < 18) { base = V; ldc = 1024; colt = (t - 14) * 256; kind = 128; }
            else if (t < 22) { base = O; ldc = 1024; colt = (t - 18) * 256; act = true; kind = 128; }
            else { base = MG; ldc = 2048; colt = (t - 22) * 256; act = true; kind = 0; }
            const int col0 = colt + wc * 32 + 8 * fq;
#pragma unroll
            for (int ai = 0; ai < 2; ++ai)
#pragma unroll
                for (int m = 0; m < 4; ++m) { const int rr = row0 + ai * 128 + m * 16;
#pragma unroll
                    for (int bj = 0; bj < 2; ++bj) { f32x4 v0 = acc[ai][bj][m][0], v1 = acc[ai][bj][m][1]; const int cc = col0 + bj * 128;
                        if (act) { v0 = sig4(v0); v1 = sig4(v1); }
                        const size_t off = kind == 0 ? (size_t)rr * ldc + cc : (kind == 1 ? um_xbc(rr, cc) : um(rr, cc, kind));
                        *(u32x4*)(base + off) = pack8(v0, v1); }
                    MEM_FENCE(); SCHED_FENCE(); }
        } else if (wc < 2) {
#pragma unroll
            for (int ai = 0; ai < 2; ++ai)
#pragma unroll
                for (int m = 0; m < 4; ++m)
#pragma unroll
                    for (int n = 0; n < 2; ++n) { const int c0 = 32 * wc + 8 * fq + 4 * n;
                        *(f32x4*)(DTG + (size_t)(row0 + ai * 128 + m * 16) * 64 + c0) = acc[ai][0][m][n]; }
        }
    }
};
struct EpiG1 {
    static constexpr bool PERM = true;
    bf16_t* M1; const bf16_t* MG; const float* SSQ;
    DEV void operator()(const AccT& acc, const pg8::Unit& u, int wr, int wc, int fr, int fq) const {
        const int row0 = u.pm * 256 + wr * 64 + fr, col0 = u.pn * 256 + wc * 32 + 8 * fq;
#pragma unroll
        for (int ai = 0; ai < 2; ++ai)
#pragma unroll
            for (int m = 0; m < 4; ++m) { const size_t row = (size_t)(row0 + ai * 128 + m * 16);
                const f32x4* sq = (const f32x4*)(SSQ + row * 16); const f32x4 q0 = sq[0], q1 = sq[1], q2 = sq[2], q3 = sq[3];
                const float ss = ((q0.x + q0.y) + (q0.z + q0.w)) + ((q1.x + q1.y) + (q1.z + q1.w)) + ((q2.x + q2.y) + (q2.z + q2.w)) + ((q3.x + q3.y) + (q3.z + q3.w));
                const float rstd = RSQF(ss * (1.f / 1024.f) + EPS);
#pragma unroll
                for (int bj = 0; bj < 2; ++bj) { f32x4 g0, g1; unpack8(*(const u32x4*)(MG + row * 2048 + col0 + bj * 128), g0, g1);
                    *(u32x4*)(M1 + row * 1024 + col0 + bj * 128) = pack8(acc[ai][bj][m][0] * g0 * rstd, acc[ai][bj][m][1] * g1 * rstd); } }
    }
};
struct EpiG2 {
    static constexpr bool PERM = true;
    bf16_t* MERGED; const bf16_t* M1; const bf16_t* MG;
    DEV void operator()(const AccT& acc, const pg8::Unit& u, int wr, int wc, int fr, int fq) const {
        const int row0 = u.pm * 256 + wr * 64 + fr, col0 = u.pn * 256 + wc * 32 + 8 * fq;
#pragma unroll
        for (int ai = 0; ai < 2; ++ai)
#pragma unroll
            for (int m = 0; m < 4; ++m) { const size_t row = (size_t)(row0 + ai * 128 + m * 16);
#pragma unroll
                for (int bj = 0; bj < 2; ++bj) { f32x4 g0, g1, p0, p1; unpack8(*(const u32x4*)(MG + row * 2048 + 1024 + col0 + bj * 128), g0, g1);
                    unpack8(*(const u32x4*)(M1 + row * 1024 + col0 + bj * 128), p0, p1);
                    *(u32x4*)(MERGED + row * 1024 + col0 + bj * 128) = pack8(p0 + acc[ai][bj][m][0] * g0, p1 + acc[ai][bj][m][1] * g1); } }
    }
};
struct EpiG3 {
    static constexpr bool PERM = true;
    const float* x; bf16_t* x1; const float* mod;
    DEV void operator()(const AccT& acc, const pg8::Unit& u, int wr, int wc, int fr, int fq) const {
        const int row0 = u.pm * 256 + wr * 64 + fr, col0 = u.pn * 256 + wc * 32 + 8 * fq;
        const float* gate = mod + ((u.pm * 256) / SEQ) * 6144 + 2 * 1024;
#pragma unroll
        for (int bj = 0; bj < 2; ++bj) { const int c = col0 + bj * 128; const f32x4 g0 = *(const f32x4*)(gate + c), g1 = *(const f32x4*)(gate + c + 4);
#pragma unroll
            for (int ai = 0; ai < 2; ++ai)
#pragma unroll
                for (int m = 0; m < 4; ++m) { const size_t row = (size_t)(row0 + ai * 128 + m * 16); const float* xp = x + row * 1024 + c;
                    const f32x4 v0 = *(const f32x4*)xp + g0 * acc[ai][bj][m][0], v1 = *(const f32x4*)(xp + 4) + g1 * acc[ai][bj][m][1];
                    *(u32x4*)(x1 + row * X1LD + c) = pack8(v0, v1); } }
    }
};
struct EpiRS {
    static constexpr bool PERM = true;
    float* LOGIT; bf16_t* HS;
    DEV void operator()(const AccT& acc, const pg8::Unit& u, int wr, int wc, int fr, int fq) const {
        const int row0 = u.pm * 256 + wr * 64 + fr;
        if (u.pn == 0) {
            {
#pragma unroll
                for (int ai = 0; ai < 2; ++ai)
#pragma unroll
                    for (int m = 0; m < 4; ++m)
#pragma unroll
                        for (int bj = 0; bj < 2; ++bj)
#pragma unroll
                            for (int n = 0; n < 2; ++n) { const int c = bj * 128 + wc * 32 + 8 * fq + 4 * n;
                                if (c < NEXP) *(f32x4*)(LOGIT + (size_t)(row0 + ai * 128 + m * 16) * NEXP + c) = acc[ai][bj][m][n]; }
            }
        } else {
            const int col0 = (u.pn - 1) * 128 + wc * 32 + 8 * fq;
#pragma unroll
            for (int ai = 0; ai < 2; ++ai)
#pragma unroll
                for (int m = 0; m < 4; ++m) { f32x4 h0, h1;
#pragma unroll
                    for (int i = 0; i < 4; ++i) { h0[i] = siluf_(acc[ai][0][m][0][i]) * acc[ai][1][m][0][i]; h1[i] = siluf_(acc[ai][0][m][1][i]) * acc[ai][1][m][1][i]; }
                    *(u32x4*)(HS + (size_t)(row0 + ai * 128 + m * 16) * 256 + col0) = pack8(h0, h1); }
        }
    }
};
struct EpiX1 {
    static constexpr bool PERM = true;
    bf16_t* H;
    DEV void operator()(const AccT& acc, const pg8::Unit& u, int wr, int wc, int fr, int fq) const {
        const int row0 = u.pm * 256 + wr * 64 + fr, col0 = u.pn * 128 + wc * 32 + 8 * fq;
#pragma unroll
        for (int ai = 0; ai < 2; ++ai)
#pragma unroll
            for (int m = 0; m < 4; ++m) { f32x4 h0, h1;
#pragma unroll
                for (int i = 0; i < 4; ++i) { h0[i] = siluf_(acc[ai][0][m][0][i]) * acc[ai][1][m][0][i]; h1[i] = siluf_(acc[ai][0][m][1][i]) * acc[ai][1][m][1][i]; }
                *(u32x4*)(H + (size_t)(row0 + ai * 128 + m * 16) * 256 + col0) = pack8(h0, h1); }
    }
};
struct EpiX2 {
    static constexpr bool PERM = true;
    static constexpr bool W16 = true;
    unsigned char* Y8; signed char* YSC; const int* sdst; const float* sw;
    DEV void operator()(const AccT& acc, const pg8::Unit& u, int wr, int wc, int fr, int fq) const {
        const int row0 = u.pm * 256 + wr * 64 + fr, c16 = u.pn * 256 + wc * 64 + 16 * fq;
        int dst[8]; float w[8];
#pragma unroll
        for (int r = 0; r < 8; ++r) { const int slot = row0 + (r >> 2) * 128 + (r & 3) * 16; dst[r] = sdst[slot]; w[r] = sw[slot]; }
#pragma unroll
        for (int ai = 0; ai < 2; ++ai)
#pragma unroll
            for (int m = 0; m < 4; ++m) { const int d = dst[ai * 4 + m]; const float ww = w[ai * 4 + m];
                if (d >= 0) { int ex; const u32x4 q = fp8_block16(acc[ai][0][m][0] * ww, acc[ai][0][m][1] * ww, acc[ai][1][m][0] * ww, acc[ai][1][m][1] * ww, ex);
                    *(u32x4*)(Y8 + (size_t)d * 1024 + c16) = q; YSC[(size_t)d * 64 + (c16 >> 4)] = (signed char)ex; } }
    }
};
struct EpiSD {
    static constexpr bool PERM = true;
    static constexpr bool W16 = true;
    unsigned char* YS8; signed char* YSE;
    DEV void operator()(const AccT& acc, const pg8::Unit& u, int wr, int wc, int fr, int fq) const {
        const int row0 = u.pm * 256 + wr * 64 + fr, c16 = u.pn * 256 + wc * 64 + 16 * fq;
#pragma unroll
        for (int ai = 0; ai < 2; ++ai)
#pragma unroll
            for (int m = 0; m < 4; ++m) { const size_t row = (size_t)(row0 + ai * 128 + m * 16); int ex;
                const u32x4 q = fp8_block16(acc[ai][0][m][0], acc[ai][0][m][1], acc[ai][1][m][0], acc[ai][1][m][1], ex);
                *(u32x4*)(YS8 + row * 1024 + c16) = q; YSE[row * 64 + (c16 >> 4)] = (signed char)ex;
                MEM_FENCE(); }
    }
};

DEV int chunk_row0(int b, int cc) { return cc < NCH ? b * SEQ + cc * CHUNK : NLAT + b * CTXL + (cc - NCH) * CHUNK; }

struct GateBias { const float *dtb, *ib, *fb; };
template <bool ML> DEV void tok_ag(const float* DTG, const float* aneg, const GateBias& gbv, size_t row, int dir, int hg, float& a, float& g) {
    if (!ML) { const float dt = softplusf_(DTG[row * 64 + dir * 16 + hg] + gbv.dtb[dir * 16 + hg]); a = dt * aneg[dir * 16 + hg]; g = dt; }
    else { const float ig = DTG[row * 64 + 32 + dir * 16 + hg] + gbv.ib[dir * 8 + hg]; a = logsigmoidf_(DTG[row * 64 + 32 + dir * 16 + 8 + hg] + gbv.fb[dir * 8 + hg]); g = EXPF(ig); }
}
struct CtxW { float w[5][8], b[8]; };
DEV void ctx_conv_prep(CtxW& c, const float* cw, const float* cb, int ld, int col) {
#pragma unroll
    for (int j = 0; j < 5; ++j) { const f32x4 a = *(const f32x4*)(cw + (size_t)j * ld + col), d = *(const f32x4*)(cw + (size_t)j * ld + col + 4);
#pragma unroll
        for (int i = 0; i < 4; ++i) { c.w[j][i] = a[i]; c.w[j][4 + i] = d[i]; } }
    const f32x4 a = *(const f32x4*)(cb + col), d = *(const f32x4*)(cb + col + 4);
#pragma unroll
    for (int i = 0; i < 4; ++i) { c.b[i] = a[i]; c.b[4 + i] = d[i]; }
}
DEV u32x4 ctx_conv_chunk(const CtxW& c, const bf16_t* buf, int ld  , int seg0, int kseg, int col) {
    float a[8];
#pragma unroll
    for (int i = 0; i < 8; ++i) a[i] = c.b[i];
#pragma unroll
    for (int j = 0; j < 5; ++j) { const int kk = kseg + j - 2;
        if (kk >= 0 && kk < CTXL) { f32x4 v0, v1; unpack8(*(const u32x4*)(buf + (ld == 1536 ? um_xbc(seg0 + kk, col) : um(seg0 + kk, col, 64))), v0, v1);
#pragma unroll
            for (int i = 0; i < 4; ++i) { a[i] += c.w[j][i] * v0[i]; a[4 + i] += c.w[j][4 + i] * v1[i]; } } }
    f32x4 o0, o1;
#pragma unroll
    for (int i = 0; i < 4; ++i) { o0[i] = siluf_(a[i]); o1[i] = siluf_(a[4 + i]); }
    return pack8(o0, o1);
}

DEV int chunk_order(int dir, int s) { return dir == 0 ? (s < NCHC ? NCH + s : s - NCHC) : (s < NCHC ? NCH + (NCHC - 1 - s) : NCH - 1 - (s - NCHC)); }
DEV void p5_scan(Frame& F) {
    constexpr int NS_ = BATCH * 2 * SSD_H * SSD_P * (SSD_N / 8); const int NS = NS_, NM = BATCH * 2 * ML_H * ML_PP * (ML_DK / 8);
    static_assert(NS_ % 64 == 0, "whole waves of SSD chains");
    for (int task = F.wave * F.G + F.bid; task * 64 < NS + NM; task += 8 * F.G) { const int idx = task * 64 + F.lane;
        if (idx >= NS + NM) continue;
        bf16_t* base; const float* dec; size_t cstride; int dstride, dir;
        if (idx < NS) { const int n8 = idx % 16, p = (idx / 16) % 64, hd = (idx / 1024) % 16; dir = (idx / 16384) % 2; const int b = idx / 32768;
            base = WSP(bf16_t, WS_STS) + (size_t)(b * 2 + dir) * NCHT * STS_CH + ((size_t)hd * 64 + p) * 128 + n8 * 8; cstride = STS_CH;
            dec = WSP(float, WS_DECS) + (size_t)(b * 2 + dir) * NCHT * 16 + hd; dstride = 16; }
        else { const int j = idx - NS; const int n8 = j % 8, p = (j / 8) % 144, hd = (j / 1152) % 8; dir = (j / 9216) % 2; const int b = j / 18432;
            base = WSP(bf16_t, WS_STM) + (size_t)(b * 2 + dir) * NCHT * STM_CH + ((size_t)hd * 144 + p) * 64 + n8 * 8; cstride = STM_CH;
            dec = WSP(float, WS_DECM) + (size_t)(b * 2 + dir) * NCHT * 8 + hd; dstride = 8; }
        f32x4 c0 = {0.f, 0.f, 0.f, 0.f}, c1 = {0.f, 0.f, 0.f, 0.f};
        constexpr int UB = (NCHT % 10 == 0) ? 10 : ((NCHT % 2 == 0) ? 2 : 1);
        for (int s0 = 0; s0 < NCHT; s0 += UB) {
            u32x4 v[UB]; float d[UB];
#pragma unroll
            for (int j = 0; j < UB; ++j) { const int cc = chunk_order(dir, s0 + j); v[j] = *(const u32x4*)(base + (size_t)cc * cstride); d[j] = dec[cc * dstride]; }
#pragma unroll
            for (int j = 0; j < UB; ++j) { const int cc = chunk_order(dir, s0 + j);
                if (cc < NCH) *(u32x4*)(base + (size_t)cc * cstride) = pack8(c0, c1);
                f32x4 a0, a1; unpack8(v[j], a0, a1); c0 = c0 * d[j] + a0; c1 = c1 * d[j] + a1; }
        }
    }
}

DEV bf16x8 tr_frag(const LAS bf16_t* T, int LD, int k0, int c0, int lane) {
    const LAS bf16_t* p0 = T + (k0 + 8 * (lane >> 4) + ((lane & 15) >> 2)) * LD + c0 + 4 * (lane & 3);
    const s16x4 a = lds_tr16(p0), b = lds_tr16(p0 + 4 * LD);
    bf16x8 r; r[0] = a[0]; r[1] = a[1]; r[2] = a[2]; r[3] = a[3]; r[4] = b[0]; r[5] = b[1]; r[6] = b[2]; r[7] = b[3]; return r;
}
DEV bf16x8 tr_frag8(const LAS bf16_t* T, int LD, int k0, int c0, int lane) {
    const LAS bf16_t* p0 = T + (k0 + 8 * (lane >> 4) + ((lane & 15) >> 2)) * LD + c0 + 8 * (lane & 3);
    const s16x4 a = lds_tr16(p0), b = lds_tr16(p0 + 4 * LD);
    bf16x8 r; r[0] = a[0]; r[1] = a[1]; r[2] = a[2]; r[3] = a[3]; r[4] = b[0]; r[5] = b[1]; r[6] = b[2]; r[7] = b[3]; return r;
}
DEV bf16x8 row_frag(const LAS bf16_t* T, int LD, int r0, int k0, int lane) { return *(const LAS bf16x8*)(T + (r0 + (lane & 15)) * LD + k0 + 8 * (lane >> 4)); }
DEV float gtv(u32x2 g, int i) { return i == 0 ? bflo(g.x) : (i == 1 ? bfhi(g.x) : (i == 2 ? bflo(g.y) : bfhi(g.y))); }

DEV void s3v2_ssd(Frame& F, int b, int cc, int gi, const float* aneg) {
    constexpr int LDC = 136, LDX = 80;
    const bf16_t* XBC = WSP(bf16_t, WS_XBC); const float* DTG = WSP(float, WS_DTG); const bf16_t* Z = WSP(bf16_t, WS_Z); bf16_t* YP = WSP(bf16_t, WS_YPRE); float* SSQ = WSP(float, WS_SSQ);
    LAS bf16_t* CQ = (LAS bf16_t*)F.lds;
    LAS bf16_t* GLB = CQ + 128 * LDC;
    LAS bf16_t* XS = GLB + 128 * LDC;
    LAS bf16_t* STF = XS + 128 * LDX;
    LAS bf16_t* STB = STF + 64 * LDC;
    LAS float* Pf = (LAS float*)(STB + 64 * LDC);
    LAS float* Eb = Pf + 128; LAS float* gf = Eb + 128; LAS float* gb = gf + 128; LAS float* itf = gb + 128; LAS float* itb = itf + 128;
    int tid_ = F.tid; OPAQUE_V(tid_);
    const int row0 = chunk_row0(b, cc), w = F.wave, tid = tid_, lane = tid & 63, lq = lane >> 4, lc = lane & 15;
    SYNC();
    for (int idx = tid; idx < 128 * 16; idx += NTHR) { const int k = idx >> 4, n8 = idx & 15;
        *(LAS u32x4*)(CQ + k * LDC + n8 * 8) = *(const u32x4*)(XBC + um_xbc(row0 + k, 1280 + gi * 128 + n8 * 8));
        *(LAS u32x4*)(GLB + k * LDC + n8 * 8) = *(const u32x4*)(XBC + um_xbc(row0 + k, 1024 + gi * 128 + n8 * 8)); }
    u32x4 rx[2], rsf[2], rsb[2]; float rdt[2];
#define S3S_LOAD(hh) do { const int hg_ = gi * 8 + (hh); \
        _Pragma("unroll") for (int j_ = 0; j_ < 2; ++j_) { const int id_ = tid + NTHR * j_; \
            rx[j_] = *(const u32x4*)(XBC + um_xbc(row0 + (id_ >> 3), hg_ * 64 + (id_ & 7) * 8)); \
            rsf[j_] = *(const u32x4*)(WSP(bf16_t, WS_STS) + ((size_t)(b * 2 + 0) * NCHT + cc) * STS_CH + (size_t)hg_ * 8192 + (size_t)id_ * 8); \
            rsb[j_] = *(const u32x4*)(WSP(bf16_t, WS_STS) + ((size_t)(b * 2 + 1) * NCHT + cc) * STS_CH + (size_t)hg_ * 8192 + (size_t)id_ * 8); \
            } \
        if (w < 2) { rdt[0] = DTG[(size_t)(row0 + lane) * 64 + w * 16 + hg_]; rdt[1] = DTG[(size_t)(row0 + 64 + lane) * 64 + w * 16 + hg_]; } } while (0)
    S3S_LOAD(0);
    SYNC();
    bf16x8 aC[4];
#pragma unroll
    for (int ns = 0; ns < 4; ++ns) aC[ns] = row_frag(CQ, LDC, w * 16, ns * 32, lane);
    u32x2 Gt[8];
#pragma unroll
    for (int ct = 0; ct < 8; ++ct) { f32x4 z = {0.f, 0.f, 0.f, 0.f};
#pragma unroll
        for (int ns = 0; ns < 4; ++ns) z = mfma16(row_frag(GLB, LDC, ct * 16, ns * 32, lane), aC[ns], z);
        Gt[ct] = pack4(z); }
    TOUCH(rx[0]); TOUCH(rx[1]); TOUCH(rsf[0]); TOUCH(rsf[1]); TOUCH(rsb[0]); TOUCH(rsb[1]); TOUCH(rdt[0]); TOUCH(rdt[1]);
#pragma unroll 1
    for (int h = 0; h < 8; ++h) {
        const int hg = gi * 8 + h;
        SYNC();
#pragma unroll
        for (int j = 0; j < 2; ++j) { const int id = tid + NTHR * j;
            *(LAS u32x4*)(XS + (id >> 3) * LDX + (id & 7) * 8) = rx[j];
            *(LAS u32x4*)(STF + (id >> 4) * LDC + (id & 15) * 8) = rsf[j];
            *(LAS u32x4*)(STB + (id >> 4) * LDC + (id & 15) * 8) = rsb[j]; }
        if (w < 2) { const float an = aneg[w * 16 + hg], db = F.pp->in[11][w * 16 + hg]; rdt[0] = softplusf_(rdt[0] + db); rdt[1] = softplusf_(rdt[1] + db); const float a0 = rdt[0] * an, a1 = rdt[1] * an;
            const float p0 = wave_incl_scan(a0, lane); const float t0 = __shfl(p0, 63);
            const float p1 = wave_incl_scan(a1, lane) + t0; const float T = __shfl(p1, 63);
            if (w == 0) { Pf[lane] = p0; Pf[64 + lane] = p1; gf[lane] = rdt[0]; gf[64 + lane] = rdt[1]; itf[lane] = EXPF(p0); itf[64 + lane] = EXPF(p1); }
            else { const float e0 = p0 - a0, e1 = p1 - a1; Eb[lane] = e0; Eb[64 + lane] = e1; gb[lane] = rdt[0]; gb[64 + lane] = rdt[1]; itb[lane] = EXPF(T - e0); itb[64 + lane] = EXPF(T - e1); } }
        if (h + 1 < 8) S3S_LOAD(h + 1);
        SYNC();
        const u32x4 zc0 = *(const u32x4*)(Z + um(row0 + 16 * w + (lane >> 3), hg * 64 + (lane & 7) * 8, 64)), zc1 = *(const u32x4*)(Z + um(row0 + 16 * w + (lane >> 3) + 8, hg * 64 + (lane & 7) * 8, 64));
        { const int q = w * 16 + lc; const float pfq = Pf[q], ebq = Eb[q];
#pragma unroll
          for (int ct = 0; ct < 8; ++ct) { const int k0 = ct * 16 + 4 * lq, rel = ct - w; f32x4 fac;
              if (rel < 0) { const f32x4 pk = *(const LAS f32x4*)(Pf + k0), gk = *(const LAS f32x4*)(gf + k0);
#pragma unroll
                  for (int i = 0; i < 4; ++i) fac[i] = EXPF(pfq - pk[i]) * gk[i]; }
              else if (rel > 0) { const f32x4 ek = *(const LAS f32x4*)(Eb + k0), gk = *(const LAS f32x4*)(gb + k0);
#pragma unroll
                  for (int i = 0; i < 4; ++i) fac[i] = EXPF(ek[i] - ebq) * gk[i]; }
              else { const f32x4 pk = *(const LAS f32x4*)(Pf + k0), gfk = *(const LAS f32x4*)(gf + k0), ek = *(const LAS f32x4*)(Eb + k0), gbk = *(const LAS f32x4*)(gb + k0);
#pragma unroll
                  for (int i = 0; i < 4; ++i) { const int d = lc - (4 * lq + i);
                      fac[i] = d > 0 ? EXPF(pfq - pk[i]) * gfk[i] : (d < 0 ? EXPF(ek[i] - ebq) * gbk[i] : gfk[i] + gbk[i]); } }
              f32x4 gv; gv[0] = bflo(Gt[ct].x); gv[1] = bfhi(Gt[ct].x); gv[2] = bflo(Gt[ct].y); gv[3] = bfhi(Gt[ct].y);
              *(LAS u32x2*)(GLB + q * LDC + k0) = pack4(gv * fac); } }
        WAVE_LDS_FENCE();
        bf16x8 aG[4];
#pragma unroll
        for (int ks = 0; ks < 4; ++ks) aG[ks] = row_frag(GLB, LDC, w * 16, ks * 32, lane);
        float iqf[4], iqb[4];
#pragma unroll
        for (int i = 0; i < 4; ++i) { iqf[i] = itf[w * 16 + 4 * lq + i]; iqb[i] = itb[w * 16 + 4 * lq + i]; }
        WAVE_LDS_FENCE();
        LAS float* OUTW = (LAS float*)(GLB + w * 16 * LDC);
#pragma unroll 1
        for (int pt = 0; pt < 4; ++pt) { f32x4 a1 = {0.f, 0.f, 0.f, 0.f}, af = {0.f, 0.f, 0.f, 0.f}, ab = {0.f, 0.f, 0.f, 0.f};
#pragma unroll
            for (int ks = 0; ks < 4; ++ks) a1 = mfma16(aG[ks], tr_frag(XS, LDX, ks * 32, pt * 16, lane), a1);
#pragma unroll
            for (int ns = 0; ns < 4; ++ns) { af = mfma16(aC[ns], row_frag(STF, LDC, pt * 16, ns * 32, lane), af); ab = mfma16(aC[ns], row_frag(STB, LDC, pt * 16, ns * 32, lane), ab); }
#pragma unroll
            for (int i = 0; i < 4; ++i) OUTW[(4 * lq + i) * (LDC / 2) + pt * 16 + lc] = a1[i] + iqf[i] * af[i] + iqb[i] * ab[i]; }
        WAVE_LDS_FENCE();
        if (h + 1 < 8) { TOUCH(rx[0]); TOUCH(rx[1]); TOUCH(rsf[0]); TOUCH(rsf[1]); TOUCH(rsb[0]); TOUCH(rsb[1]); TOUCH(rdt[0]); TOUCH(rdt[1]); }
        const float dsk = F.pp->in[13][hg]; const float* ng = F.pp->in[14] + hg * 64 + (lane & 7) * 8;
        const f32x4 ng0 = *(const f32x4*)ng, ng1 = *(const f32x4*)(ng + 4);
#pragma unroll
        for (int r = 0; r < 2; ++r) { const int ql = (lane >> 3) + 8 * r, ch = lane & 7; const size_t row = (size_t)(row0 + 16 * w + ql);
            const f32x4 y0 = *(const LAS f32x4*)(OUTW + ql * (LDC / 2) + ch * 8), y1 = *(const LAS f32x4*)(OUTW + ql * (LDC / 2) + ch * 8 + 4);
            f32x4 x0, x1, z0, z1; unpack8(*(const LAS u32x4*)(XS + (16 * w + ql) * LDX + ch * 8), x0, x1); unpack8(r == 0 ? zc0 : zc1, z0, z1);
            f32x4 t0, t1; float ss = 0.f;
#pragma unroll
            for (int i = 0; i < 4; ++i) { t0[i] = (y0[i] + dsk * x0[i]) * siluf_(z0[i]); t1[i] = (y1[i] + dsk * x1[i]) * siluf_(z1[i]); ss += t0[i] * t0[i] + t1[i] * t1[i]; }
            *(u32x4*)(YP + row * 1024 + hg * 64 + ch * 8) = pack8(t0 * ng0, t1 * ng1);
            ss += __shfl_xor(ss, 1); ss += __shfl_xor(ss, 2); ss += __shfl_xor(ss, 4);
            if (ch == 0) SSQ[row * 16 + hg] = ss; }
    }
#undef S3S_LOAD
}

struct MlRegs { u32x4 q[2], k[2], v[4], sf[3], sb[3]; float g[4]; };
DEV void s3v2_ml_load(Frame& F, MlRegs& R, int b, int cc, int hd) {
    const bf16_t* QK = WSP(bf16_t, WS_QK); const bf16_t* V = WSP(bf16_t, WS_V); const float* DTG = WSP(float, WS_DTG);
    int tid_ = F.tid; OPAQUE_V(tid_);
    const int row0 = chunk_row0(b, cc), tid = tid_, lane = tid & 63, w = F.wave;
#pragma unroll
    for (int j = 0; j < 2; ++j) { const int id = tid + NTHR * j; R.q[j] = *(const u32x4*)(QK + um(row0 + (id >> 3), hd * 64 + (id & 7) * 8, 64)); R.k[j] = *(const u32x4*)(QK + um(row0 + (id >> 3), 512 + hd * 64 + (id & 7) * 8, 64)); }
#pragma unroll
    for (int j = 0; j < 4; ++j) { const int id = tid + NTHR * j; R.v[j] = *(const u32x4*)(V + um(row0 + (id >> 4), hd * 128 + (id & 15) * 8, 128)); }
#pragma unroll
    for (int j = 0; j < 3; ++j) { const int id = tid + NTHR * j; if (id < 144 * 8) {
        R.sf[j] = *(const u32x4*)(WSP(bf16_t, WS_STM) + ((size_t)(b * 2 + 0) * NCHT + cc) * STM_CH + (size_t)hd * 9216 + (size_t)id * 8);
        R.sb[j] = *(const u32x4*)(WSP(bf16_t, WS_STM) + ((size_t)(b * 2 + 1) * NCHT + cc) * STM_CH + (size_t)hd * 9216 + (size_t)id * 8); } }
    if (w < 2) { R.g[0] = DTG[(size_t)(row0 + lane) * 64 + 32 + w * 16 + hd]; R.g[1] = DTG[(size_t)(row0 + 64 + lane) * 64 + 32 + w * 16 + hd];
                 R.g[2] = DTG[(size_t)(row0 + lane) * 64 + 32 + w * 16 + 8 + hd]; R.g[3] = DTG[(size_t)(row0 + 64 + lane) * 64 + 32 + w * 16 + 8 + hd]; }
}
DEV void s3v2_ml_item(Frame& F, MlRegs& R, int b, int cc, int hd, bool has_next, int nb, int ncc, int nhd) {
    constexpr int LDQ = 72, LDG = 136, LDV = 144;
    LAS bf16_t* CQ = (LAS bf16_t*)F.lds;
    LAS bf16_t* GLB = CQ + 128 * LDQ;
    LAS bf16_t* XS = GLB + 128 * LDG;
    LAS bf16_t* STF = XS + 128 * LDV;
    LAS bf16_t* STB = STF + 144 * LDQ;
    LAS float* Pf = (LAS float*)(STB + 144 * LDQ); LAS float* Eb = Pf + 128; LAS float* gf = Eb + 128; LAS float* gb = gf + 128; LAS float* itf = gb + 128; LAS float* itb = itf + 128;
    int tid_ = F.tid; OPAQUE_V(tid_);
    const int row0 = chunk_row0(b, cc), w = F.wave, tid = tid_, lane = tid & 63, lq = lane >> 4, lc = lane & 15;
    SYNC();
#pragma unroll
    for (int j = 0; j < 2; ++j) { const int id = tid + NTHR * j; *(LAS u32x4*)(CQ + (id >> 3) * LDQ + (id & 7) * 8) = R.q[j]; *(LAS u32x4*)(GLB + (id >> 3) * LDQ + (id & 7) * 8) = R.k[j]; }
#pragma unroll
    for (int j = 0; j < 4; ++j) { const int id = tid + NTHR * j; *(LAS u32x4*)(XS + (id >> 4) * LDV + (id & 15) * 8) = R.v[j]; }
    if (tid < 256) { const int k = tid >> 1, hf = tid & 1; u32x4 o = {0u, 0u, 0u, 0u}; if (hf == 0) o.x = 0x3F80u; *(LAS u32x4*)(XS + k * LDV + 128 + hf * 8) = o; }
#pragma unroll
    for (int j = 0; j < 3; ++j) { const int id = tid + NTHR * j; if (id < 144 * 8) { *(LAS u32x4*)(STF + (id >> 3) * LDQ + (id & 7) * 8) = R.sf[j]; *(LAS u32x4*)(STB + (id >> 3) * LDQ + (id & 7) * 8) = R.sb[j]; } }
    if (w < 2) { const float ibv = F.pp->in[17][w * 8 + hd], fbv = F.pp->in[18][w * 8 + hd];
        const float a0 = logsigmoidf_(R.g[2] + fbv), a1 = logsigmoidf_(R.g[3] + fbv), g0 = EXPF(R.g[0] + ibv), g1 = EXPF(R.g[1] + ibv);
        const float p0 = wave_incl_scan(a0, lane); const float t0 = __shfl(p0, 63);
        const float p1 = wave_incl_scan(a1, lane) + t0; const float T = __shfl(p1, 63);
        if (w == 0) { Pf[lane] = p0; Pf[64 + lane] = p1; gf[lane] = g0; gf[64 + lane] = g1; itf[lane] = EXPF(p0); itf[64 + lane] = EXPF(p1); }
        else { const float e0 = p0 - a0, e1 = p1 - a1; Eb[lane] = e0; Eb[64 + lane] = e1; gb[lane] = g0; gb[64 + lane] = g1; itb[lane] = EXPF(T - e0); itb[64 + lane] = EXPF(T - e1); } }
    if (has_next) s3v2_ml_load(F, R, nb, ncc, nhd);
    SYNC();
    bf16x8 aC[2];
#pragma unroll
    for (int ns = 0; ns < 2; ++ns) aC[ns] = row_frag(CQ, LDQ, w * 16, ns * 32, lane);
    u32x2 Gt[8];
#pragma unroll
    for (int ct = 0; ct < 8; ++ct) { f32x4 z = {0.f, 0.f, 0.f, 0.f};
#pragma unroll
        for (int ns = 0; ns < 2; ++ns) z = mfma16(row_frag(GLB, LDQ, ct * 16, ns * 32, lane), aC[ns], z);
        Gt[ct] = pack4(z); }
    SYNC();
    u32x4 oc[4];
#pragma unroll
    for (int r = 0; r < 4; ++r) oc[r] = *(const u32x4*)(WSP(bf16_t, WS_O) + um(row0 + 16 * w + (lane >> 4) + 4 * r, hd * 128 + (lane & 15) * 8, 128));
    bf16x8 aG[2][4]; f32x4 rden[2]; float iq[2][4];
#pragma unroll
    for (int dir = 0; dir < 2; ++dir) {
        const LAS float* PE = dir == 0 ? Pf : Eb; const LAS float* gg = dir == 0 ? gf : gb; const LAS float* it = dir == 0 ? itf : itb; const LAS bf16_t* ST = dir == 0 ? STF : STB;
#pragma unroll
        for (int i = 0; i < 4; ++i) iq[dir][i] = it[w * 16 + 4 * lq + i];
        WAVE_LDS_FENCE();
        { const int q = w * 16 + lc; const float peq = PE[q];
#pragma unroll
          for (int ct = 0; ct < 8; ++ct) { const int k0 = ct * 16 + 4 * lq, rel = ct - w; const bool tile_on = dir == 0 ? rel <= 0 : rel >= 0;
              u32x2 o = {0u, 0u};
              if (tile_on) { const f32x4 pek = *(const LAS f32x4*)(PE + k0), gk = *(const LAS f32x4*)(gg + k0); f32x4 fac;
#pragma unroll
                  for (int i = 0; i < 4; ++i) { const int d = lc - (4 * lq + i); const bool on = rel != 0 || (dir == 0 ? d >= 0 : d <= 0);
                      fac[i] = on ? EXPF(dir == 0 ? peq - pek[i] : pek[i] - peq) * gk[i] : 0.f; }
                  f32x4 gv; gv[0] = bflo(Gt[ct].x); gv[1] = bfhi(Gt[ct].x); gv[2] = bflo(Gt[ct].y); gv[3] = bfhi(Gt[ct].y);
                  o = pack4(gv * fac); }
              *(LAS u32x2*)(GLB + q * LDG + k0) = o; } }
        WAVE_LDS_FENCE();
#pragma unroll
        for (int ks = 0; ks < 4; ++ks) aG[dir][ks] = row_frag(GLB, LDG, w * 16, ks * 32, lane);
        f32x4 a1 = {0.f, 0.f, 0.f, 0.f}, a2 = {0.f, 0.f, 0.f, 0.f};
#pragma unroll
        for (int ks = 0; ks < 4; ++ks) a1 = mfma16(aG[dir][ks], tr_frag(XS, LDV, ks * 32, 128, lane), a1);
#pragma unroll
        for (int ns = 0; ns < 2; ++ns) a2 = mfma16(aC[ns], row_frag(ST, LDQ, 128, ns * 32, lane), a2);
#pragma unroll
        for (int i = 0; i < 4; ++i) { const float dv = a1[i] + iq[dir][i] * a2[i]; rden[dir][i] = RCPF(fmaxf(fabsf(__shfl(dv, lane & 48)), 1.0f)); }
    }
    WAVE_LDS_FENCE();
    float ss[4] = {0.f, 0.f, 0.f, 0.f};
#pragma unroll 1
    for (int pt = 0; pt < 8; ++pt) { f32x4 af = {0.f, 0.f, 0.f, 0.f}, ab = {0.f, 0.f, 0.f, 0.f}, sf = {0.f, 0.f, 0.f, 0.f}, sb = {0.f, 0.f, 0.f, 0.f};
#pragma unroll
        for (int ks = 0; ks < 4; ++ks) { const bf16x8 xb = tr_frag(XS, LDV, ks * 32, pt * 16, lane); af = mfma16(aG[0][ks], xb, af); ab = mfma16(aG[1][ks], xb, ab); }
#pragma unroll
        for (int ns = 0; ns < 2; ++ns) { sf = mfma16(aC[ns], row_frag(STF, LDQ, pt * 16, ns * 32, lane), sf); sb = mfma16(aC[ns], row_frag(STB, LDQ, pt * 16, ns * 32, lane), sb); }
#pragma unroll
        for (int i = 0; i < 4; ++i) { const float hv = (af[i] + iq[0][i] * sf[i]) * rden[0][i] + (ab[i] + iq[1][i] * sb[i]) * rden[1][i]; ss[i] += hv * hv;
            GLB[(w * 16 + 4 * lq + i) * LDG + pt * 16 + lc] = (bf16_t)f2bf(hv); } }
    LAS float* rsw = itb + 128 + w * 16;
#pragma unroll
    for (int i = 0; i < 4; ++i) { float sv = ss[i]; sv += __shfl_xor(sv, 1); sv += __shfl_xor(sv, 2); sv += __shfl_xor(sv, 4); sv += __shfl_xor(sv, 8);
        if (lc == 0) rsw[4 * lq + i] = RSQF(sv * (1.f / 128.f) + EPS); }
    WAVE_LDS_FENCE();
    if (has_next) {
#pragma unroll
        for (int j = 0; j < 2; ++j) { TOUCH(R.q[j]); TOUCH(R.k[j]); }
#pragma unroll
        for (int j = 0; j < 4; ++j) TOUCH(R.v[j]);
#pragma unroll
        for (int j = 0; j < 3; ++j) { TOUCH(R.sf[j]); TOUCH(R.sb[j]); }
        TOUCH(R.g[0]); TOUCH(R.g[1]); TOUCH(R.g[2]); TOUCH(R.g[3]); }
    bf16_t* HP = WSP(bf16_t, WS_HP); const float* ng = F.pp->in[19] + hd * 128 + (lane & 15) * 8;
    const f32x4 ng0 = *(const f32x4*)ng, ng1 = *(const f32x4*)(ng + 4);
#pragma unroll
    for (int r = 0; r < 4; ++r) { const int ql = (lane >> 4) + 4 * r, ch = lane & 15; const size_t row = (size_t)(row0 + 16 * w + ql); const float rsq = rsw[ql];
        f32x4 h0, h1, o0, o1; unpack8(*(const LAS u32x4*)(GLB + (w * 16 + ql) * LDG + ch * 8), h0, h1); unpack8(oc[r], o0, o1);
        *(u32x4*)(HP + row * 1024 + hd * 128 + ch * 8) = pack8(h0 * rsq * ng0 * o0, h1 * rsq * ng1 * o1); }
}
DEV void p6v2_outputs(Frame& F) {
    LAS float* aneg_l = (LAS float*)(F.lds + LDS_BYTES - 256);
    if (F.tid < 32) aneg_l[F.tid] = -EXPF(F.pp->in[12][F.tid]);
    SYNC();
    const int nS = BATCH * NCH * 2, nM = BATCH * NCH * 8;
#pragma unroll 1
    for (int it = F.bid; it < nS; it += F.G) { const int b = it / (NCH * 2), r = it % (NCH * 2); s3v2_ssd(F, b, r / 2, r % 2, (const float*)aneg_l); }
    SYNC();
    MlRegs R;
    if (F.bid < nM) { const int it = F.bid; s3v2_ml_load(F, R, it / (NCH * 8), (it % (NCH * 8)) / 8, it % 8);
#pragma unroll
        for (int j = 0; j < 2; ++j) { TOUCH(R.q[j]); TOUCH(R.k[j]); }
#pragma unroll
        for (int j = 0; j < 4; ++j) TOUCH(R.v[j]);
#pragma unroll
        for (int j = 0; j < 3; ++j) { TOUCH(R.sf[j]); TOUCH(R.sb[j]); }
        TOUCH(R.g[0]); TOUCH(R.g[1]); TOUCH(R.g[2]); TOUCH(R.g[3]); }
#pragma unroll 1
    for (int it = F.bid; it < nM; it += F.G) { const int nx = it + F.G; const bool hn = nx < nM;
        s3v2_ml_item(F, R, it / (NCH * 8), (it % (NCH * 8)) / 8, it % 8, hn, nx / (NCH * 8), (nx % (NCH * 8)) / 8, nx % 8); }
    SYNC();
}

template <bool ML> struct S1K { static constexpr int NN = ML ? 64 : 128, LDB = ML ? 80 : 144, NHS = ML ? 1 : 4, PD = ML ? 128 : 64, XC = ML ? 144 : 256, LDXW = ML ? 144 : 272, NQ = ML ? 1 : 2, NXR = ML ? 4 : 8, NBK = ML ? 2 : 4, PPH = ML ? 144 : 64, CPR = NHS * PD / 8; };
template <bool ML> struct S1Regs { u32x4 x[S1K<ML>::NXR]; u32x4 bk[S1K<ML>::NBK]; float g[4]; };
DEV void s1_decode(int code, int& b, int& cc, int& gi) { b = code >> 20; cc = (code >> 8) & 0xfff; gi = code & 0xff; }
template <bool ML> DEV void s1_load(Frame& F, S1Regs<ML>& R, int code, int hq) {
    typedef S1K<ML> K; int b, cc, gi; s1_decode(code, b, cc, gi);
    const bf16_t* XBC = WSP(bf16_t, WS_XBC); const bf16_t* QK = WSP(bf16_t, WS_QK); const bf16_t* V = WSP(bf16_t, WS_V); const float* DTG = WSP(float, WS_DTG);
    int tid_ = F.tid; OPAQUE_V(tid_); const int tid = tid_, lane = tid & 63, w = F.wave, row0 = chunk_row0(b, cc);
    const bool isctx = cc >= NCH; const int seg0 = NLAT + b * CTXL, kseg0 = (cc - NCH) * CHUNK;
    if (ML || !isctx) {
#pragma unroll
        for (int j = 0; j < K::NXR; ++j) { const int id = tid + NTHR * j, rr = row0 + id / K::CPR, c8 = (id % K::CPR) * 8;
            R.x[j] = ML ? *(const u32x4*)(V + um(rr, gi * 128 + c8, 128)) : *(const u32x4*)(XBC + um_xbc(rr, (gi * 8 + hq * 4) * 64 + c8)); }
    } else { static_assert(NTHR % K::CPR == 0, "a thread's chunks share their columns");
        const int col = (gi * 8 + hq * 4) * 64 + (tid % K::CPR) * 8; CtxW cwv; ctx_conv_prep(cwv, F.pp->in[9], F.pp->in[10], 1536, col);
#pragma unroll
        for (int j = 0; j < K::NXR; ++j) { const int id = tid + NTHR * j; R.x[j] = ctx_conv_chunk(cwv, XBC, 1536, seg0, kseg0 + id / K::CPR, col); } }
    if (hq == 0) { const int ldb = ML ? 1024 : 1536;
        if (!isctx) {
#pragma unroll
            for (int j = 0; j < K::NBK; ++j) { const int id = tid + NTHR * j, k = id / (K::NN / 8), n8 = id % (K::NN / 8);
                R.bk[j] = ML ? *(const u32x4*)(QK + um(row0 + k, 512 + gi * 64 + n8 * 8, 64)) : *(const u32x4*)(XBC + um_xbc(row0 + k, 1024 + gi * 128 + n8 * 8)); }
        } else { static_assert(NTHR % (K::NN / 8) == 0, "a thread's chunks share their columns");
            const int col = (ML ? 512 + gi * 64 : 1024 + gi * 128) + (tid % (K::NN / 8)) * 8; CtxW cwv; ctx_conv_prep(cwv, ML ? F.pp->in[15] : F.pp->in[9], ML ? F.pp->in[16] : F.pp->in[10], ldb, col);
#pragma unroll
            for (int j = 0; j < K::NBK; ++j) { const int id = tid + NTHR * j; R.bk[j] = ctx_conv_chunk(cwv, ML ? QK : XBC, ldb, seg0, kseg0 + id / (K::NN / 8), col); } } }
    if (!ML) { const int dir = w >> 2, hg = gi * 8 + hq * 4 + (w & 3);
        R.g[0] = DTG[(size_t)(row0 + lane) * 64 + dir * 16 + hg]; R.g[1] = DTG[(size_t)(row0 + 64 + lane) * 64 + dir * 16 + hg]; }
    else if (w < 2) { R.g[0] = DTG[(size_t)(row0 + lane) * 64 + 32 + w * 16 + gi]; R.g[1] = DTG[(size_t)(row0 + 64 + lane) * 64 + 32 + w * 16 + gi];
                      R.g[2] = DTG[(size_t)(row0 + lane) * 64 + 32 + w * 16 + 8 + gi]; R.g[3] = DTG[(size_t)(row0 + 64 + lane) * 64 + 32 + w * 16 + 8 + gi]; }
}
template <bool ML> DEV void s1_stage(Frame& F, S1Regs<ML>& R, int code, int hq, bool has_next, int ncode, int nhq, const float* aneg) {
    typedef S1K<ML> K; int b, cc, gi; s1_decode(code, b, cc, gi);
    LAS bf16_t* BKN = (LAS bf16_t*)F.lds;
    LAS bf16_t* XW = BKN + 128 * K::LDB;
    LAS float* wl = (LAS float*)(XW + 128 * K::LDXW);
    int tid_ = F.tid; OPAQUE_V(tid_); const int tid = tid_, lane = tid & 63, w = F.wave;
    SYNC();
    if (hq == 0) {
#pragma unroll
        for (int j = 0; j < K::NBK; ++j) { const int id = tid + NTHR * j; *(LAS u32x4*)(BKN + (id / (K::NN / 8)) * K::LDB + (id % (K::NN / 8)) * 8) = R.bk[j]; } }
    u32x4 xc[K::NXR];
#pragma unroll
    for (int j = 0; j < K::NXR; ++j) xc[j] = R.x[j];
    float gc[4];
#pragma unroll
    for (int j = 0; j < 4; ++j) gc[j] = R.g[j];
    if (has_next) s1_load<ML>(F, R, ncode, nhq);
    if (!ML || w < 2) { const int dir = ML ? w : (w >> 2), hl = ML ? 0 : (w & 3), hg = ML ? gi : gi * 8 + hq * 4 + hl;
        float a0, a1, g0, g1;
        if (!ML) { const float db = F.pp->in[11][dir * 16 + hg], an = aneg[dir * 16 + hg]; g0 = softplusf_(gc[0] + db); g1 = softplusf_(gc[1] + db); a0 = g0 * an; a1 = g1 * an; }
        else { const float ibv = F.pp->in[17][dir * 8 + hg], fbv = F.pp->in[18][dir * 8 + hg]; g0 = EXPF(gc[0] + ibv); g1 = EXPF(gc[1] + ibv); a0 = logsigmoidf_(gc[2] + fbv); a1 = logsigmoidf_(gc[3] + fbv); }
        const float p0 = wave_incl_scan(a0, lane); const float t0 = __shfl(p0, 63);
        const float p1 = wave_incl_scan(a1, lane) + t0; const float T = __shfl(p1, 63);
        float w0, w1;
        if (dir == 0) { w0 = EXPF(T - p0) * g0; w1 = EXPF(T - p1) * g1; } else { w0 = EXPF(p0 - a0) * g0; w1 = EXPF(p1 - a1) * g1; }
        wl[(dir * K::NHS + hl) * 128 + lane] = w0; wl[(dir * K::NHS + hl) * 128 + 64 + lane] = w1;
        if (lane == 0) { float* dec = ML ? WSP(float, WS_DECM) + ((size_t)(b * 2 + dir) * NCHT + cc) * 8 + hg : WSP(float, WS_DECS) + ((size_t)(b * 2 + dir) * NCHT + cc) * 16 + hg; *dec = EXPF(T); } }
    SYNC();
#pragma unroll 1
    for (int dir = 0; dir < 2; ++dir) {
        if (dir == 1) SYNC();
#pragma unroll
        for (int j = 0; j < K::NXR; ++j) { const int id = tid + NTHR * j, k = id / K::CPR, c8 = id % K::CPR; const float wk = wl[(dir * K::NHS + (c8 * 8) / K::PD) * 128 + k];
            f32x4 v0, v1; unpack8(xc[j], v0, v1); *(LAS u32x4*)(XW + k * K::LDXW + c8 * 8) = pack8(v0 * wk, v1 * wk); }
        if (ML) { if (tid < 256) { const int k = tid >> 1, hf = tid & 1; u32x4 o = {0u, 0u, 0u, 0u}; if (hf == 0) o.x = f2bf(wl[dir * 128 + k]); *(LAS u32x4*)(XW + k * K::LDXW + 128 + hf * 8) = o; } }
        SYNC();
        if (dir == 1 && has_next) {
#pragma unroll
            for (int j = 0; j < K::NXR; ++j) TOUCH(R.x[j]);
#pragma unroll
            for (int j = 0; j < K::NBK; ++j) TOUCH(R.bk[j]);
            TOUCH(R.g[0]); TOUCH(R.g[1]); TOUCH(R.g[2]); TOUCH(R.g[3]); }
        constexpr int RT = K::NN / 16, CT = K::XC / 16;
        const int ct0 = w, ct1 = w + 8; const bool two = ct1 < CT;
        if (ct0 < CT) {
            bf16x8 bx0[4], bx1[4];
#pragma unroll
            for (int ks = 0; ks < 4; ++ks) { bx0[ks] = tr_frag(XW, K::LDXW, ks * 32, ct0 * 16, lane); bx1[ks] = two ? tr_frag(XW, K::LDXW, ks * 32, ct1 * 16, lane) : bx0[ks]; }
#pragma unroll 1
            for (int u = 0; u < RT / 2; ++u) {
                bf16x8 a0[4], a1[4];
#pragma unroll
                for (int ks = 0; ks < 4; ++ks) { a0[ks] = tr_frag8(BKN, K::LDB, ks * 32, u * 32, lane); a1[ks] = tr_frag8(BKN, K::LDB, ks * 32, u * 32 + 4, lane); }
                f32x4 c00 = {0.f, 0.f, 0.f, 0.f}, c01 = {0.f, 0.f, 0.f, 0.f}, c10 = {0.f, 0.f, 0.f, 0.f}, c11 = {0.f, 0.f, 0.f, 0.f};
#pragma unroll
                for (int ks = 0; ks < 4; ++ks) { c00 = mfma16(a0[ks], bx0[ks], c00); c01 = mfma16(a1[ks], bx0[ks], c01); }
                if (two) {
#pragma unroll
                    for (int ks = 0; ks < 4; ++ks) { c10 = mfma16(a0[ks], bx1[ks], c10); c11 = mfma16(a1[ks], bx1[ks], c11); } }
#pragma unroll
                for (int cs = 0; cs < 2; ++cs) { if (cs == 1 && !two) break;
                    const int pg = (cs ? ct1 : ct0) * 16 + (lane & 15), hl = pg / K::PPH, p = pg % K::PPH, hg = ML ? gi : gi * 8 + hq * 4 + hl, n = u * 32 + 8 * (lane >> 4);
                    bf16_t* dst = ML ? WSP(bf16_t, WS_STM) + ((size_t)(b * 2 + dir) * NCHT + cc) * STM_CH + ((size_t)hg * 144 + p) * 64 + n
                                     : WSP(bf16_t, WS_STS) + ((size_t)(b * 2 + dir) * NCHT + cc) * STS_CH + ((size_t)hg * 64 + p) * 128 + n;
                    *(u32x4*)dst = cs ? pack8(c10, c11) : pack8(c00, c01); }
            }
        }
    }
}
template <bool ML> DEV int s1_build_list(Frame& F, LAS int* list) {
    constexpr int nLS = BATCH * NCH * 2, nCS = BATCH * NCHC * 2, nLM = BATCH * NCH * 8, nCM = BATCH * NCHC * 8;
    const int excl = F.G >= 4 * nCS ? nCS : 0, GE = F.G - excl;
    int n = 0;
    if (!ML) {
        for (int it = F.bid; it < nLS; it += F.G) { const int b = it / (NCH * 2), r = it % (NCH * 2); if (F.tid == 0) list[n] = (b << 20) | ((r / 2) << 8) | (r % 2); ++n; }
        for (int it = F.G - 1 - F.bid; it < nCS; it += F.G) { const int b = it / (NCHC * 2), r = it % (NCHC * 2); if (F.tid == 0) list[n] = (b << 20) | ((NCH + r / 2) << 8) | (r % 2); ++n; }
    } else if (F.bid < GE) {
        for (int it = F.bid; it < nLM + nCM; it += GE) {
            int code;
            if (it < nLM) { const int b = it / (NCH * 8), r = it % (NCH * 8); code = (b << 20) | ((r / 8) << 8) | (r % 8); }
            else { const int j = it - nLM, b = j / (NCHC * 8), r = j % (NCHC * 8); code = (b << 20) | ((NCH + r / 8) << 8) | (r % 8); }
            if (F.tid == 0) list[n] = code; ++n; }
    }
    return n;
}
template <bool ML> DEV void s1_run(Frame& F, const float* aneg, LAS int* list) {
    typedef S1K<ML> K;
    const int n = s1_build_list<ML>(F, list);
    SYNC();
    const int nst = n * K::NQ;
    S1Regs<ML> R;
    if (nst > 0) { s1_load<ML>(F, R, list[0], 0);
#pragma unroll
        for (int j = 0; j < K::NXR; ++j) TOUCH(R.x[j]);
#pragma unroll
        for (int j = 0; j < K::NBK; ++j) TOUCH(R.bk[j]);
        TOUCH(R.g[0]); TOUCH(R.g[1]); TOUCH(R.g[2]); TOUCH(R.g[3]); }
#pragma unroll 1
    for (int st = 0; st < nst; ++st) { const int nx = st + 1; const bool hn = nx < nst;
        s1_stage<ML>(F, R, list[st / K::NQ], st % K::NQ, hn, hn ? list[nx / K::NQ] : 0, nx % K::NQ, aneg); }
    SYNC();
}
DEV void p4v2_local_states(Frame& F) {
    LAS float* aneg_l = (LAS float*)(F.lds + LDS_BYTES - 256);
    LAS int* list = (LAS int*)(F.lds + LDS_BYTES - 1024);
    if (F.tid < 32) aneg_l[F.tid] = -EXPF(F.pp->in[12][F.tid]);
    SYNC();
    s1_run<false>(F, (const float*)aneg_l, list);
    s1_run<true>(F, (const float*)aneg_l, list);
}

DEV void route_tok(Frame& F, int t, LAS int* cntL) {
    const float* rb = F.pp->in[24]; const float* lg = WSP(float, WS_LOG) + (size_t)t * NEXP;
    int* ae = WSP(int, WS_ASGE); int* ar = WSP(int, WS_ASGR); float* aw = WSP(float, WS_ASGW);
    constexpr int GS = NEXP / 8, GQ = GS / 4; static_assert(GS % 4 == 0, "16-byte pieces per group");
    const float NEG = -3.0e38f;
    float gs[8];
    f32x4 q[GQ], qn[GQ];
#pragma unroll
    for (int j = 0; j < GQ; ++j) q[j] = ((const f32x4*)lg)[j];
#pragma unroll
    for (int g = 0; g < 8; ++g) { float m1 = NEG, m2 = NEG;
        if (g < 7) {
#pragma unroll
            for (int j = 0; j < GQ; ++j) qn[j] = ((const f32x4*)lg)[(g + 1) * GQ + j]; }
        MEM_FENCE();
#pragma unroll
        for (int j = 0; j < GS; ++j) { const float v = sigmoidf_(q[j >> 2][j & 3]) + rb[g * GS + j]; if (v > m1) { m2 = m1; m1 = v; } else if (v > m2) m2 = v; }
        gs[g] = m1 + m2;
#pragma unroll
        for (int j = 0; j < GQ; ++j) q[j] = qn[j]; }
    unsigned selmask = 0u;
#pragma unroll
    for (int g = 0; g < 8; ++g) { int rank = 0;
#pragma unroll
        for (int gp = 0; gp < 8; ++gp) rank += (gs[gp] > gs[g] || (gs[gp] == gs[g] && gp < g)) ? 1 : 0;
        if (rank < TOPKG) selmask |= 1u << g; }
    float tv[8]; int ti[8];
#pragma unroll
    for (int i = 0; i < 8; ++i) { tv[i] = NEG; ti[i] = 0; }
    unsigned smk = selmask;
#pragma unroll 1
    for (int sg = 0; sg < TOPKG; ++sg) { const int g = __builtin_ctz(smk); smk &= smk - 1u;
#pragma unroll
        for (int j = 0; j < GQ; ++j) q[j] = ((const f32x4*)lg)[g * GQ + j];
        MEM_FENCE();
#pragma unroll
        for (int j = 0; j < GS; ++j) { const int e = g * GS + j; float cv = sigmoidf_(q[j >> 2][j & 3]) + rb[e]; int ce = e;
#pragma unroll
            for (int i = 0; i < 8; ++i) { const bool gtv = cv > tv[i]; const float ov = tv[i]; const int oi = ti[i];
                tv[i] = gtv ? cv : ov; ti[i] = gtv ? ce : oi; cv = gtv ? ov : cv; ce = gtv ? oi : ce; } }
    }
    float sc[8], ssum = 0.f;
#pragma unroll
    for (int i = 0; i < 8; ++i) { sc[i] = sigmoidf_(lg[ti[i]]); ssum += sc[i]; }
    const float inv = 2.5f / ssum;
#pragma unroll
    for (int i = 0; i < 8; ++i) { const int rk = ATOMIC_ADD_LDS(&cntL[ti[i]], 1); const int a = t * TOPK + i; ae[a] = ti[i]; ar[a] = rk; aw[a] = sc[i] * inv; }
}
DEV void route_tile(Frame& F, int pm) {
    LAS int* cntL = (LAS int*)F.lds;
    for (int e = F.tid; e < 2 * NEXP; e += NTHR) cntL[e] = 0;
    SYNC();
    if (F.wave < 4) route_tok(F, pm * 256 + F.wave * 64 + F.lane, cntL + (F.wave >> 1) * NEXP);
    SYNC();
    int* cm = WSP(int, WS_CMAT) + (size_t)(2 * pm) * NEXP;
    for (int e = F.tid; e < 2 * NEXP; e += NTHR) cm[e] = cntL[e];
    SYNC();
}
DEV void p13_slots(Frame& F) {
    int* ctl = WSP(int, WS_CTL); const int* cmat = WSP(int, WS_CMAT);
    LAS int* cl = (LAS int*)F.lds; LAS int* tb = cl + NEXP; LAS int* pl = tb + NEXP + 1;
    {
        LAS int* pt = cl + 4 * NEXP;
        constexpr int NU = NLAT / 128;
        const int bpw = (NU + 7) / 8, b0 = F.wave * bpw, b1 = (b0 + bpw < NU) ? b0 + bpw : NU, c = F.lane * 4;
        if (c < NEXP) { i32x4 tot = {0, 0, 0, 0}, pre = {0, 0, 0, 0};
#pragma unroll 8
            for (int b = b0; b < b1; ++b) { const i32x4 v = *(const i32x4*)(cmat + (size_t)b * NEXP + c); tot += v; if (b < F.bid) pre += v; }
            *(LAS i32x4*)(pt + F.wave * NEXP + c) = tot; *(LAS i32x4*)(pt + (8 + F.wave) * NEXP + c) = pre; }
        SYNC();
        for (int e = F.tid; e < NEXP; e += NTHR) { int tot = 0, pre = 0;
#pragma unroll
            for (int w = 0; w < 8; ++w) { tot += pt[w * NEXP + e]; pre += pt[(8 + w) * NEXP + e]; }
            cl[e] = tot; pl[e] = pre; }
    }
    SYNC();
    if (F.wave == 0) {
        int loc[EPL], sum = 0;
#pragma unroll
        for (int j = 0; j < EPL; ++j) { loc[j] = (cl[F.lane * EPL + j] + 255) >> 8; sum += loc[j]; }
        int inc = sum;
#pragma unroll
        for (int d = 1; d < 64; d <<= 1) { const int t = __shfl_up(inc, d); if (F.lane >= d) inc += t; }
        int run = inc - sum;
#pragma unroll
        for (int j = 0; j < EPL; ++j) { tb[F.lane * EPL + j] = run; run += loc[j]; }
        if (F.lane == 63) tb[NEXP] = run;
    }
    SYNC();
    const int* ae = WSP(int, WS_ASGE); const int* ar = WSP(int, WS_ASGR); const float* aw = WSP(float, WS_ASGW);
    int* stok = WSP(int, WS_STOK); int* sdst = WSP(int, WS_SDST); float* sw = WSP(float, WS_SW); int* texp = WSP(int, WS_TEXP);
    for (int t0 = F.bid * 128; t0 < NLAT; t0 += F.G * 128)
        for (int i = F.tid; i < 128 * TOPK; i += NTHR) { const int a = t0 * TOPK + i; if (a < NASG) { const int e = ae[a];
            const int slot = tb[e] * 256 + pl[e] + ar[a]; stok[slot] = a / TOPK; sdst[slot] = a; sw[slot] = aw[a]; } }
    for (int e = F.bid; e < NEXP; e += F.G) {
        for (int sl = tb[e] * 256 + cl[e] + F.tid; sl < tb[e + 1] * 256; sl += NTHR) { stok[sl] = 0; sdst[sl] = -1; sw[sl] = 0.f; }
        for (int t = tb[e] + F.tid; t < tb[e + 1]; t += NTHR) texp[t] = e;
    }
    if (F.bid == 0 && F.tid == 0) { ctl[1024] = tb[NEXP]; }
}
DEV void p_final(Frame& F) {
    const float* mod = WSP(float, WS_MOD); const unsigned char* Y8 = WSP(unsigned char, WS_Y); const signed char* YSC = WSP(signed char, WS_YSC); const unsigned char* YS8 = WSP(unsigned char, WS_YS); const signed char* YSE = WSP(signed char, WS_YS) + (size_t)NLAT * 1024; const float* gf = F.pp->in[31];
    const int gw = F.bid * 8 + F.wave, NGW = F.G * 8, lane = F.lane;
    for (int t = gw; t < NLAT; t += NGW) {
        const float* gate = mod + (t / SEQ) * 6144 + 5 * 1024;
        u32x4 yq[TOPK + 1]; int ye[TOPK + 1]; u32x4 xr[2];
#pragma unroll
        for (int k = 0; k < TOPK; ++k) { const size_t a = (size_t)(t * TOPK + k); yq[k] = *((const u32x4*)(Y8 + a * 1024) + lane); ye[k] = (int)YSC[a * 64 + lane]; }
        yq[TOPK] = *((const u32x4*)(YS8 + (size_t)t * 1024) + lane); ye[TOPK] = (int)YSE[(size_t)t * 64 + lane];
#pragma unroll
        for (int h = 0; h < 2; ++h) xr[h] = *((const u32x4*)((const bf16_t*)F.out + (size_t)t * X1LD) + 2 * lane + h);
        f32x4 a[4];
#pragma unroll
        for (int h = 0; h < 4; ++h) a[h] = (f32x4){0.f, 0.f, 0.f, 0.f};
#pragma unroll
        for (int k = 0; k <= TOPK; ++k) { const float sc = ldexp_(1.0f, ye[k]); fp8_acc4(yq[k].x, sc, a[0]); fp8_acc4(yq[k].y, sc, a[1]); fp8_acc4(yq[k].z, sc, a[2]); fp8_acc4(yq[k].w, sc, a[3]); }
        f32x4 x[4]; unpack8(xr[0], x[0], x[1]); unpack8(xr[1], x[2], x[3]);
        f32x4 v[4]; float ssq = 0.f;
#pragma unroll
        for (int h = 0; h < 4; ++h) { v[h] = x[h] + ((const f32x4*)gate)[4 * lane + h] * a[h]; ssq += (v[h].x * v[h].x + v[h].y * v[h].y) + (v[h].z * v[h].z + v[h].w * v[h].w); }
        const float rstd = RSQF(wave_sum(ssq) * (1.f / DM) + EPS);
        f32x4* orow = (f32x4*)(F.out + (size_t)t * DM) + 4 * lane;
#pragma unroll
        for (int h = 0; h < 4; ++h) orow[h] = v[h] * rstd * ((const f32x4*)gf)[4 * lane + h];
    }
}

#ifndef HOST_EMU
#define XB_TMO      128
#define XB_XCNT(j)  (256  + 64 * (j))
#define XB_XSUB(j)  (1280 + 64 * (j))
#define XB_XGEN(j)  (2304 + 64 * (j))
#define XB_TOP      3328
#define XB_TOPGEN   3392
#define XCD_BAR_WORDS 3456
#define XB_SPIN_CAP (1u << 18)
__device__ __forceinline__ unsigned xb_ld(unsigned* p)              { return __hip_atomic_load(p, __ATOMIC_RELAXED, __HIP_MEMORY_SCOPE_AGENT); }
__device__ __forceinline__ unsigned xb_add(unsigned* p, unsigned v) { return __hip_atomic_fetch_add(p, v, __ATOMIC_RELAXED, __HIP_MEMORY_SCOPE_AGENT); }
__device__ __forceinline__ unsigned xb_xcc_id() { return (unsigned)__builtin_amdgcn_s_getreg((3 << 11) | 20) & 0xFu; }
#define XB_SPIN(cond, bar) do { unsigned _sp = 0; while (cond) { __builtin_amdgcn_s_sleep(1); \
    if ((++_sp & 255u) == 0u) { if (xb_ld(&(bar)[XB_TMO])) break; if (_sp > XB_SPIN_CAP) { atomicAdd(&(bar)[XB_TMO], 1u); break; } } } } while (0)
struct XcdBarrier { unsigned* bar; unsigned x; volatile LAS unsigned* st; };
__device__ __forceinline__ XcdBarrier xcd_barrier_post(unsigned* bar, volatile LAS unsigned* st) {
    XcdBarrier b; b.bar = bar; b.x = xb_xcc_id(); b.st = st;
    if (threadIdx.x == 0) (void)xb_add(&bar[XB_XCNT(b.x)], 1u);
    return b;
}
__device__ __forceinline__ void xcd_barrier_complete(unsigned* bar, unsigned x, unsigned& nloc, unsigned& nx) {
    const unsigned G = gridDim.x * gridDim.y * gridDim.z;
    unsigned sum, cnt, mine, sp = 0u;
    for (;;) {
        sum = 0u; cnt = 0u; mine = 0u;
#pragma unroll
        for (unsigned j = 0; j < 16; ++j) { const unsigned c = xb_ld(&bar[XB_XCNT(j)]); sum += c; cnt += (c > 0u) ? 1u : 0u; mine = (j == x) ? c : mine; }
        if (sum == G) break;
        __builtin_amdgcn_s_sleep(1);
        if ((++sp & 255u) == 0u) { if (xb_ld(&bar[XB_TMO])) break; if (sp > XB_SPIN_CAP) { atomicAdd(&bar[XB_TMO], 1u); break; } }
    }
    nloc = mine > 0u ? mine : 1u; nx = cnt > 0u ? cnt : 1u;
}
__device__ __forceinline__ void xcd_barrier(const XcdBarrier& b) {
    asm volatile("s_waitcnt vmcnt(0)" ::: "memory");
    __syncthreads();
    if (threadIdx.x == 0) {
        unsigned* bar = b.bar;
        __builtin_amdgcn_s_waitcnt(0);
        unsigned nloc = b.st[0], nx = b.st[1];
        if (nloc == 0u) { xcd_barrier_complete(bar, b.x, nloc, nx); b.st[0] = nloc; b.st[1] = nx; }
        const unsigned old = xb_add(&bar[XB_XSUB(b.x)], 1u);
        const unsigned gen = old / nloc;
        if (old + 1u == (gen + 1u) * nloc) {
            __builtin_amdgcn_fence(__ATOMIC_RELEASE, "agent");
            asm volatile("s_waitcnt vmcnt(0)" ::: "memory");
            const unsigned og = xb_add(&bar[XB_TOP], 1u);
            const unsigned tg = og / nx;
            if (og + 1u == (tg + 1u) * nx) xb_add(&bar[XB_TOPGEN], 1u);
            else XB_SPIN(xb_ld(&bar[XB_TOPGEN]) == tg, bar);
            __builtin_amdgcn_fence(__ATOMIC_ACQUIRE, "agent");
            xb_add(&bar[XB_XGEN(b.x)], 1u);
            asm volatile("s_waitcnt vmcnt(0)" ::: "memory");
        } else {
            XB_SPIN(xb_ld(&bar[XB_XGEN(b.x)]) == gen, bar);
            __builtin_amdgcn_fence(__ATOMIC_ACQUIRE, "agent");
            asm volatile("s_waitcnt vmcnt(0)" ::: "memory");
        }
    }
    __syncthreads();
}
#endif

#ifndef HOST_EMU
template <class T> __device__ __forceinline__ T* uni_ptr(T* p) { const unsigned long long v = (unsigned long long)p; const unsigned lo = __builtin_amdgcn_readfirstlane((unsigned)v), hi = __builtin_amdgcn_readfirstlane((unsigned)(v >> 32));
    typedef __attribute__((address_space(1))) T GT; GT* g = (GT*)(((unsigned long long)hi << 32) | lo); return (T*)g; }
#endif
#ifndef HOST_EMU
constexpr int WS_BAR_OFF = 16384;
constexpr int LDS_BARST = LDS_BYTES - 64;
#ifndef TPROBE_LO
#define TPROBE_LO -2
#define TPROBE_HI -2
#define TPROBE_MUL 0
#endif
__global__ void __launch_bounds__(NTHR, 2) fwd_megakernel(Params prm) {
    extern __shared__ __attribute__((aligned(16))) unsigned char lds_raw[];
    if (threadIdx.x < 4) ((LAS unsigned*)((LAS unsigned char*)lds_raw + LDS_BARST))[threadIdx.x] = 0u;
    __syncthreads();
    XcdBarrier gbar = xcd_barrier_post((unsigned*)(prm.ws + WS_CTL + WS_BAR_OFF), (volatile LAS unsigned*)((LAS unsigned char*)lds_raw + LDS_BARST));
    unsigned long long tp0 = 0ull, tp1 = 0ull;
    if (TPROBE_LO == 0) tp0 = __builtin_amdgcn_s_memrealtime();
#define GRID_SYNC() xcd_barrier(gbar)
#define PROBE_END(k) do { if ((k) == TPROBE_LO - 1) tp0 = __builtin_amdgcn_s_memrealtime(); if ((k) == TPROBE_HI) tp1 = __builtin_amdgcn_s_memrealtime(); } while (0)
#else
void fwd_megakernel(Params prm) {
    unsigned char* lds_raw = emu_lds();
#define GRID_SYNC() do {} while (0)
#define PROBE_END(k) do {} while (0)
#endif
    Frame F;
    F.lds = (LAS unsigned char*)lds_raw; F.tid = TID; F.lane = F.tid & 63; F.wave = RFL(F.tid >> 6); F.G = NBLK; F.bid = BID;
    F.pp = &prm;
    F.out = prm.out; F.ws = prm.ws;
    const int lo = prm.ph_lo, hi = prm.ph_hi;
#ifndef PH_MASK
#define PH_MASK 0xFFFFFFu
#endif
#define IN(k) ((((PH_MASK) >> (k)) & 1u) && lo <= (k) && (k) < hi)
#ifndef HOST_EMU
#define FRESH() do { int t_ = threadIdx.x; OPAQUE_V(t_); F.tid = t_; F.lane = t_ & 63; F.wave = __builtin_amdgcn_readfirstlane(t_ >> 6); \
        F.ws = uni_ptr(prm.ws); F.out = uni_ptr(prm.out); } while (0)
#else
#define FRESH() do {} while (0)
#endif
#define SEAM(k) do { if (IN(k) && IN((k) + 1)) GRID_SYNC(); PROBE_END(k); } while (0)
#ifndef HOST_EMU
#define OPAQUE_WS() do { unsigned char* t_ = prm.ws; asm volatile("" : "+s"(t_)); F.ws = t_; float* o_ = prm.out; asm volatile("" : "+s"(o_)); F.out = o_; } while (0)
#else
#define OPAQUE_WS() do {} while (0)
#endif
    if (IN(0)) { FRESH(); p0_small(F); } SEAM(0);
    if (IN(1)) { FRESH(); p1_xn(F); } SEAM(1);
    if (IN(2)) { FRESH(); pg8::Gemm g{WSP(bf16_t, WS_XN), WSP(bf16_t, WS_WIN), NROWS, NIN, 1024}; pg8::StaticOrder S; S.init(NROWS, NIN, F.G, F.bid);
        EpiInProj E{WSP(bf16_t, WS_Z), WSP(bf16_t, WS_XBC), WSP(bf16_t, WS_QK), WSP(bf16_t, WS_V), WSP(bf16_t, WS_O), WSP(bf16_t, WS_MG), WSP(float, WS_DTG), F.pp->in[9], F.pp->in[10], F.pp->in[15], F.pp->in[16], F.lds + pg8::STAGE_BYTES};
        pg8::gemm_phase<EpiInProj, pg8::StaticOrder>(F.lds, g, S, E); } SEAM(2);
    if (IN(4)) { FRESH(); p4v2_local_states(F); } SEAM(4);
    if (IN(5)) { FRESH(); p5_scan(F); } SEAM(5);
    if (IN(6)) { FRESH(); p6v2_outputs(F); } SEAM(6);
    if (IN(7)) { FRESH(); pg8::Gemm g{WSP(bf16_t, WS_YPRE), WSP(bf16_t, WS_WSO), NLAT, 1024, 1024}; pg8::StaticOrder S; S.init(NLAT, 1024, F.G, F.bid);
        EpiG1 E{WSP(bf16_t, WS_M1), WSP(bf16_t, WS_MG), WSP(float, WS_SSQ)}; pg8::gemm_phase<EpiG1, pg8::StaticOrder>(F.lds, g, S, E);
        FRESH(); pg8::Gemm g2{WSP(bf16_t, WS_HP), WSP(bf16_t, WS_WMO), NLAT, 1024, 1024};
        EpiG2 E2{WSP(bf16_t, WS_MERGED), WSP(bf16_t, WS_M1), WSP(bf16_t, WS_MG)}; pg8::gemm_phase<EpiG2, pg8::StaticOrder>(F.lds, g2, S, E2); } SEAM(7);
    if (IN(9)) { FRESH(); pg8::Gemm g{WSP(bf16_t, WS_MERGED), WSP(bf16_t, WS_WOUT), NLAT, 1024, 1024}; pg8::StaticOrder S; S.init(NLAT, 1024, F.G, F.bid);
        EpiG3 E{F.pp->in[0], (bf16_t*)F.out, WSP(float, WS_MOD)}; pg8::gemm_phase<EpiG3, pg8::StaticOrder>(F.lds, g, S, E); } SEAM(9);
    if (IN(10)) { FRESH();
#pragma unroll 1
        for (int pm = F.bid; pm < NLAT / 256; pm += F.G) xn2_tile(F, pm);
        FRESH();
        { pg8::Gemm g{WSP(bf16_t, WS_XN), WSP(bf16_t, WS_WRS), NLAT, 768, 1024}; pg8::TileOrder S{F.bid, F.G, NLAT / 256, 3};
          EpiRS E{WSP(float, WS_LOG), WSP(bf16_t, WS_HS)}; pg8::gemm_phase<EpiRS, pg8::TileOrder>(F.lds, g, S, E); }
        FRESH();
#pragma unroll 1
        for (int pm = F.bid; pm < NLAT / 256; pm += F.G) route_tile(F, pm);
        FRESH(); p_expert_weights(F, NLAT / 256 < F.G ? NLAT / 256 : F.G); } SEAM(10);
    if (IN(13)) { FRESH(); p13_slots(F); } SEAM(13);
    if (IN(14)) { FRESH(); const int ntl = WSP(int, WS_CTL)[1024];
        pg8::Gemm g{WSP(bf16_t, WS_XN), WSP(bf16_t, WS_W1T), NLAT, 512, 1024};
        pg8::ExpertOrder<true> S{0, ntl, 2, F.G, F.bid, WSP(int, WS_TEXP), 0, (size_t)512 * 1024, WSP(int, WS_STOK)};
        EpiX1 E{WSP(bf16_t, WS_H)}; pg8::gemm_phase<EpiX1, pg8::ExpertOrder<true>>(F.lds, g, S, E); } SEAM(14);
    if (IN(15)) { FRESH(); const int ntl = WSP(int, WS_CTL)[1024];
        pg8::Gemm g{WSP(bf16_t, WS_H), WSP(bf16_t, WS_W2T), MAXSLOT, 1024, 256};
        pg8::ExpertOrder<false> S{0, ntl, 4, F.G, F.bid, WSP(int, WS_TEXP), 0, (size_t)1024 * 256, nullptr};
        EpiX2 E{WSP(unsigned char, WS_Y), WSP(signed char, WS_YSC), WSP(int, WS_SDST), WSP(float, WS_SW)}; pg8::gemm_phase<EpiX2, pg8::ExpertOrder<false>>(F.lds, g, S, E);
        FRESH();
        pg8::Gemm g2{WSP(bf16_t, WS_HS), WSP(bf16_t, WS_WSD), NLAT, 1024, 256}; pg8::StaticOrder S2; S2.init(NLAT, 1024, F.G, F.bid);
        EpiSD E2{WSP(unsigned char, WS_YS), WSP(signed char, WS_YS) + (size_t)NLAT * 1024}; pg8::gemm_phase<EpiSD, pg8::StaticOrder>(F.lds, g2, S2, E2); } SEAM(15);
    if (IN(16)) { FRESH(); p_final(F); }
#ifndef HOST_EMU
    if (TPROBE_MUL > 0) { asm volatile("s_waitcnt vmcnt(0)" ::: "memory"); __syncthreads(); PROBE_END(16);
        if (TPSEC != 0 && threadIdx.x == 0) { tp0 = 1ull; tp1 = 1ull + *(LAS unsigned long long*)((LAS unsigned char*)lds_raw + 147328); }
        if (blockIdx.x == 0 && threadIdx.x == 0) { const unsigned long long t0 = __builtin_amdgcn_s_memrealtime(), want = (tp0 != 0ull && tp1 > tp0 && tp1 - tp0 < 2000000ull) ? (unsigned long long)TPROBE_MUL * (tp1 - tp0) : 0ull;
            while (__builtin_amdgcn_s_memrealtime() - t0 < want) __builtin_amdgcn_s_sleep(8); } }
#endif
#undef IN
#undef SEAM
}

#ifndef HOST_EMU
extern "C" void kernel_launch(void* const* d_in, const int* in_sizes, int n_in, void* d_out, int out_size, void* d_ws, size_t ws_size, hipStream_t stream) {
    static int grid = 0;
    if (grid == 0) {
        if (n_in != 32 || out_size != NLAT * DM || ws_size < WS_NEED) { fprintf(stderr, "kernel_launch: unexpected problem (n_in %d out %d ws %zu need %zu)\n", n_in, out_size, ws_size, (size_t)WS_NEED); grid = -1; return; }
        int dev = 0, cus = 0, per_cu = 0;
        hipGetDevice(&dev); hipDeviceGetAttribute(&cus, hipDeviceAttributeMultiprocessorCount, dev);
        hipFuncSetAttribute((const void*)fwd_megakernel, hipFuncAttributeMaxDynamicSharedMemorySize, LDS_BYTES);
        hipOccupancyMaxActiveBlocksPerMultiprocessor(&per_cu, (const void*)fwd_megakernel, NTHR, LDS_BYTES);
        if (per_cu < 1) { fprintf(stderr, "kernel_launch: occupancy query says %d blocks per CU\n", per_cu); per_cu = 1; }
        (void)hipGetLastError();
        grid = cus;
    }
    if (grid < 0) return;
    hipMemsetAsync((char*)d_ws + WS_CTL, 0, CTL_BYTES, stream);
    Params p{};
    for (int i = 0; i < 32; ++i) p.in[i] = (const float*)d_in[i];
    p.out = (float*)d_out; p.ws = (unsigned char*)d_ws; p.ph_lo = 0; p.ph_hi = NPHASE;
    void* args[] = {&p};
    const hipError_t e = hipLaunchCooperativeKernel((const void*)fwd_megakernel, dim3(grid), dim3(NTHR), args, LDS_BYTES, stream);
    if (e != hipSuccess) fprintf(stderr, "kernel_launch: launch failed: %s (grid %d)\n", hipGetErrorString(e), grid);
}
#endif
```
